# Optimizing an MI355X kernel written in HIP

```python
import jax, jax.numpy as jnp
from jax import lax
import numpy as np

D_MODEL = 2048
BATCH = 2
SEQ = 4096
DEPTH = 1

MIX_WIDTH = D_MODEL
MOBA_WIDTH = D_MODEL // 2
MOBA_HEADS = 8
MOBA_HEAD_DIM = MOBA_WIDTH // MOBA_HEADS
MOBA_BLOCK = 256
MOBA_TOPK = 3
MOBA_QCHUNK = 64
ROPE_THETA = 500000.0
ROPE_DIMS = MOBA_HEAD_DIM // 4
RET_WIDTH = MIX_WIDTH - MOBA_WIDTH
RET_HEADS = 4
RET_HEAD_DIM = RET_WIDTH // RET_HEADS
RET_CHUNK = 128
RET_ROPE_BASE = 10000.0
IN_SPLITS = [MOBA_WIDTH] * 3 + [RET_WIDTH] * 4
IN_PROJ_DIM = sum(IN_SPLITS)
N_EXPERTS = 64
TOP_K = 8
N_GROUPS = 8
TOPK_GROUPS = 4
EXPERT_DIM = D_MODEL // 4
SHARED_DIM = EXPERT_DIM
ROUTE_SCALE = 2.5
MOE_BLOCK = 128
NORM_EPS = 1e-6
NEG = -1e30

kernel_name = "hymba_moba_retnet_moe_adaln"


def rms_norm(x, g):
    xf = x.astype(jnp.float32)
    y = xf * lax.rsqrt(jnp.mean(xf * xf, axis=-1, keepdims=True) + NORM_EPS)
    return (y * g.astype(jnp.float32)).astype(x.dtype)


def modulate(h, shift, scale):
    return h * (1.0 + scale[:, None, :]) + shift[:, None, :]


def rotary(x, positions, rot_dims, inv_freq):
    half = rot_dims // 2
    ang = positions[:, None, :, None].astype(jnp.float32) * inv_freq
    cos, sin = jnp.cos(ang), jnp.sin(ang)
    xr = x[..., :rot_dims].astype(jnp.float32)
    x1, x2 = xr[..., :half], xr[..., half:]
    rot = jnp.concatenate([x1 * cos - x2 * sin, x2 * cos + x1 * sin], axis=-1)
    return jnp.concatenate([rot.astype(x.dtype), x[..., rot_dims:]], axis=-1)


def moba_attention(q, k, v):
    B, H, T, hd = q.shape
    nb = -(-T // MOBA_BLOCK)
    Tp = nb * MOBA_BLOCK
    pad = ((0, 0), (0, 0), (0, Tp - T), (0, 0))
    q, k, v = jnp.pad(q, pad), jnp.pad(k, pad), jnp.pad(v, pad)
    kb = k.reshape(B, H, nb, MOBA_BLOCK, hd)
    vb = v.reshape(B, H, nb, MOBA_BLOCK, hd)
    kmean = jnp.mean(kb.astype(jnp.float32), axis=3)
    gate = jnp.einsum('bhtd,bhnd->bhtn', q.astype(jnp.float32), kmean)
    qblk = jnp.arange(Tp) // MOBA_BLOCK
    past = jnp.arange(nb)[None, :] < qblk[:, None]
    gate = jnp.where(past, gate, NEG)
    ksel = min(MOBA_TOPK, max(nb - 1, 1))
    gval, gidx = lax.top_k(gate, ksel)
    gvalid = gval > 0.5 * NEG
    nq = Tp // MOBA_QCHUNK
    def chunked(t):
        return jnp.moveaxis(t.reshape(B, H, nq, MOBA_QCHUNK, *t.shape[3:]), 2, 0)
    q_c, idx_c, val_c = chunked(q), chunked(gidx), chunked(gvalid)
    scale = hd ** -0.5
    bi = jnp.arange(B)[:, None, None, None]
    hi = jnp.arange(H)[None, :, None, None]

    def attend(args):
        c, qc, idx, valid = args
        kg = kb[bi, hi, idx].astype(jnp.float32)
        vg = vb[bi, hi, idx].astype(jnp.float32)
        blk = (c * MOBA_QCHUNK) // MOBA_BLOCK
        ko = lax.dynamic_index_in_dim(kb, blk, axis=2, keepdims=False).astype(jnp.float32)
        vo = lax.dynamic_index_in_dim(vb, blk, axis=2, keepdims=False).astype(jnp.float32)
        qf = qc.astype(jnp.float32) * scale
        s_sel = jnp.einsum('bhqd,bhqskd->bhqsk', qf, kg)
        s_sel = jnp.where(valid[..., None], s_sel, NEG).reshape(B, H, MOBA_QCHUNK, ksel * MOBA_BLOCK)
        s_own = jnp.einsum('bhqd,bhkd->bhqk', qf, ko)
        qpos = c * MOBA_QCHUNK + jnp.arange(MOBA_QCHUNK)
        kpos = blk * MOBA_BLOCK + jnp.arange(MOBA_BLOCK)
        s_own = jnp.where(kpos[None, :] <= qpos[:, None], s_own, NEG)
        p = jax.nn.softmax(jnp.concatenate([s_sel, s_own], axis=-1), axis=-1)
        p_sel = p[..., :ksel * MOBA_BLOCK].reshape(B, H, MOBA_QCHUNK, ksel, MOBA_BLOCK)
        p_own = p[..., ksel * MOBA_BLOCK:]
        o = jnp.einsum('bhqsk,bhqskd->bhqd', p_sel, vg) + jnp.einsum('bhqk,bhkd->bhqd', p_own, vo)
        return o.astype(q.dtype)

    out = lax.map(attend, (jnp.arange(nq), q_c, idx_c, val_c))
    out = jnp.moveaxis(out, 0, 2).reshape(B, H, Tp, hd)
    return out[:, :, :T]


def retention(q, k, v):
    B, H, T, d = q.shape
    C = RET_CHUNK
    n = T // C
    q = q.astype(jnp.float32)
    k = k.astype(jnp.float32) * (d ** -0.5)
    v = v.astype(jnp.float32)
    gamma = 1.0 - jnp.exp2(-5.0 - jnp.arange(H, dtype=jnp.float32))
    log_g = jnp.log(gamma)
    pos = jnp.arange(C, dtype=jnp.float32)
    diff = pos[:, None] - pos[None, :]
    dmask = jnp.where(diff >= 0, jnp.exp(jnp.maximum(diff, 0.0) * log_g[:, None, None]), 0.0)
    xi = jnp.exp((pos + 1.0) * log_g[:, None])
    zeta = jnp.exp((C - 1.0 - pos) * log_g[:, None])
    chunk_decay = jnp.exp(C * log_g)
    def chunked(t):
        return jnp.moveaxis(t.reshape(B, H, n, C, d), 2, 0)

    def step(S, inp):
        qi, ki, vi = inp
        inner = jnp.einsum('bhnd,bhmd->bhnm', qi, ki) * dmask
        o = jnp.einsum('bhnm,bhme->bhne', inner, vi) + jnp.einsum('bhnd,bhde->bhne', qi, S) * xi[None, :, :, None]
        S = S * chunk_decay[None, :, None, None] + jnp.einsum('bhmd,bhme->bhde', ki * zeta[None, :, :, None], vi)
        return S, o

    S0 = jnp.zeros((B, H, d, d), jnp.float32)
    _, o = lax.scan(step, S0, (chunked(q), chunked(k), chunked(v)))
    return jnp.moveaxis(o, 0, 2).reshape(B, H, T, d)


def moe_ffn(h, w_router, router_bias, w_gate, w_up, w_down, ws_gate, ws_up, ws_down):
    N, D = h.shape
    E, K, M = N_EXPERTS, TOP_K, MOE_BLOCK
    scores = jax.nn.sigmoid(h.astype(jnp.float32) @ w_router.astype(jnp.float32))
    biased = scores + router_bias.astype(jnp.float32)
    grp = biased.reshape(N, N_GROUPS, E // N_GROUPS)
    grp_score = jnp.sum(lax.top_k(grp, 2)[0], axis=-1)
    _, gsel = lax.top_k(grp_score, TOPK_GROUPS)
    gmask = jnp.sum(jax.nn.one_hot(gsel, N_GROUPS, dtype=jnp.float32), axis=1) > 0
    emask = jnp.repeat(gmask, E // N_GROUPS, axis=1)
    _, eidx = lax.top_k(jnp.where(emask, biased, NEG), K)
    w = jnp.take_along_axis(scores, eidx, axis=1)
    w = w / jnp.sum(w, axis=-1, keepdims=True) * ROUTE_SCALE
    e_flat = eidx.reshape(-1)
    tok_flat = jnp.repeat(jnp.arange(N, dtype=jnp.int32), K)
    w_flat = w.reshape(-1)
    order = jnp.argsort(e_flat)
    e_s, tok_s, w_s = e_flat[order], tok_flat[order], w_flat[order]
    counts = jnp.bincount(e_flat, length=E)
    pcounts = (counts + M - 1) // M * M
    start = jnp.cumsum(counts) - counts
    pend = jnp.cumsum(pcounts)
    pstart = pend - pcounts
    dest = pstart[e_s] + jnp.arange(N * K) - start[e_s]
    R = N * K + E * M
    nblk = R // M
    row_tok = jnp.zeros((R,), jnp.int32).at[dest].set(tok_s)
    row_w = jnp.zeros((R,), jnp.float32).at[dest].set(w_s)
    blk_expert = jnp.clip(jnp.searchsorted(pend, jnp.arange(nblk) * M, side='right'), 0, E - 1)

    def expert_block(args):
        tok, wt, e = args
        xb = h[tok]
        a = xb @ w_gate[e]
        u = xb @ w_up[e]
        return ((jax.nn.silu(a) * u) @ w_down[e]) * wt[:, None].astype(h.dtype)

    y = lax.map(expert_block, (row_tok.reshape(nblk, M), row_w.reshape(nblk, M), blk_expert))
    routed = jax.ops.segment_sum(y.reshape(R, D), row_tok, num_segments=N)
    shared = (jax.nn.silu(h @ ws_gate) * (h @ ws_up)) @ ws_down
    return routed + shared


def setup_inputs(seed: int = 0) -> dict:
    key = jax.random.key(seed)
    ks = jax.random.split(key, 17)
    f32 = jnp.float32
    D = D_MODEL
    def nrm(k, shape, fan_in, s=1.0):
        return jax.random.normal(k, shape, f32) * (s * fan_in ** -0.5)
    x = jax.random.normal(ks[0], (BATCH, SEQ, D), f32)
    c = jax.random.normal(ks[1], (BATCH, D), f32)
    positions = jnp.broadcast_to(jnp.arange(SEQ, dtype=jnp.int32)[None, :], (BATCH, SEQ))
    w_ada = nrm(ks[2], (DEPTH, D, 6 * D), D, 0.5)
    b_ada = 0.02 * jax.random.normal(ks[3], (DEPTH, 6 * D), f32)
    norm_mix = 1.0 + 0.02 * jax.random.normal(ks[4], (DEPTH, D), f32)
    norm_ffn = 1.0 + 0.02 * jax.random.normal(ks[5], (DEPTH, D), f32)
    norm_out = 1.0 + 0.02 * jax.random.normal(ks[6], (D,), f32)
    w_in = nrm(ks[7], (DEPTH, D, IN_PROJ_DIM), D)
    w_out = nrm(ks[8], (DEPTH, MIX_WIDTH, D), MIX_WIDTH)
    w_router = nrm(ks[9], (DEPTH, D, N_EXPERTS), D)
    router_bias = 0.01 * jax.random.normal(ks[10], (DEPTH, N_EXPERTS), f32)
    w_gate = nrm(ks[11], (DEPTH, N_EXPERTS, D, EXPERT_DIM), D)
    w_up = nrm(ks[12], (DEPTH, N_EXPERTS, D, EXPERT_DIM), D)
    w_down = nrm(ks[13], (DEPTH, N_EXPERTS, EXPERT_DIM, D), EXPERT_DIM)
    w_sh_gate = nrm(ks[14], (DEPTH, D, SHARED_DIM), D)
    w_sh_up = nrm(ks[15], (DEPTH, D, SHARED_DIM), D)
    w_sh_down = nrm(ks[16], (DEPTH, SHARED_DIM, D), SHARED_DIM)
    return {"x": x, "c": c, "positions": positions, "w_ada": w_ada, "b_ada": b_ada,
            "norm_mix": norm_mix, "norm_ffn": norm_ffn, "norm_out": norm_out,
            "w_in": w_in, "w_out": w_out, "w_router": w_router, "router_bias": router_bias,
            "w_gate": w_gate, "w_up": w_up, "w_down": w_down,
            "w_sh_gate": w_sh_gate, "w_sh_up": w_sh_up, "w_sh_down": w_sh_down}


def reference(x, c, positions, w_ada, b_ada, norm_mix, norm_ffn, norm_out, w_in, w_out,
              w_router, router_bias, w_gate, w_up, w_down, w_sh_gate, w_sh_up, w_sh_down):
    B, T, D = x.shape
    moba_inv = ROPE_THETA ** (-(jnp.arange(ROPE_DIMS // 2, dtype=jnp.float32) * 2.0 / ROPE_DIMS))
    ret_inv = RET_ROPE_BASE ** (-jnp.linspace(0.0, 1.0, RET_HEAD_DIM // 2, dtype=jnp.float32))
    split_idx = [int(s) for s in np.cumsum(IN_SPLITS)[:-1]]
    def to_heads(t, H):
        return t.reshape(B, T, H, -1).transpose(0, 2, 1, 3)
    def from_heads(t):
        return t.transpose(0, 2, 1, 3).reshape(B, T, -1)
    for l in range(DEPTH):
        mod = jax.nn.silu(c) @ w_ada[l] + b_ada[l]
        shift_a, scale_a, gate_a, shift_f, scale_f, gate_f = jnp.split(mod, 6, axis=-1)
        h = modulate(rms_norm(x, norm_mix[l]), shift_a, scale_a)
        proj = h @ w_in[l]
        qa, ka, va, qr, kr, vr, gr = jnp.split(proj, split_idx, axis=-1)
        qa = rotary(to_heads(qa, MOBA_HEADS), positions, ROPE_DIMS, moba_inv)
        ka = rotary(to_heads(ka, MOBA_HEADS), positions, ROPE_DIMS, moba_inv)
        o_a = from_heads(moba_attention(qa, ka, to_heads(va, MOBA_HEADS)))
        qr = rotary(to_heads(qr, RET_HEADS), positions, RET_HEAD_DIM, ret_inv)
        kr = rotary(to_heads(kr, RET_HEADS), positions, RET_HEAD_DIM, ret_inv)
        o_r = retention(qr, kr, to_heads(vr, RET_HEADS))
        mu = jnp.mean(o_r, axis=-1, keepdims=True)
        var = jnp.mean(jnp.square(o_r - mu), axis=-1, keepdims=True)
        o_r = ((o_r - mu) * lax.rsqrt(var + NORM_EPS)).astype(x.dtype)
        o_r = from_heads(o_r) * jax.nn.silu(gr)
        mix = jnp.concatenate([o_a, o_r], axis=-1) @ w_out[l]
        x = x + gate_a[:, None, :] * mix
        h = modulate(rms_norm(x, norm_ffn[l]), shift_f, scale_f)
        y = moe_ffn(h.reshape(B * T, D), w_router[l], router_bias[l], w_gate[l], w_up[l], w_down[l],
                    w_sh_gate[l], w_sh_up[l], w_sh_down[l]).reshape(B, T, D)
        x = x + gate_f[:, None, :] * y
    return rms_norm(x, norm_out)
```

```cpp
#include <hip/hip_runtime.h>
#include <cstdio>
#include <cstdint>

constexpr int NB = 2, T = 4096, D = 2048, M = NB * T;
constexpr int NPROJ = 7168;
constexpr int NE = 64, EH = 512;
constexpr float NORM_EPS = 1e-6f;
constexpr float NEGF = -1e30f;

constexpr size_t MiB = 1u << 20;
constexpr size_t WS_CTL = 0, CTL_ZERO_BYTES = 1 * MiB;
constexpr size_t WS_MOD = 3 * MiB;
constexpr size_t WS_KMEAN = 4 * MiB;
constexpr size_t WS_RSTD = 5 * MiB;
constexpr size_t WS_LTOK = 6 * MiB;
constexpr size_t WS_LW = 9 * MiB;
constexpr size_t WS_ROPEM = 12 * MiB;
constexpr size_t WS_ROPER = 13 * MiB;
constexpr size_t WS_LOGITS = 21 * MiB;
constexpr size_t WS_WGU = 24 * MiB;
constexpr size_t WS_WD = 284 * MiB;
constexpr size_t WS_X1 = 414 * MiB;
constexpr size_t WS_XN = 478 * MiB;
constexpr size_t WS_ACT = 510 * MiB;
constexpr size_t WS_WIN = 600 * MiB;
constexpr size_t WS_WOUT = 628 * MiB;
constexpr size_t WS_PROJ = 636 * MiB;
constexpr size_t WS_MIX = 748 * MiB;
constexpr size_t WS_U = 780 * MiB;
constexpr size_t WS_S = 844 * MiB;
constexpr size_t WS_YSLOT = 600 * MiB;
constexpr size_t WS_PROJF = 780 * MiB;
constexpr size_t WS_END = 1024 * MiB;
constexpr int CW_CNT = 1024;

typedef unsigned short bf16;
__device__ __forceinline__ float bf2f(bf16 v) { return __uint_as_float(((unsigned)v) << 16); }
__device__ __forceinline__ bf16 f2bf(float f) { unsigned u = __float_as_uint(f); return (bf16)((u + 0x7fffu + ((u >> 16) & 1u)) >> 16); }
__device__ __forceinline__ float wave_sum(float v) {
#pragma unroll
    for (int o = 1; o < 64; o <<= 1) v += __shfl_xor(v, o);
    return v;
}
__device__ __forceinline__ float wave_max(float v) {
#pragma unroll
    for (int o = 1; o < 64; o <<= 1) v = fmaxf(v, __shfl_xor(v, o));
    return v;
}
__device__ __forceinline__ float silu_f(float x) { return x / (1.f + __expf(-x)); }

namespace nv {

__global__ void k_rope(const int* pos, float2* ropem, float2* roper) {
    int i = blockIdx.x * blockDim.x + threadIdx.x;
    if (i < M * 16) { int m = i >> 4, f = i & 15; double inv = pow(500000.0, -(double)f / 16.0); double a = (double)pos[m] * inv; ropem[i] = make_float2((float)cos(a), (float)sin(a)); }
    if (i < M * 128) { int m = i >> 7, f = i & 127; double inv = pow(10000.0, -(double)f / 127.0); double a = (double)pos[m] * inv; roper[i] = make_float2((float)cos(a), (float)sin(a)); }
}
__global__ void k_mod(const float* c, const float* w_ada, const float* b_ada, float* mod) {
    __shared__ float sc[2][D];
    for (int i = threadIdx.x; i < 2 * D; i += blockDim.x) sc[i / D][i % D] = silu_f(c[i]);
    __syncthreads();
    int n = blockIdx.x * blockDim.x + threadIdx.x;
    if (n >= 6 * D) return;
    float a0 = 0.f, a1 = 0.f;
    for (int k = 0; k < D; ++k) { float w = w_ada[(size_t)k * (6 * D) + n]; a0 += sc[0][k] * w; a1 += sc[1][k] * w; }
    mod[n] = a0 + b_ada[n]; mod[6 * D + n] = a1 + b_ada[n];
}
__global__ void k_norm_mod(const float* x, const float* g, const float* mod, int shift_off, int scale_off, bf16* xn, float* rstd_out) {
    int wave = threadIdx.x >> 6, lane = threadIdx.x & 63;
    int m = blockIdx.x * (blockDim.x >> 6) + wave; if (m >= M) return;
    int b = m / T;
    const float4* xr = (const float4*)(x + (size_t)m * D);
    float4 v[8]; float s = 0.f;
#pragma unroll
    for (int j = 0; j < 8; ++j) { v[j] = xr[lane + 64 * j]; s += v[j].x * v[j].x + v[j].y * v[j].y + v[j].z * v[j].z + v[j].w * v[j].w; }
    s = wave_sum(s);
    float rstd = rsqrtf(s * (1.f / D) + NORM_EPS);
    if (rstd_out && lane == 0) rstd_out[m] = rstd;
    const float* sh = mod + b * 6 * D + shift_off; const float* scv = mod + b * 6 * D + scale_off;
#pragma unroll
    for (int j = 0; j < 8; ++j) {
        int col = (lane + 64 * j) * 4;
        float4 gg = *(const float4*)(g + col), s4 = *(const float4*)(scv + col), h4 = *(const float4*)(sh + col);
        float o0 = v[j].x * rstd * gg.x * (1.f + s4.x) + h4.x, o1 = v[j].y * rstd * gg.y * (1.f + s4.y) + h4.y;
        float o2 = v[j].z * rstd * gg.z * (1.f + s4.z) + h4.z, o3 = v[j].w * rstd * gg.w * (1.f + s4.w) + h4.w;
        ushort4 o; o.x = f2bf(o0); o.y = f2bf(o1); o.z = f2bf(o2); o.w = f2bf(o3);
        *(ushort4*)(xn + (size_t)m * D + col) = o;
    }
}

template <class FA, class FB, class FE>
__device__ __forceinline__ void ngemm_tile(float* sm, int K, FA fa, FB fb, FE fe) {
    float* As = sm; float* Bs = sm + 16 * 68;
    const int tid = threadIdx.x, ty = tid >> 5, tx = tid & 31;
    float acc[4][4];
#pragma unroll
    for (int i = 0; i < 4; ++i)
#pragma unroll
        for (int j = 0; j < 4; ++j) acc[i][j] = 0.f;
    for (int k0 = 0; k0 < K; k0 += 16) {
#pragma unroll
        for (int i = tid; i < 1024; i += 512) { int r = i >> 4, k = i & 15; As[k * 68 + r] = fa(r, k0 + k); }
#pragma unroll
        for (int i = tid; i < 2048; i += 512) { int k = i >> 7, c = i & 127; Bs[k * 132 + c] = fb(k0 + k, c); }
        __syncthreads();
#pragma unroll
        for (int k = 0; k < 16; ++k) {
            float4 a = *(float4*)&As[k * 68 + ty * 4]; float4 b = *(float4*)&Bs[k * 132 + tx * 4];
            float av[4] = {a.x, a.y, a.z, a.w}, bv[4] = {b.x, b.y, b.z, b.w};
#pragma unroll
            for (int i = 0; i < 4; ++i)
#pragma unroll
                for (int j = 0; j < 4; ++j) acc[i][j] += av[i] * bv[j];
        }
        __syncthreads();
    }
    fe(ty * 4, tx * 4, acc);
}
constexpr int NG_SM = 16 * 68 + 16 * 132;

__global__ void __launch_bounds__(512) k_proj(const bf16* xn, const float* w_in, float* projf) {
    __shared__ __attribute__((aligned(16))) float sm[NG_SM];
    const int m0 = (blockIdx.x / (NPROJ / 128)) * 64, n0 = (blockIdx.x % (NPROJ / 128)) * 128;
    ngemm_tile(sm, D,
        [&](int r, int k) { return bf2f(xn[(size_t)(m0 + r) * D + k]); },
        [&](int k, int c) { return w_in[(size_t)k * NPROJ + n0 + c]; },
        [&](int r0, int c0, const float (&acc)[4][4]) {
#pragma unroll
            for (int i = 0; i < 4; ++i) *(float4*)(projf + (size_t)(m0 + r0 + i) * NPROJ + n0 + c0) = make_float4(acc[i][0], acc[i][1], acc[i][2], acc[i][3]);
        });
}
__global__ void k_rot(const float* projf, const float2* ropem, const float2* roper, bf16* proj) {
    size_t i = (size_t)blockIdx.x * blockDim.x + threadIdx.x;
    if (i >= (size_t)M * NPROJ) return;
    int m = (int)(i / NPROJ), col = (int)(i % NPROJ), t = col >> 10, cc = col & 1023;
    const float* row = projf + (size_t)m * NPROJ;
    float x = row[col], val = x;
    if (t == 0 || t == 1) {
        int d = cc & 127;
        if (d < 32) { int f = d & 15; float2 cs = ropem[m * 16 + f]; float xp = row[col + (d < 16 ? 16 : -16)]; val = d < 16 ? x * cs.x - xp * cs.y : x * cs.x + xp * cs.y; }
    } else if (t == 3 || t == 4) {
        int d = cc & 255, f = d & 127; float2 cs = roper[m * 128 + f]; float xp = row[col + (d < 128 ? 128 : -128)];
        val = d < 128 ? x * cs.x - xp * cs.y : x * cs.x + xp * cs.y;
    }
    proj[(size_t)t * M * 1024 + (size_t)m * 1024 + cc] = f2bf(val);
}
__global__ void k_kmean(const bf16* ka, float* kmean) {
    int i = blockIdx.x * blockDim.x + threadIdx.x; if (i >= NB * 16 * 1024) return;
    int col = i & 1023, bb = i >> 10;
    float s = 0.f;
    for (int r = 0; r < 256; ++r) s += bf2f(ka[(size_t)(bb * 256 + r) * 1024 + col]);
    kmean[i] = s * (1.f / 256.f);
}
__global__ void __launch_bounds__(512) k_moba(const bf16* qa, const bf16* ka, const bf16* va, const float* kmean, bf16* mix) {
    __shared__ float sq[8][128];
    __shared__ float sp[8][1024];
    __shared__ float sg[8][16];
    const int m = blockIdx.x, h = threadIdx.x >> 6, lane = threadIdx.x & 63;
    const int b = m / T, t = m % T, qb = t >> 8;
    float q0 = bf2f(qa[(size_t)m * 1024 + h * 128 + lane]), q1 = bf2f(qa[(size_t)m * 1024 + h * 128 + lane + 64]);
    sq[h][lane] = q0; sq[h][lane + 64] = q1;
    for (int n = 0; n < qb; ++n) {
        const float* km = kmean + ((size_t)(b * 16 + n) * 1024 + h * 128);
        float g = wave_sum(q0 * km[lane] + q1 * km[lane + 64]);
        if (lane == 0) sg[h][n] = g;
    }
    __syncthreads();
    int sel[4]; bool val[4];
    {
        unsigned chosen = 0u;
#pragma unroll
        for (int s = 0; s < 3; ++s) {
            float best = -3e38f; int bi = -1;
            for (int n = 0; n < qb; ++n) if (!((chosen >> n) & 1u) && sg[h][n] > best) { best = sg[h][n]; bi = n; }
            val[s] = bi >= 0; sel[s] = bi >= 0 ? bi : 0; if (bi >= 0) chosen |= 1u << bi;
        }
        sel[3] = qb; val[3] = true;
    }
    const float scale = 0.08838834764831845f;
    float sc[4][4]; float mx = -3e38f;
#pragma unroll
    for (int j = 0; j < 4; ++j)
#pragma unroll
        for (int i = 0; i < 4; ++i) {
            float s = NEGF;
            if (val[j]) {
                int key = sel[j] * 256 + lane + 64 * i;
                if (j < 3 || key <= t) {
                    const uint4* kr = (const uint4*)(ka + (size_t)(b * T + key) * 1024 + h * 128);
                    float a = 0.f;
#pragma unroll 4
                    for (int c = 0; c < 16; ++c) { uint4 kk = kr[c]; const float* qq = &sq[h][c * 8];
                        a += qq[0] * __uint_as_float(kk.x << 16) + qq[1] * __uint_as_float(kk.x & 0xffff0000u) + qq[2] * __uint_as_float(kk.y << 16) + qq[3] * __uint_as_float(kk.y & 0xffff0000u)
                           + qq[4] * __uint_as_float(kk.z << 16) + qq[5] * __uint_as_float(kk.z & 0xffff0000u) + qq[6] * __uint_as_float(kk.w << 16) + qq[7] * __uint_as_float(kk.w & 0xffff0000u); }
                    s = a * scale;
                }
            }
            sc[j][i] = s; mx = fmaxf(mx, s);
        }
    mx = wave_max(mx);
    float sum = 0.f;
#pragma unroll
    for (int j = 0; j < 4; ++j)
#pragma unroll
        for (int i = 0; i < 4; ++i) { float p = __expf(sc[j][i] - mx); sc[j][i] = p; sum += p; }
    sum = wave_sum(sum);
    const float inv = 1.f / sum;
#pragma unroll
    for (int j = 0; j < 4; ++j)
#pragma unroll
        for (int i = 0; i < 4; ++i) sp[h][j * 256 + lane + 64 * i] = sc[j][i] * inv;
    __syncthreads();
    float o0 = 0.f, o1 = 0.f;
#pragma unroll
    for (int j = 0; j < 4; ++j) {
        if (!val[j]) continue;
        const int nk = (j < 3) ? 256 : (t & 255) + 1;
        const bf16* vb = va + (size_t)(b * T + sel[j] * 256) * 1024 + h * 128;
        for (int i = 0; i < nk; ++i) { float p = sp[h][j * 256 + i]; o0 += p * bf2f(vb[(size_t)i * 1024 + lane]); o1 += p * bf2f(vb[(size_t)i * 1024 + lane + 64]); }
    }
    mix[(size_t)m * D + h * 128 + lane] = f2bf(o0); mix[(size_t)m * D + h * 128 + lane + 64] = f2bf(o1);
}
__global__ void __launch_bounds__(512) k_ret(const bf16* qr, const bf16* kr, const bf16* vr, const bf16* gr, bf16* mix) {
    __shared__ float sq[8][256];
    __shared__ float sp[8][1024];
    const int w = threadIdx.x >> 6, lane = threadIdx.x & 63;
    const int m = blockIdx.x * 2 + (w >> 2), h = w & 3, b = m / T, t = m % T;
    for (int j = 0; j < 4; ++j) sq[w][lane + 64 * j] = bf2f(qr[(size_t)m * 1024 + h * 256 + lane + 64 * j]);
    __syncthreads();
    const float gamma = 1.f - exp2f(-5.f - (float)h), lg2 = log2f(gamma);
    float o[4] = {0.f, 0.f, 0.f, 0.f};
    for (int s0 = 0; s0 <= t; s0 += 1024) {
        const int send = min(s0 + 1023, t);
        if ((float)(t - send) * lg2 < -100.f) continue;
#pragma unroll 1
        for (int i = 0; i < 16; ++i) {
            int s = s0 + lane + 64 * i; float p = 0.f;
            if (s <= t) {
                const uint4* kk4 = (const uint4*)(kr + (size_t)(b * T + s) * 1024 + h * 256);
                float a = 0.f;
#pragma unroll 4
                for (int c = 0; c < 32; ++c) { uint4 kk = kk4[c]; const float* qq = &sq[w][c * 8];
                    a += qq[0] * __uint_as_float(kk.x << 16) + qq[1] * __uint_as_float(kk.x & 0xffff0000u) + qq[2] * __uint_as_float(kk.y << 16) + qq[3] * __uint_as_float(kk.y & 0xffff0000u)
                       + qq[4] * __uint_as_float(kk.z << 16) + qq[5] * __uint_as_float(kk.z & 0xffff0000u) + qq[6] * __uint_as_float(kk.w << 16) + qq[7] * __uint_as_float(kk.w & 0xffff0000u); }
                p = a * 0.0625f * exp2f((float)(t - s) * lg2);
            }
            sp[w][lane + 64 * i] = p;
        }
        __builtin_amdgcn_wave_barrier();
        const int nk = send - s0 + 1;
        const bf16* vb = vr + (size_t)(b * T + s0) * 1024 + h * 256;
        for (int i = 0; i < nk; ++i) { float p = sp[w][i];
#pragma unroll
            for (int j = 0; j < 4; ++j) o[j] += p * bf2f(vb[(size_t)i * 1024 + lane + 64 * j]); }
        __builtin_amdgcn_wave_barrier();
    }
    float mu = wave_sum(o[0] + o[1] + o[2] + o[3]) * (1.f / 256.f);
    float vs = 0.f;
#pragma unroll
    for (int j = 0; j < 4; ++j) { o[j] -= mu; vs += o[j] * o[j]; }
    float rs = rsqrtf(wave_sum(vs) * (1.f / 256.f) + NORM_EPS);
#pragma unroll
    for (int j = 0; j < 4; ++j) { float g = bf2f(gr[(size_t)m * 1024 + h * 256 + lane + 64 * j]); mix[(size_t)m * D + 1024 + h * 256 + lane + 64 * j] = f2bf(o[j] * rs * silu_f(g)); }
}
__global__ void __launch_bounds__(512) k_outproj(const bf16* mix, const float* w_out, const float* x, const float* mod, float* x1) {
    __shared__ __attribute__((aligned(16))) float sm[NG_SM];
    const int m0 = (blockIdx.x / (D / 128)) * 64, n0 = (blockIdx.x % (D / 128)) * 128;
    const float* gate = mod + (m0 / T) * 6 * D + 2 * D;
    ngemm_tile(sm, D,
        [&](int r, int k) { return bf2f(mix[(size_t)(m0 + r) * D + k]); },
        [&](int k, int c) { return w_out[(size_t)k * D + n0 + c]; },
        [&](int r0, int c0, const float (&acc)[4][4]) {
#pragma unroll
            for (int i = 0; i < 4; ++i) { size_t off = (size_t)(m0 + r0 + i) * D + n0 + c0; float4 xv = *(const float4*)(x + off), g4 = *(const float4*)(gate + n0 + c0);
                *(float4*)(x1 + off) = make_float4(xv.x + g4.x * acc[i][0], xv.y + g4.y * acc[i][1], xv.z + g4.z * acc[i][2], xv.w + g4.w * acc[i][3]); }
        });
}
__global__ void __launch_bounds__(512) k_logits(const float* x1, const float* rstd, const float* g, const float* mod, const float* w_router, float* logits) {
    __shared__ __attribute__((aligned(16))) float sm[NG_SM];
    const int m0 = blockIdx.x * 64, b = m0 / T;
    const float* sh = mod + b * 6 * D + 3 * D; const float* scv = mod + b * 6 * D + 4 * D;
    ngemm_tile(sm, D,
        [&](int r, int k) { return x1[(size_t)(m0 + r) * D + k] * rstd[m0 + r] * g[k] * (1.f + scv[k]) + sh[k]; },
        [&](int k, int c) { return c < 64 ? w_router[(size_t)k * 64 + c] : 0.f; },
        [&](int r0, int c0, const float (&acc)[4][4]) {
            if (c0 < 64) {
#pragma unroll
                for (int i = 0; i < 4; ++i) *(float4*)(logits + (size_t)(m0 + r0 + i) * 64 + c0) = make_float4(acc[i][0], acc[i][1], acc[i][2], acc[i][3]); }
        });
}
__global__ void k_route(const float* logits, const float* bias, unsigned* cnt, int* ltok, float* lw) {
    const int wave = threadIdx.x >> 6, lane = threadIdx.x & 63;
    const int m = blockIdx.x * (blockDim.x >> 6) + wave; if (m >= M) return;
    const float lg = logits[(size_t)m * 64 + lane];
    const float score = 1.f / (1.f + __expf(-lg));
    const float biased = score + bias[lane];
    float m1 = biased;
    m1 = fmaxf(m1, __shfl_xor(m1, 1)); m1 = fmaxf(m1, __shfl_xor(m1, 2)); m1 = fmaxf(m1, __shfl_xor(m1, 4));
    unsigned long long eq = __ballot(biased == m1);
    unsigned gb = (unsigned)(eq >> (lane & ~7)) & 0xffu;
    int first = __ffs(gb) - 1;
    float v2 = ((lane & 7) == first) ? -3e38f : biased;
    v2 = fmaxf(v2, __shfl_xor(v2, 1)); v2 = fmaxf(v2, __shfl_xor(v2, 2)); v2 = fmaxf(v2, __shfl_xor(v2, 4));
    const float gs = m1 + v2; const int g = lane >> 3;
    int grank = 0;
#pragma unroll
    for (int j = 0; j < 8; ++j) { float o = __shfl(gs, j * 8); grank += (o > gs || (o == gs && j < g)) ? 1 : 0; }
    const float masked = grank < 4 ? biased : NEGF;
    int rank = 0;
#pragma unroll
    for (int j = 0; j < 64; ++j) { float o = __shfl(masked, j); rank += (o > masked || (o == masked && j < lane)) ? 1 : 0; }
    const bool selx = rank < 8;
    const float ssum = wave_sum(selx ? score : 0.f);
    if (selx) {
        unsigned pos = atomicAdd(&cnt[lane], 1u);
        ltok[lane * M + pos] = m * 16 + rank; lw[lane * M + pos] = score / ssum * 2.5f;
    }
    if (lane == 0) { ltok[64 * M + m] = m * 16 + 8; lw[64 * M + m] = 1.f; }
}
__device__ __forceinline__ int expert_count(const unsigned* cnt, int e) { return e < 64 ? (int)cnt[e] : M; }
__device__ __forceinline__ int find_expert(const unsigned* cnt, int R0, int& local, int& count) {
    int start = 0;
    for (int e = 0; e < 65; ++e) { int c = expert_count(cnt, e); int pc = (c + 255) / 256 * 256; if (R0 < start + pc) { local = R0 - start; count = c; return e; } start += pc; }
    return -1;
}
__global__ void __launch_bounds__(512) k_gateup(const bf16* xn, const unsigned* cnt, const int* ltok, const float* wg, const float* wu, const float* wsg, const float* wsu, bf16* act) {
    __shared__ __attribute__((aligned(16))) float sm[NG_SM];
    __shared__ int stok[64];
    const int R0 = (blockIdx.x / 8) * 64, j0 = (blockIdx.x % 8) * 64;
    int local, count; const int e = find_expert(cnt, R0, local, count);
    if (e < 0 || local >= count) return;
    if (threadIdx.x < 64) { int r = local + threadIdx.x; stok[threadIdx.x] = r < count ? (ltok[e * M + r] >> 4) : (ltok[e * M + count - 1] >> 4); }
    __syncthreads();
    const float* G = e < 64 ? wg + (size_t)e * D * EH : wsg; const float* U = e < 64 ? wu + (size_t)e * D * EH : wsu;
    ngemm_tile(sm, D,
        [&](int r, int k) { return bf2f(xn[(size_t)stok[r] * D + k]); },
        [&](int k, int c) { return (c & 1) ? U[(size_t)k * EH + j0 + (c >> 1)] : G[(size_t)k * EH + j0 + (c >> 1)]; },
        [&](int r0, int c0, const float (&acc)[4][4]) {
#pragma unroll
            for (int i = 0; i < 4; ++i) { bf16* o = act + (size_t)(R0 + r0 + i) * EH + j0 + (c0 >> 1);
                o[0] = f2bf(silu_f(acc[i][0]) * acc[i][1]); o[1] = f2bf(silu_f(acc[i][2]) * acc[i][3]); }
        });
}
__global__ void __launch_bounds__(512) k_down(const bf16* act, const unsigned* cnt, const int* ltok, const float* lw, const float* wd, const float* wsd, bf16* yslot) {
    __shared__ __attribute__((aligned(16))) float sm[NG_SM];
    __shared__ int stok[64]; __shared__ float sw[64];
    const int R0 = (blockIdx.x / 16) * 64, n0 = (blockIdx.x % 16) * 128;
    int local, count; const int e = find_expert(cnt, R0, local, count);
    if (e < 0 || local >= count) return;
    if (threadIdx.x < 64) { int r = local + threadIdx.x; stok[threadIdx.x] = r < count ? ltok[e * M + r] : -1; sw[threadIdx.x] = r < count ? lw[e * M + r] : 0.f; }
    __syncthreads();
    const float* W = e < 64 ? wd + (size_t)e * EH * D : wsd;
    ngemm_tile(sm, EH,
        [&](int r, int k) { return bf2f(act[(size_t)(R0 + r) * EH + k]); },
        [&](int k, int c) { return W[(size_t)k * D + n0 + c]; },
        [&](int r0, int c0, const float (&acc)[4][4]) {
#pragma unroll
            for (int i = 0; i < 4; ++i) { int tk = stok[r0 + i]; if (tk < 0) continue; float w = sw[r0 + i];
                bf16* o = yslot + ((size_t)(tk >> 4) * 9 + (tk & 15)) * D + n0 + c0;
                ushort4 v; v.x = f2bf(acc[i][0] * w); v.y = f2bf(acc[i][1] * w); v.z = f2bf(acc[i][2] * w); v.w = f2bf(acc[i][3] * w); *(ushort4*)o = v; }
        });
}
__global__ void k_final(const float* x1, const bf16* yslot, const float* mod, const float* gout, float* out) {
    int wave = threadIdx.x >> 6, lane = threadIdx.x & 63;
    int m = blockIdx.x * (blockDim.x >> 6) + wave; if (m >= M) return;
    const float* gate = mod + (m / T) * 6 * D + 5 * D;
    float4 v[8]; float s = 0.f;
#pragma unroll
    for (int j = 0; j < 8; ++j) {
        int col = (lane + 64 * j) * 4;
        float y0 = 0.f, y1 = 0.f, y2 = 0.f, y3 = 0.f;
#pragma unroll
        for (int k = 0; k < 9; ++k) { ushort4 u = *(const ushort4*)(yslot + ((size_t)m * 9 + k) * D + col); y0 += bf2f(u.x); y1 += bf2f(u.y); y2 += bf2f(u.z); y3 += bf2f(u.w); }
        float4 xv = *(const float4*)(x1 + (size_t)m * D + col), g4 = *(const float4*)(gate + col);
        v[j] = make_float4(xv.x + g4.x * y0, xv.y + g4.y * y1, xv.z + g4.z * y2, xv.w + g4.w * y3);
        s += v[j].x * v[j].x + v[j].y * v[j].y + v[j].z * v[j].z + v[j].w * v[j].w;
    }
    s = wave_sum(s);
    float rstd = rsqrtf(s * (1.f / D) + NORM_EPS);
#pragma unroll
    for (int j = 0; j < 8; ++j) { int col = (lane + 64 * j) * 4; float4 gg = *(const float4*)(gout + col);
        *(float4*)(out + (size_t)m * D + col) = make_float4(v[j].x * rstd * gg.x, v[j].y * rstd * gg.y, v[j].z * rstd * gg.z, v[j].w * rstd * gg.w); }
}
}

extern "C" void kernel_launch(void* const* d_in, const int* in_sizes, int n_in, void* d_out, int out_size, void* d_ws, size_t ws_size, hipStream_t stream) {
    if (n_in != 18 || ws_size < WS_END) { fprintf(stderr, "kernel_launch: bad args n_in %d ws %zu\n", n_in, ws_size); return; }
    const float* x = (const float*)d_in[0]; const float* c = (const float*)d_in[1]; const int* pos = (const int*)d_in[2];
    const float* w_ada = (const float*)d_in[3]; const float* b_ada = (const float*)d_in[4];
    const float* norm_mix = (const float*)d_in[5]; const float* norm_ffn = (const float*)d_in[6]; const float* norm_out = (const float*)d_in[7];
    const float* w_in = (const float*)d_in[8]; const float* w_out = (const float*)d_in[9]; const float* w_router = (const float*)d_in[10]; const float* rbias = (const float*)d_in[11];
    const float* w_gate = (const float*)d_in[12]; const float* w_up = (const float*)d_in[13]; const float* w_down = (const float*)d_in[14];
    const float* ws_gate = (const float*)d_in[15]; const float* ws_up = (const float*)d_in[16]; const float* ws_down = (const float*)d_in[17];
    unsigned char* ws = (unsigned char*)d_ws;
    unsigned* ctl = (unsigned*)(ws + WS_CTL); float* mod = (float*)(ws + WS_MOD); float* kmean = (float*)(ws + WS_KMEAN); float* rstd = (float*)(ws + WS_RSTD);
    int* ltok = (int*)(ws + WS_LTOK); float* lw = (float*)(ws + WS_LW); float2* ropem = (float2*)(ws + WS_ROPEM); float2* roper = (float2*)(ws + WS_ROPER);
    float* logits = (float*)(ws + WS_LOGITS); float* x1 = (float*)(ws + WS_X1); bf16* xn = (bf16*)(ws + WS_XN); bf16* act = (bf16*)(ws + WS_ACT);
    bf16* proj = (bf16*)(ws + WS_PROJ); bf16* mix = (bf16*)(ws + WS_MIX); bf16* yslot = (bf16*)(ws + WS_YSLOT); float* projf = (float*)(ws + WS_PROJF);
    const size_t PS = (size_t)M * 1024;
    (void)hipMemsetAsync(ws + WS_CTL, 0, CTL_ZERO_BYTES, stream);
    nv::k_rope<<<(M * 128 + 255) / 256, 256, 0, stream>>>(pos, ropem, roper);
    nv::k_mod<<<6 * D / 256, 256, 0, stream>>>(c, w_ada, b_ada, mod);
    nv::k_norm_mod<<<M / 8, 512, 0, stream>>>(x, norm_mix, mod, 0, D, xn, nullptr);
    nv::k_proj<<<(M / 64) * (NPROJ / 128), 512, 0, stream>>>(xn, w_in, projf);
    nv::k_rot<<<(unsigned)(((size_t)M * NPROJ + 255) / 256), 256, 0, stream>>>(projf, ropem, roper, proj);
    nv::k_kmean<<<NB * 16 * 1024 / 256, 256, 0, stream>>>(proj + PS, kmean);
    nv::k_moba<<<M, 512, 0, stream>>>(proj, proj + PS, proj + 2 * PS, kmean, mix);
    nv::k_ret<<<M / 2, 512, 0, stream>>>(proj + 3 * PS, proj + 4 * PS, proj + 5 * PS, proj + 6 * PS, mix);
    nv::k_outproj<<<(M / 64) * (D / 128), 512, 0, stream>>>(mix, w_out, x, mod, x1);
    nv::k_norm_mod<<<M / 8, 512, 0, stream>>>(x1, norm_ffn, mod, 3 * D, 4 * D, xn, rstd);
    nv::k_logits<<<M / 64, 512, 0, stream>>>(x1, rstd, norm_ffn, mod, w_router, logits);
    nv::k_route<<<M / 8, 512, 0, stream>>>(logits, rbias, ctl + CW_CNT, ltok, lw);
    const int max_rt = (M * 9 + 65 * 256) / 64;
    nv::k_gateup<<<max_rt * 8, 512, 0, stream>>>(xn, ctl + CW_CNT, ltok, w_gate, w_up, ws_gate, ws_up, act);
    nv::k_down<<<max_rt * 16, 512, 0, stream>>>(act, ctl + CW_CNT, ltok, lw, w_down, ws_down, yslot);
    nv::k_final<<<M / 8, 512, 0, stream>>>(x1, yslot, mod, norm_out, (float*)d_out);
}
```

```cpp
#include <hip/hip_runtime.h>
#include <cstdio>
#include <cstdint>

constexpr int NB = 2, T = 4096, D = 2048, M = NB * T;
constexpr int NPROJ = 7168;
constexpr int NE = 64, EH = 512;
constexpr float NORM_EPS = 1e-6f;
constexpr float NEGF = -1e30f;

constexpr size_t MiB = 1u << 20;
constexpr size_t WS_CTL = 0, CTL_ZERO_BYTES = 1 * MiB;
constexpr size_t WS_KMEAN = 512 * 1024;
constexpr size_t WS_MODP = 1 * MiB;
constexpr size_t WS_MOD = 3 * MiB;
constexpr size_t WS_RSTD = 5 * MiB;
constexpr size_t WS_LTOK = 6 * MiB;
constexpr size_t WS_LW = 9 * MiB;
constexpr size_t WS_ROPEM = 12 * MiB;
constexpr size_t WS_ROPER = 13 * MiB;
constexpr size_t WS_LOGITS = 21 * MiB;
constexpr size_t WS_WGU = 24 * MiB;
constexpr size_t WS_WD = 284 * MiB;
constexpr size_t WS_X1 = 414 * MiB;
constexpr size_t WS_XN = 478 * MiB;
constexpr size_t WS_ACT = 510 * MiB;
constexpr size_t WS_WIN = 600 * MiB;
constexpr size_t WS_WOUT = 628 * MiB;
constexpr size_t WS_PROJ = 636 * MiB;
constexpr size_t WS_MIX = 748 * MiB;
constexpr size_t WS_U = 780 * MiB;
constexpr size_t WS_S = 844 * MiB;
constexpr size_t WS_YSLOT = 600 * MiB;
constexpr size_t WS_PROJF = 780 * MiB;
constexpr size_t WS_END = 1024 * MiB;
constexpr int CW_CNT = 1024;
constexpr int CW_BAR = 4096;

typedef unsigned short bf16;
__device__ __forceinline__ float bf2f(bf16 v) { return __uint_as_float(((unsigned)v) << 16); }
__device__ __forceinline__ bf16 f2bf(float f) { unsigned u = __float_as_uint(f); return (bf16)((u + 0x7fffu + ((u >> 16) & 1u)) >> 16); }
__device__ __forceinline__ float wave_sum(float v) {
#pragma unroll
    for (int o = 1; o < 64; o <<= 1) v += __shfl_xor(v, o);
    return v;
}
__device__ __forceinline__ float wave_max(float v) {
#pragma unroll
    for (int o = 1; o < 64; o <<= 1) v = fmaxf(v, __shfl_xor(v, o));
    return v;
}
__device__ __forceinline__ float silu_f(float x) { return x / (1.f + __expf(-x)); }

namespace nv {

__global__ void k_rope(const int* pos, float2* ropem, float2* roper) {
    int i = blockIdx.x * blockDim.x + threadIdx.x;
    if (i < M * 16) { int m = i >> 4, f = i & 15; double inv = pow(500000.0, -(double)f / 16.0); double a = (double)pos[m] * inv; ropem[i] = make_float2((float)cos(a), (float)sin(a)); }
    if (i < M * 128) { int m = i >> 7, f = i & 127; double inv = pow(10000.0, -(double)f / 127.0); double a = (double)pos[m] * inv; roper[i] = make_float2((float)cos(a), (float)sin(a)); }
}
__global__ void k_mod(const float* c, const float* w_ada, const float* b_ada, float* mod) {
    __shared__ float sc[2][D];
    for (int i = threadIdx.x; i < 2 * D; i += blockDim.x) sc[i / D][i % D] = silu_f(c[i]);
    __syncthreads();
    int n = blockIdx.x * blockDim.x + threadIdx.x;
    if (n >= 6 * D) return;
    float a0 = 0.f, a1 = 0.f;
    for (int k = 0; k < D; ++k) { float w = w_ada[(size_t)k * (6 * D) + n]; a0 += sc[0][k] * w; a1 += sc[1][k] * w; }
    mod[n] = a0 + b_ada[n]; mod[6 * D + n] = a1 + b_ada[n];
}
__global__ void k_norm_mod(const float* x, const float* g, const float* mod, int shift_off, int scale_off, bf16* xn, float* rstd_out) {
    int wave = threadIdx.x >> 6, lane = threadIdx.x & 63;
    int m = blockIdx.x * (blockDim.x >> 6) + wave; if (m >= M) return;
    int b = m / T;
    const float4* xr = (const float4*)(x + (size_t)m * D);
    float4 v[8]; float s = 0.f;
#pragma unroll
    for (int j = 0; j < 8; ++j) { v[j] = xr[lane + 64 * j]; s += v[j].x * v[j].x + v[j].y * v[j].y + v[j].z * v[j].z + v[j].w * v[j].w; }
    s = wave_sum(s);
    float rstd = rsqrtf(s * (1.f / D) + NORM_EPS);
    if (rstd_out && lane == 0) rstd_out[m] = rstd;
    const float* sh = mod + b * 6 * D + shift_off; const float* scv = mod + b * 6 * D + scale_off;
#pragma unroll
    for (int j = 0; j < 8; ++j) {
        int col = (lane + 64 * j) * 4;
        float4 gg = *(const float4*)(g + col), s4 = *(const float4*)(scv + col), h4 = *(const float4*)(sh + col);
        float o0 = v[j].x * rstd * gg.x * (1.f + s4.x) + h4.x, o1 = v[j].y * rstd * gg.y * (1.f + s4.y) + h4.y;
        float o2 = v[j].z * rstd * gg.z * (1.f + s4.z) + h4.z, o3 = v[j].w * rstd * gg.w * (1.f + s4.w) + h4.w;
        ushort4 o; o.x = f2bf(o0); o.y = f2bf(o1); o.z = f2bf(o2); o.w = f2bf(o3);
        *(ushort4*)(xn + (size_t)m * D + col) = o;
    }
}

template <class FA, class FB, class FE>
__device__ __forceinline__ void ngemm_tile(float* sm, int K, FA fa, FB fb, FE fe) {
    float* As = sm; float* Bs = sm + 16 * 68;
    const int tid = threadIdx.x, ty = tid >> 5, tx = tid & 31;
    float acc[4][4];
#pragma unroll
    for (int i = 0; i < 4; ++i)
#pragma unroll
        for (int j = 0; j < 4; ++j) acc[i][j] = 0.f;
    for (int k0 = 0; k0 < K; k0 += 16) {
#pragma unroll
        for (int i = tid; i < 1024; i += 512) { int r = i >> 4, k = i & 15; As[k * 68 + r] = fa(r, k0 + k); }
#pragma unroll
        for (int i = tid; i < 2048; i += 512) { int k = i >> 7, c = i & 127; Bs[k * 132 + c] = fb(k0 + k, c); }
        __syncthreads();
#pragma unroll
        for (int k = 0; k < 16; ++k) {
            float4 a = *(float4*)&As[k * 68 + ty * 4]; float4 b = *(float4*)&Bs[k * 132 + tx * 4];
            float av[4] = {a.x, a.y, a.z, a.w}, bv[4] = {b.x, b.y, b.z, b.w};
#pragma unroll
            for (int i = 0; i < 4; ++i)
#pragma unroll
                for (int j = 0; j < 4; ++j) acc[i][j] += av[i] * bv[j];
        }
        __syncthreads();
    }
    fe(ty * 4, tx * 4, acc);
}
constexpr int NG_SM = 16 * 68 + 16 * 132;

__global__ void __launch_bounds__(512) k_proj(const bf16* xn, const float* w_in, float* projf) {
    __shared__ __attribute__((aligned(16))) float sm[NG_SM];
    const int m0 = (blockIdx.x / (NPROJ / 128)) * 64, n0 = (blockIdx.x % (NPROJ / 128)) * 128;
    ngemm_tile(sm, D,
        [&](int r, int k) { return bf2f(xn[(size_t)(m0 + r) * D + k]); },
        [&](int k, int c) { return w_in[(size_t)k * NPROJ + n0 + c]; },
        [&](int r0, int c0, const float (&acc)[4][4]) {
#pragma unroll
            for (int i = 0; i < 4; ++i) *(float4*)(projf + (size_t)(m0 + r0 + i) * NPROJ + n0 + c0) = make_float4(acc[i][0], acc[i][1], acc[i][2], acc[i][3]);
        });
}
__global__ void k_rot(const float* projf, const float2* ropem, const float2* roper, bf16* proj) {
    size_t i = (size_t)blockIdx.x * blockDim.x + threadIdx.x;
    if (i >= (size_t)M * NPROJ) return;
    int m = (int)(i / NPROJ), col = (int)(i % NPROJ), t = col >> 10, cc = col & 1023;
    const float* row = projf + (size_t)m * NPROJ;
    float x = row[col], val = x;
    if (t == 0 || t == 1) {
        int d = cc & 127;
        if (d < 32) { int f = d & 15; float2 cs = ropem[m * 16 + f]; float xp = row[col + (d < 16 ? 16 : -16)]; val = d < 16 ? x * cs.x - xp * cs.y : x * cs.x + xp * cs.y; }
    } else if (t == 3 || t == 4) {
        int d = cc & 255, f = d & 127; float2 cs = roper[m * 128 + f]; float xp = row[col + (d < 128 ? 128 : -128)];
        val = d < 128 ? x * cs.x - xp * cs.y : x * cs.x + xp * cs.y;
        if (t == 4) val *= 0.0625f;
    }
    proj[(size_t)t * M * 1024 + (size_t)m * 1024 + cc] = f2bf(val);
}
__global__ void k_kmean(const bf16* ka, float* kmean) {
    int i = blockIdx.x * blockDim.x + threadIdx.x; if (i >= NB * 16 * 1024) return;
    int col = i & 1023, bb = i >> 10;
    float s = 0.f;
    for (int r = 0; r < 256; ++r) s += bf2f(ka[(size_t)(bb * 256 + r) * 1024 + col]);
    kmean[i] = s * (1.f / 256.f);
}
__global__ void __launch_bounds__(512) k_moba(const bf16* qa, const bf16* ka, const bf16* va, const float* kmean, bf16* mix) {
    __shared__ float sq[8][128];
    __shared__ float sp[8][1024];
    __shared__ float sg[8][16];
    const int m = blockIdx.x, h = threadIdx.x >> 6, lane = threadIdx.x & 63;
    const int b = m / T, t = m % T, qb = t >> 8;
    float q0 = bf2f(qa[(size_t)m * 1024 + h * 128 + lane]), q1 = bf2f(qa[(size_t)m * 1024 + h * 128 + lane + 64]);
    sq[h][lane] = q0; sq[h][lane + 64] = q1;
    for (int n = 0; n < qb; ++n) {
        const float* km = kmean + ((size_t)(b * 16 + n) * 1024 + h * 128);
        float g = wave_sum(q0 * km[lane] + q1 * km[lane + 64]);
        if (lane == 0) sg[h][n] = g;
    }
    __syncthreads();
    int sel[4]; bool val[4];
    {
        unsigned chosen = 0u;
#pragma unroll
        for (int s = 0; s < 3; ++s) {
            float best = -3e38f; int bi = -1;
            for (int n = 0; n < qb; ++n) if (!((chosen >> n) & 1u) && sg[h][n] > best) { best = sg[h][n]; bi = n; }
            val[s] = bi >= 0; sel[s] = bi >= 0 ? bi : 0; if (bi >= 0) chosen |= 1u << bi;
        }
        sel[3] = qb; val[3] = true;
    }
    const float scale = 0.08838834764831845f;
    float sc[4][4]; float mx = -3e38f;
#pragma unroll
    for (int j = 0; j < 4; ++j)
#pragma unroll
        for (int i = 0; i < 4; ++i) {
            float s = NEGF;
            if (val[j]) {
                int key = sel[j] * 256 + lane + 64 * i;
                if (j < 3 || key <= t) {
                    const uint4* kr = (const uint4*)(ka + (size_t)(b * T + key) * 1024 + h * 128);
                    float a = 0.f;
#pragma unroll 4
                    for (int c = 0; c < 16; ++c) { uint4 kk = kr[c]; const float* qq = &sq[h][c * 8];
                        a += qq[0] * __uint_as_float(kk.x << 16) + qq[1] * __uint_as_float(kk.x & 0xffff0000u) + qq[2] * __uint_as_float(kk.y << 16) + qq[3] * __uint_as_float(kk.y & 0xffff0000u)
                           + qq[4] * __uint_as_float(kk.z << 16) + qq[5] * __uint_as_float(kk.z & 0xffff0000u) + qq[6] * __uint_as_float(kk.w << 16) + qq[7] * __uint_as_float(kk.w & 0xffff0000u); }
                    s = a * scale;
                }
            }
            sc[j][i] = s; mx = fmaxf(mx, s);
        }
    mx = wave_max(mx);
    float sum = 0.f;
#pragma unroll
    for (int j = 0; j < 4; ++j)
#pragma unroll
        for (int i = 0; i < 4; ++i) { float p = __expf(sc[j][i] - mx); sc[j][i] = p; sum += p; }
    sum = wave_sum(sum);
    const float inv = 1.f / sum;
#pragma unroll
    for (int j = 0; j < 4; ++j)
#pragma unroll
        for (int i = 0; i < 4; ++i) sp[h][j * 256 + lane + 64 * i] = sc[j][i] * inv;
    __syncthreads();
    float o0 = 0.f, o1 = 0.f;
#pragma unroll
    for (int j = 0; j < 4; ++j) {
        if (!val[j]) continue;
        const int nk = (j < 3) ? 256 : (t & 255) + 1;
        const bf16* vb = va + (size_t)(b * T + sel[j] * 256) * 1024 + h * 128;
        for (int i = 0; i < nk; ++i) { float p = sp[h][j * 256 + i]; o0 += p * bf2f(vb[(size_t)i * 1024 + lane]); o1 += p * bf2f(vb[(size_t)i * 1024 + lane + 64]); }
    }
    mix[(size_t)m * D + h * 128 + lane] = f2bf(o0); mix[(size_t)m * D + h * 128 + lane + 64] = f2bf(o1);
}
__global__ void __launch_bounds__(512) k_ret(const bf16* qr, const bf16* kr, const bf16* vr, const bf16* gr, bf16* mix) {
    __shared__ float sq[8][256];
    __shared__ float sp[8][1024];
    const int w = threadIdx.x >> 6, lane = threadIdx.x & 63;
    const int m = blockIdx.x * 2 + (w >> 2), h = w & 3, b = m / T, t = m % T;
    for (int j = 0; j < 4; ++j) sq[w][lane + 64 * j] = bf2f(qr[(size_t)m * 1024 + h * 256 + lane + 64 * j]);
    __syncthreads();
    const float gamma = 1.f - exp2f(-5.f - (float)h), lg2 = log2f(gamma);
    float o[4] = {0.f, 0.f, 0.f, 0.f};
    for (int s0 = 0; s0 <= t; s0 += 1024) {
        const int send = min(s0 + 1023, t);
        if ((float)(t - send) * lg2 < -100.f) continue;
#pragma unroll 1
        for (int i = 0; i < 16; ++i) {
            int s = s0 + lane + 64 * i; float p = 0.f;
            if (s <= t) {
                const uint4* kk4 = (const uint4*)(kr + (size_t)(b * T + s) * 1024 + h * 256);
                float a = 0.f;
#pragma unroll 4
                for (int c = 0; c < 32; ++c) { uint4 kk = kk4[c]; const float* qq = &sq[w][c * 8];
                    a += qq[0] * __uint_as_float(kk.x << 16) + qq[1] * __uint_as_float(kk.x & 0xffff0000u) + qq[2] * __uint_as_float(kk.y << 16) + qq[3] * __uint_as_float(kk.y & 0xffff0000u)
                       + qq[4] * __uint_as_float(kk.z << 16) + qq[5] * __uint_as_float(kk.z & 0xffff0000u) + qq[6] * __uint_as_float(kk.w << 16) + qq[7] * __uint_as_float(kk.w & 0xffff0000u); }
                p = a * exp2f((float)(t - s) * lg2);
            }
            sp[w][lane + 64 * i] = p;
        }
        __builtin_amdgcn_wave_barrier();
        const int nk = send - s0 + 1;
        const bf16* vb = vr + (size_t)(b * T + s0) * 1024 + h * 256;
        for (int i = 0; i < nk; ++i) { float p = sp[w][i];
#pragma unroll
            for (int j = 0; j < 4; ++j) o[j] += p * bf2f(vb[(size_t)i * 1024 + lane + 64 * j]); }
        __builtin_amdgcn_wave_barrier();
    }
    float mu = wave_sum(o[0] + o[1] + o[2] + o[3]) * (1.f / 256.f);
    float vs = 0.f;
#pragma unroll
    for (int j = 0; j < 4; ++j) { o[j] -= mu; vs += o[j] * o[j]; }
    float rs = rsqrtf(wave_sum(vs) * (1.f / 256.f) + NORM_EPS);
#pragma unroll
    for (int j = 0; j < 4; ++j) { float g = bf2f(gr[(size_t)m * 1024 + h * 256 + lane + 64 * j]); mix[(size_t)m * D + 1024 + h * 256 + lane + 64 * j] = f2bf(o[j] * rs * silu_f(g)); }
}
__global__ void __launch_bounds__(512) k_outproj(const bf16* mix, const float* w_out, const float* x, const float* mod, float* x1) {
    __shared__ __attribute__((aligned(16))) float sm[NG_SM];
    const int m0 = (blockIdx.x / (D / 128)) * 64, n0 = (blockIdx.x % (D / 128)) * 128;
    const float* gate = mod + (m0 / T) * 6 * D + 2 * D;
    ngemm_tile(sm, D,
        [&](int r, int k) { return bf2f(mix[(size_t)(m0 + r) * D + k]); },
        [&](int k, int c) { return w_out[(size_t)k * D + n0 + c]; },
        [&](int r0, int c0, const float (&acc)[4][4]) {
#pragma unroll
            for (int i = 0; i < 4; ++i) { size_t off = (size_t)(m0 + r0 + i) * D + n0 + c0; float4 xv = *(const float4*)(x + off), g4 = *(const float4*)(gate + n0 + c0);
                *(float4*)(x1 + off) = make_float4(xv.x + g4.x * acc[i][0], xv.y + g4.y * acc[i][1], xv.z + g4.z * acc[i][2], xv.w + g4.w * acc[i][3]); }
        });
}
__global__ void __launch_bounds__(512) k_logits(const float* x1, const float* rstd, const float* g, const float* mod, const float* w_router, float* logits) {
    __shared__ __attribute__((aligned(16))) float sm[NG_SM];
    const int m0 = blockIdx.x * 64, b = m0 / T;
    const float* sh = mod + b * 6 * D + 3 * D; const float* scv = mod + b * 6 * D + 4 * D;
    ngemm_tile(sm, D,
        [&](int r, int k) { return x1[(size_t)(m0 + r) * D + k] * rstd[m0 + r] * g[k] * (1.f + scv[k]) + sh[k]; },
        [&](int k, int c) { return c < 64 ? w_router[(size_t)k * 64 + c] : 0.f; },
        [&](int r0, int c0, const float (&acc)[4][4]) {
            if (c0 < 64) {
#pragma unroll
                for (int i = 0; i < 4; ++i) *(float4*)(logits + (size_t)(m0 + r0 + i) * 64 + c0) = make_float4(acc[i][0], acc[i][1], acc[i][2], acc[i][3]); }
        });
}
__global__ void k_route(const float* logits, const float* bias, unsigned* cnt, int* ltok, float* lw) {
    const int wave = threadIdx.x >> 6, lane = threadIdx.x & 63;
    const int m = blockIdx.x * (blockDim.x >> 6) + wave; if (m >= M) return;
    const float lg = logits[(size_t)m * 64 + lane];
    const float score = 1.f / (1.f + __expf(-lg));
    const float biased = score + bias[lane];
    float m1 = biased;
    m1 = fmaxf(m1, __shfl_xor(m1, 1)); m1 = fmaxf(m1, __shfl_xor(m1, 2)); m1 = fmaxf(m1, __shfl_xor(m1, 4));
    unsigned long long eq = __ballot(biased == m1);
    unsigned gb = (unsigned)(eq >> (lane & ~7)) & 0xffu;
    int first = __ffs(gb) - 1;
    float v2 = ((lane & 7) == first) ? -3e38f : biased;
    v2 = fmaxf(v2, __shfl_xor(v2, 1)); v2 = fmaxf(v2, __shfl_xor(v2, 2)); v2 = fmaxf(v2, __shfl_xor(v2, 4));
    const float gs = m1 + v2; const int g = lane >> 3;
    int grank = 0;
#pragma unroll
    for (int j = 0; j < 8; ++j) { float o = __shfl(gs, j * 8); grank += (o > gs || (o == gs && j < g)) ? 1 : 0; }
    const float masked = grank < 4 ? biased : NEGF;
    int rank = 0;
#pragma unroll
    for (int j = 0; j < 64; ++j) { float o = __shfl(masked, j); rank += (o > masked || (o == masked && j < lane)) ? 1 : 0; }
    const bool selx = rank < 8;
    const float ssum = wave_sum(selx ? score : 0.f);
    if (selx) {
        unsigned pos = atomicAdd(&cnt[lane], 1u);
        ltok[lane * M + pos] = m * 16 + rank; lw[lane * M + pos] = score / ssum * 2.5f;
    }
    if (lane == 0) { ltok[64 * M + m] = m * 16 + 8; lw[64 * M + m] = 1.f; }
}
__device__ __forceinline__ int expert_count(const unsigned* cnt, int e) { return e < 64 ? (int)cnt[e] : M; }
__device__ __forceinline__ int find_expert(const unsigned* cnt, int R0, int& local, int& count) {
    int start = 0;
    for (int e = 0; e < 65; ++e) { int c = expert_count(cnt, e); int pc = (c + 255) / 256 * 256; if (R0 < start + pc) { local = R0 - start; count = c; return e; } start += pc; }
    return -1;
}
__global__ void __launch_bounds__(512) k_gateup(const bf16* xn, const unsigned* cnt, const int* ltok, const float* wg, const float* wu, const float* wsg, const float* wsu, bf16* act) {
    __shared__ __attribute__((aligned(16))) float sm[NG_SM];
    __shared__ int stok[64];
    const int R0 = (blockIdx.x / 8) * 64, j0 = (blockIdx.x % 8) * 64;
    int local, count; const int e = find_expert(cnt, R0, local, count);
    if (e < 0 || local >= count) return;
    if (threadIdx.x < 64) { int r = local + threadIdx.x; stok[threadIdx.x] = r < count ? (ltok[e * M + r] >> 4) : (ltok[e * M + count - 1] >> 4); }
    __syncthreads();
    const float* G = e < 64 ? wg + (size_t)e * D * EH : wsg; const float* U = e < 64 ? wu + (size_t)e * D * EH : wsu;
    ngemm_tile(sm, D,
        [&](int r, int k) { return bf2f(xn[(size_t)stok[r] * D + k]); },
        [&](int k, int c) { return (c & 1) ? U[(size_t)k * EH + j0 + (c >> 1)] : G[(size_t)k * EH + j0 + (c >> 1)]; },
        [&](int r0, int c0, const float (&acc)[4][4]) {
#pragma unroll
            for (int i = 0; i < 4; ++i) { bf16* o = act + (size_t)(R0 + r0 + i) * EH + j0 + (c0 >> 1);
                o[0] = f2bf(silu_f(acc[i][0]) * acc[i][1]); o[1] = f2bf(silu_f(acc[i][2]) * acc[i][3]); }
        });
}
__global__ void __launch_bounds__(512) k_down(const bf16* act, const unsigned* cnt, const int* ltok, const float* lw, const float* wd, const float* wsd, bf16* yslot) {
    __shared__ __attribute__((aligned(16))) float sm[NG_SM];
    __shared__ int stok[64]; __shared__ float sw[64];
    const int R0 = (blockIdx.x / 16) * 64, n0 = (blockIdx.x % 16) * 128;
    int local, count; const int e = find_expert(cnt, R0, local, count);
    if (e < 0 || local >= count) return;
    if (threadIdx.x < 64) { int r = local + threadIdx.x; stok[threadIdx.x] = r < count ? ltok[e * M + r] : -1; sw[threadIdx.x] = r < count ? lw[e * M + r] : 0.f; }
    __syncthreads();
    const float* W = e < 64 ? wd + (size_t)e * EH * D : wsd;
    ngemm_tile(sm, EH,
        [&](int r, int k) { return bf2f(act[(size_t)(R0 + r) * EH + k]); },
        [&](int k, int c) { return W[(size_t)k * D + n0 + c]; },
        [&](int r0, int c0, const float (&acc)[4][4]) {
#pragma unroll
            for (int i = 0; i < 4; ++i) { int tk = stok[r0 + i]; if (tk < 0) continue; float w = sw[r0 + i];
                bf16* o = yslot + ((size_t)(tk >> 4) * 9 + (tk & 15)) * D + n0 + c0;
                ushort4 v; v.x = f2bf(acc[i][0] * w); v.y = f2bf(acc[i][1] * w); v.z = f2bf(acc[i][2] * w); v.w = f2bf(acc[i][3] * w); *(ushort4*)o = v; }
        });
}
__global__ void k_final(const float* x1, const bf16* yslot, const float* mod, const float* gout, float* out) {
    int wave = threadIdx.x >> 6, lane = threadIdx.x & 63;
    int m = blockIdx.x * (blockDim.x >> 6) + wave; if (m >= M) return;
    const float* gate = mod + (m / T) * 6 * D + 5 * D;
    float4 v[8]; float s = 0.f;
#pragma unroll
    for (int j = 0; j < 8; ++j) {
        int col = (lane + 64 * j) * 4;
        float y0 = 0.f, y1 = 0.f, y2 = 0.f, y3 = 0.f;
#pragma unroll
        for (int k = 0; k < 9; ++k) { ushort4 u = *(const ushort4*)(yslot + ((size_t)m * 9 + k) * D + col); y0 += bf2f(u.x); y1 += bf2f(u.y); y2 += bf2f(u.z); y3 += bf2f(u.w); }
        float4 xv = *(const float4*)(x1 + (size_t)m * D + col), g4 = *(const float4*)(gate + col);
        v[j] = make_float4(xv.x + g4.x * y0, xv.y + g4.y * y1, xv.z + g4.z * y2, xv.w + g4.w * y3);
        s += v[j].x * v[j].x + v[j].y * v[j].y + v[j].z * v[j].z + v[j].w * v[j].w;
    }
    s = wave_sum(s);
    float rstd = rsqrtf(s * (1.f / D) + NORM_EPS);
#pragma unroll
    for (int j = 0; j < 8; ++j) { int col = (lane + 64 * j) * 4; float4 gg = *(const float4*)(gout + col);
        *(float4*)(out + (size_t)m * D + col) = make_float4(v[j].x * rstd * gg.x, v[j].y * rstd * gg.y, v[j].z * rstd * gg.z, v[j].w * rstd * gg.w); }
}
}

#define LAS __attribute__((address_space(3)))
#define GAS __attribute__((address_space(1)))
namespace pg8 {
typedef unsigned short bf16_t;
typedef short bf16x8 __attribute__((ext_vector_type(8)));
typedef float f32x4 __attribute__((ext_vector_type(4)));
typedef unsigned u32x4 __attribute__((ext_vector_type(4)));
constexpr int BM = 256, BK = 64, HALF = 128, HTB = HALF * BK * 2, STAGE_BYTES = 8 * HTB, NXCD = 8, WGM = 8;

__host__ __device__ __forceinline__ int lds_byte(int r, int c) { const int st = (r >> 4) * 2 + (c >> 5), rr = r & 15, cc = c & 31, ob = rr * 64 + cc * 2; return st * 1024 + (ob ^ (((ob >> 9) & 1) << 5)); }
__host__ __device__ __forceinline__ void stage_rc(int b, int& R, int& C) { const int st = b / 1024, sb = b % 1024, swz = sb ^ (((sb >> 9) & 1) << 5); R = (st >> 1) * 16 + swz / 64; C = (st & 1) * 32 + (swz % 64) / 2; }
__host__ __device__ __forceinline__ int perm32(int rho) { const int n = rho >> 4, i = rho & 15; return 8 * (i >> 2) + 4 * n + (i & 3); }

struct Unit { int pm, pn, pb, e, r0, cnt; };
struct Gemm { const bf16_t* A; const bf16_t* Bt; int K; };

__device__ __forceinline__ void tile_of(int L, int nM, int nN, int& pm, int& pn) {
    const int nwg = nM * nN; int wgid = L;
    { const int q = nwg / NXCD, r = nwg % NXCD, xcd = wgid % NXCD, off = wgid / NXCD; wgid = (xcd < r ? xcd * (q + 1) : r * (q + 1) + (xcd - r) * q) + off; }
    const int nig = WGM * nN, gid = wgid / nig, fm = gid * WGM, gsz = (nM - fm) < WGM ? (nM - fm) : WGM;
    pm = fm + ((wgid % nig) % gsz); pn = (wgid % nig) / gsz;
}
struct StaticOrder {
    int nM, nN, nwg, G, c;
    __device__ __forceinline__ void init(int Mrows, int N, int G_, int c_) { nM = Mrows / BM; nN = N / BM; nwg = nM * nN; G = G_; c = c_; }
    __device__ __forceinline__ bool next(int i, Unit& u) const {
        const int L = i * G + c; if (L >= nwg) return false;
        tile_of(L, nM, nN, u.pm, u.pn); u.pb = u.pn; u.e = 0; u.r0 = 0; u.cnt = 256; return true;
    }
    __device__ __forceinline__ void rows(const Unit&, const int*& lp, int& cnt) const { lp = nullptr; cnt = 256; }
};
struct MoeOrder {
    int nM, nN, nwg, G, c; const LAS int* tile_e; const LAS int* tile_start; const LAS int* ecount; const int* ltok;
    __device__ __forceinline__ bool next(int i, Unit& u) const {
        const int L = i * G + c; if (L >= nwg) return false;
        tile_of(L, nM, nN, u.pm, u.pn);
        const int e = tile_e[u.pm], jl = u.pm - tile_start[e], rem = ecount[e] - jl * 256;
        u.e = e; u.r0 = jl * 256; u.cnt = rem < 256 ? rem : 256; u.pb = e * nN + u.pn; return true;
    }
    __device__ __forceinline__ void rows(const Unit& u, const int*& lp, int& cnt) const { lp = ltok + (size_t)u.e * 8192 + u.r0; cnt = u.cnt; }
};

__device__ __forceinline__ unsigned cvt_pk_bf16(float lo, float hi) { unsigned r; asm volatile("v_cvt_pk_bf16_f32 %0, %1, %2" : "=v"(r) : "v"(lo), "v"(hi)); return r; }

template <class Epi, class Sched, bool GATHER, bool ALIGN_EPI>
__device__ __forceinline__ void gemm_phase(LAS unsigned char* lds, LAS unsigned char* tab, const Gemm g, const Sched& S, const Epi& E) {
    const int tid = threadIdx.x, wid = __builtin_amdgcn_readfirstlane(tid >> 6), lane = tid & 63, wr = wid >> 2, wc = wid & 3, fr = lane & 15, fq = lane >> 4;
    const int K = g.K, nt = K / BK;
    unsigned voffA[2][2], voffB[2];
#pragma unroll
    for (int i = 0; i < 2; ++i) { int R, C; stage_rc(tid * 16 + i * 8192, R, C); const int Rb = Epi::PERM ? ((R & ~31) + perm32(R & 31)) : R;
        voffA[0][i] = (unsigned)(R * K + C) * 2u; voffA[1][i] = (unsigned)((R + HALF) * K + C) * 2u; voffB[i] = (unsigned)(Rb * K + C) * 2u; }
    const size_t kstep = (size_t)(BK * 2);
    const size_t hstep = (size_t)HALF * K * 2;
    const size_t tstep = 2 * hstep;
    const unsigned ldsw = (unsigned)wid * 1024u;
    const int aoff = lds_byte(wr * 64 + fr, fq * 8), boff = lds_byte(wc * 32 + fr, fq * 8);
#define PG8_SA(b, h) (((b) * 2 + (h)) * HTB)
#define PG8_SB(b, h) ((4 + (b) * 2 + (h)) * HTB)
#define PG8_STAGE(bufoff, gbase, voff) do { _Pragma("unroll") for (int _i = 0; _i < 2; ++_i) \
        __builtin_amdgcn_global_load_lds((const unsigned*)((const char*)(gbase) + (voff)[_i]), (LAS unsigned*)(lds + (bufoff) + ldsw + _i * 8192), 16, 0, 0); } while (0)
#define PG8_LDA(dst, b, h) do { _Pragma("unroll") for (int m = 0; m < 4; ++m) _Pragma("unroll") for (int k = 0; k < 2; ++k) dst[m][k] = *(const LAS bf16x8*)(lds + PG8_SA(b, h) + aoff + m * 2048 + k * 1024); } while (0)
#define PG8_LDB(dst, b, h) do { _Pragma("unroll") for (int n = 0; n < 2; ++n) _Pragma("unroll") for (int k = 0; k < 2; ++k) dst[n][k] = *(const LAS bf16x8*)(lds + PG8_SB(b, h) + boff + n * 2048 + k * 1024); } while (0)
#define PG8_MMA(ai, bj, At, Bt) do { __builtin_amdgcn_s_setprio(1); _Pragma("unroll") for (int m = 0; m < 4; ++m) _Pragma("unroll") for (int n = 0; n < 2; ++n) _Pragma("unroll") for (int k = 0; k < 2; ++k) \
        acc[ai][bj][m][n] = __builtin_amdgcn_mfma_f32_16x16x32_bf16(Bt[n][k], At[m][k], acc[ai][bj][m][n], 0, 0, 0); __builtin_amdgcn_s_setprio(0); } while (0)
#define PG8_WAIT_V(n) asm volatile("s_waitcnt vmcnt(" #n ")" ::: "memory")
#define PG8_WAIT_L(n) asm volatile("s_waitcnt lgkmcnt(" #n ")" ::: "memory")
#define PG8_BAR __builtin_amdgcn_s_barrier()
#define PG8_SCHED __builtin_amdgcn_sched_barrier(0)
    Unit cur, nxt; int ui = 0;
    if (!S.next(0, cur)) return;
    if constexpr (GATHER) {
        const int* lp; int cnt; S.rows(cur, lp, cnt);
#pragma unroll
        for (int h = 0; h < 2; ++h)
#pragma unroll
            for (int i = 0; i < 2; ++i) { int R, C; stage_rc(tid * 16 + i * 8192, R, C); const int r = h * HALF + R; const int tk = r < cnt ? (lp[r] >> 4) : 0; voffA[h][i] = (unsigned)(tk * K + C) * 2u; }
    }
    f32x4 acc[2][2][4][2];
#pragma unroll
    for (int a = 0; a < 2; ++a)
#pragma unroll
        for (int b = 0; b < 2; ++b)
#pragma unroll
            for (int m = 0; m < 4; ++m)
#pragma unroll
                for (int n = 0; n < 2; ++n) acc[a][b][m][n] = (f32x4){0.f, 0.f, 0.f, 0.f};
    bf16x8 At[4][2], B0[2][2], B1[2][2];
    const char* cA = GATHER ? (const char*)g.A : (const char*)g.A + (size_t)cur.pm * tstep; const char* cB = (const char*)g.Bt + (size_t)cur.pb * tstep;
    PG8_STAGE(PG8_SB(0, 0), cB, voffB); PG8_STAGE(PG8_SB(0, 1), cB + hstep, voffB); PG8_STAGE(PG8_SA(0, 0), cA, voffA[0]); PG8_STAGE(PG8_SA(0, 1), cA, voffA[1]);
    if (wr == 1) PG8_BAR;
    PG8_WAIT_V(2); PG8_BAR;
    PG8_STAGE(PG8_SB(1, 0), cB + kstep, voffB); PG8_STAGE(PG8_SA(1, 0), cA + kstep, voffA[0]); PG8_STAGE(PG8_SB(1, 1), cB + hstep + kstep, voffB);
    PG8_WAIT_V(6); PG8_BAR;
    for (;;) {
        const bool has_next = S.next(ui + 1, nxt);
        int ncnt = 256;
        if constexpr (GATHER) { if (has_next) { const int* nlp; S.rows(nxt, nlp, ncnt);
            if (wid == 0) __builtin_amdgcn_global_load_lds((const unsigned*)(nlp + lane * 4), (LAS unsigned*)tab, 16, 0, 0); } }
        const char* nA = has_next ? (GATHER ? (const char*)g.A : (const char*)g.A + (size_t)nxt.pm * tstep) : cA; const char* nB = has_next ? (const char*)g.Bt + (size_t)nxt.pb * tstep : cB;
        for (int t = 0; t < nt; t += 2) {
            const bool last = (t == nt - 2);
            const char* a1 = cA + (size_t)(t + 1) * kstep;
            const char* a2 = last ? nA : cA + (size_t)(t + 2) * kstep; const char* b2 = last ? nB : cB + (size_t)(t + 2) * kstep;
            const char* a3 = a2 + kstep; const char* b3 = b2 + kstep;
            PG8_LDB(B0, 0, 0); PG8_LDB(B1, 0, 1); PG8_SCHED; PG8_LDA(At, 0, 0); PG8_STAGE(PG8_SA(1, 1), a1, voffA[1]);
            if constexpr (GATHER) { if (last && has_next) {
#pragma unroll
                for (int h = 0; h < 2; ++h)
#pragma unroll
                    for (int i = 0; i < 2; ++i) { int R, C; stage_rc(tid * 16 + i * 8192, R, C); const int r = h * HALF + R; const int v = ((const LAS int*)tab)[r]; const int tk = r < ncnt ? (v >> 4) : 0; voffA[h][i] = (unsigned)(tk * K + C) * 2u; } } }
            PG8_WAIT_V(8); PG8_WAIT_L(0); PG8_BAR; PG8_MMA(0, 0, At, B0); PG8_MMA(0, 1, At, B1); PG8_BAR; PG8_SCHED;
            PG8_LDA(At, 0, 1); PG8_STAGE(PG8_SB(0, 0), b2, voffB); PG8_STAGE(PG8_SB(0, 1), b2 + hstep, voffB); PG8_STAGE(PG8_SA(0, 0), a2, voffA[0]);
            PG8_WAIT_V(8); PG8_WAIT_L(0); PG8_BAR; PG8_MMA(1, 0, At, B0); PG8_MMA(1, 1, At, B1); PG8_BAR; PG8_SCHED;
            PG8_LDB(B0, 1, 0); PG8_LDB(B1, 1, 1); PG8_SCHED; PG8_LDA(At, 1, 0); PG8_STAGE(PG8_SA(0, 1), a2, voffA[1]);
            PG8_WAIT_V(8); PG8_WAIT_L(0); PG8_BAR; PG8_MMA(0, 0, At, B0); PG8_MMA(0, 1, At, B1); PG8_BAR; PG8_SCHED;
            PG8_LDA(At, 1, 1); PG8_STAGE(PG8_SB(1, 0), b3, voffB); PG8_STAGE(PG8_SB(1, 1), b3 + hstep, voffB); PG8_STAGE(PG8_SA(1, 0), a3, voffA[0]);
            PG8_WAIT_V(8); PG8_WAIT_L(0); PG8_BAR; PG8_MMA(1, 0, At, B0); PG8_MMA(1, 1, At, B1); PG8_BAR; PG8_SCHED;
        }
        if constexpr (ALIGN_EPI) { if (wr == 0) PG8_BAR; }
        E(acc, cur, wr, wc, fr, fq);
        if (!has_next) break;
#pragma unroll
        for (int a = 0; a < 2; ++a)
#pragma unroll
            for (int b = 0; b < 2; ++b)
#pragma unroll
                for (int m = 0; m < 4; ++m)
#pragma unroll
                    for (int n = 0; n < 2; ++n) acc[a][b][m][n] = (f32x4){0.f, 0.f, 0.f, 0.f};
        cur = nxt; cA = nA; cB = nB; ++ui;
        if constexpr (ALIGN_EPI) { if (wr == 1) PG8_BAR; }
    }
    PG8_WAIT_V(0);
    if constexpr (!ALIGN_EPI) { if (wr == 0) PG8_BAR; }
    PG8_BAR;
#undef PG8_SA
#undef PG8_SB
#undef PG8_STAGE
#undef PG8_LDA
#undef PG8_LDB
#undef PG8_MMA
#undef PG8_WAIT_V
#undef PG8_WAIT_L
#undef PG8_BAR
#undef PG8_SCHED
}
}
namespace pg8 {
struct EpiProj {
    static constexpr bool PERM = true;
    bf16_t* O; const float2* ropem; const float2* roper; float* kmean;
    __device__ __forceinline__ void operator()(const f32x4 (&acc)[2][2][4][2], const Unit& u, int wr, int wc, int fr, int fq) const {
        const int t = u.pn >> 2, coltile = (u.pn & 3) * BM;
        bf16_t* base = O + (size_t)t * M * 1024;
        const int row0 = u.pm * BM + wr * 64 + fr, col0 = coltile + wc * 32 + 8 * fq;
        const bool moba_rot = (t < 2) && (wc == 0);
        const bool ret_rot = (t == 3) || (t == 4);
        const float osc = (t == 4) ? 0.0625f : 1.f;
        float ks[2][8];
#pragma unroll
        for (int bj = 0; bj < 2; ++bj)
#pragma unroll
            for (int j = 0; j < 8; ++j) ks[bj][j] = 0.f;
#pragma unroll
        for (int ai = 0; ai < 2; ++ai)
#pragma unroll
            for (int m = 0; m < 4; ++m) {
                const int row = row0 + ai * HALF + m * 16;
                float v[2][8];
#pragma unroll
                for (int bj = 0; bj < 2; ++bj)
#pragma unroll
                    for (int j = 0; j < 8; ++j) v[bj][j] = acc[ai][bj][m][j >> 2][j & 3];
                if (moba_rot) {
                    const f32x4* cs4 = (const f32x4*)(ropem + (size_t)row * 16 + 8 * (fq & 1));
                    f32x4 cs[4];
#pragma unroll
                    for (int q = 0; q < 4; ++q) cs[q] = cs4[q];
#pragma unroll
                    for (int bj = 0; bj < 2; ++bj)
#pragma unroll
                        for (int j = 0; j < 8; ++j) { const float c = cs[j >> 1][(j & 1) * 2], s = cs[j >> 1][(j & 1) * 2 + 1]; const float xp = __shfl_xor(v[bj][j], 32);
                            v[bj][j] = (fq < 2) ? v[bj][j] * c - xp * s : v[bj][j] * c + xp * s; }
                } else if (ret_rot) {
                    const f32x4* cs4 = (const f32x4*)(roper + (size_t)row * 128 + wc * 32 + 8 * fq);
                    f32x4 cs[4];
#pragma unroll
                    for (int q = 0; q < 4; ++q) cs[q] = cs4[q];
#pragma unroll
                    for (int j = 0; j < 8; ++j) { const float c = cs[j >> 1][(j & 1) * 2], s = cs[j >> 1][(j & 1) * 2 + 1]; const float x1 = v[0][j], x2 = v[1][j];
                        v[0][j] = (x1 * c - x2 * s) * osc; v[1][j] = (x2 * c + x1 * s) * osc; }
                }
#pragma unroll
                for (int bj = 0; bj < 2; ++bj) {
                    u32x4 w; w.x = cvt_pk_bf16(v[bj][0], v[bj][1]); w.y = cvt_pk_bf16(v[bj][2], v[bj][3]); w.z = cvt_pk_bf16(v[bj][4], v[bj][5]); w.w = cvt_pk_bf16(v[bj][6], v[bj][7]);
                    *(u32x4*)(base + (size_t)row * 1024 + col0 + bj * HALF) = w;
#pragma unroll
                    for (int j = 0; j < 8; ++j) ks[bj][j] += v[bj][j];
                }
            }
        if (t == 1) {
#pragma unroll
            for (int bj = 0; bj < 2; ++bj)
#pragma unroll
                for (int j = 0; j < 8; ++j) { float s = ks[bj][j]; s += __shfl_xor(s, 1); s += __shfl_xor(s, 2); s += __shfl_xor(s, 4); s += __shfl_xor(s, 8);
                    if (fr == 0) atomicAdd(kmean + (size_t)u.pm * 1024 + col0 + bj * HALF + j, s * (1.f / 256.f)); }
        }
    }
};
struct EpiOut {
    static constexpr bool PERM = false;
    const float* x; const float* mod; float* x1;
    __device__ __forceinline__ void operator()(const f32x4 (&acc)[2][2][4][2], const Unit& u, int wr, int wc, int fr, int fq) const {
        const int row0 = u.pm * BM + wr * 64 + fr, col0 = u.pn * BM + wc * 32 + 4 * fq;
        const float* gate = mod + (u.pm / 16) * 6 * D + 2 * D;
#pragma unroll
        for (int bj = 0; bj < 2; ++bj)
#pragma unroll
            for (int n = 0; n < 2; ++n) { const int col = col0 + bj * HALF + n * 16; const f32x4 g4 = *(const f32x4*)(gate + col);
#pragma unroll
                for (int ai = 0; ai < 2; ++ai)
#pragma unroll
                    for (int m = 0; m < 4; ++m) { const size_t off = (size_t)(row0 + ai * HALF + m * 16) * D + col; const f32x4 xv = *(const f32x4*)(x + off);
                        *(f32x4*)(x1 + off) = xv + g4 * acc[ai][bj][m][n]; } }
    }
};
struct EpiAct {
    static constexpr bool PERM = true;
    bf16_t* act;
    __device__ __forceinline__ void operator()(const f32x4 (&acc)[2][2][4][2], const Unit& u, int wr, int wc, int fr, int fq) const {
        const int row0 = u.pm * BM + wr * 64 + fr, col0 = u.pn * HALF + wc * 32 + 8 * fq;
#pragma unroll
        for (int ai = 0; ai < 2; ++ai)
#pragma unroll
            for (int m = 0; m < 4; ++m) { float o[8];
#pragma unroll
                for (int j = 0; j < 8; ++j) { const float gt = acc[ai][0][m][j >> 2][j & 3], up = acc[ai][1][m][j >> 2][j & 3]; o[j] = gt / (1.f + __expf(-gt)) * up; }
                u32x4 w; w.x = cvt_pk_bf16(o[0], o[1]); w.y = cvt_pk_bf16(o[2], o[3]); w.z = cvt_pk_bf16(o[4], o[5]); w.w = cvt_pk_bf16(o[6], o[7]);
                *(u32x4*)(act + (size_t)(row0 + ai * HALF + m * 16) * EH + col0) = w; }
    }
};
struct EpiDown {
    static constexpr bool PERM = true;
    bf16_t* yslot; const int* ltok; const float* lw;
    __device__ __forceinline__ void operator()(const f32x4 (&acc)[2][2][4][2], const Unit& u, int wr, int wc, int fr, int fq) const {
        const int col0 = u.pn * BM + wc * 32 + 8 * fq;
        const int* lt = ltok + (size_t)u.e * 8192 + u.r0; const float* lwp = lw + (size_t)u.e * 8192 + u.r0;
#pragma unroll
        for (int ai = 0; ai < 2; ++ai)
#pragma unroll
            for (int m = 0; m < 4; ++m) { const int r = ai * HALF + wr * 64 + m * 16 + fr;
                if (r < u.cnt) { const int tk = lt[r]; const float w = lwp[r]; bf16_t* orow = yslot + ((size_t)(tk >> 4) * 9 + (tk & 15)) * D + col0;
#pragma unroll
                    for (int bj = 0; bj < 2; ++bj) { const f32x4 v0 = acc[ai][bj][m][0] * w, v1 = acc[ai][bj][m][1] * w;
                        u32x4 o; o.x = cvt_pk_bf16(v0[0], v0[1]); o.y = cvt_pk_bf16(v0[2], v0[3]); o.z = cvt_pk_bf16(v1[0], v1[1]); o.w = cvt_pk_bf16(v1[2], v1[3]);
                        *(u32x4*)(orow + bj * HALF) = o; } } }
    }
};
}
constexpr int NWAVES = 8;
constexpr int RING_BYTES = 131072;
constexpr int TAB_OFF = RING_BYTES;
constexpr int TILE_E_OFF = TAB_OFF + 1024;
constexpr int TILE_S_OFF = TILE_E_OFF + 2048;
constexpr int ECNT_OFF = TILE_S_OFF + 512;
constexpr int MISC_OFF = ECNT_OFF + 512;
constexpr int LDS_BYTES = MISC_OFF + 256;
static_assert(LDS_BYTES <= 160 * 1024 && LDS_BYTES > 80 * 1024, "one workgroup per CU");

typedef float f32x4 __attribute__((ext_vector_type(4)));
typedef unsigned v4u __attribute__((ext_vector_type(4)));
typedef unsigned v2u __attribute__((ext_vector_type(2)));
typedef GAS unsigned gu32;
#define RLX_AGENT __ATOMIC_RELAXED, __HIP_MEMORY_SCOPE_AGENT

#define XB_TMO      128
#define XB_XCNT(j)  (256  + 64 * (j))
#define XB_XSUB(j)  (1280 + 64 * (j))
#define XB_XGEN(j)  (2304 + 64 * (j))
#define XB_TOP      3328
#define XB_TOPGEN   3392
#define XCD_BAR_WORDS 3456
#define XB_SPIN_CAP (1u << 20)
__device__ __forceinline__ unsigned xb_ld(unsigned* p)              { return __hip_atomic_load(p, __ATOMIC_RELAXED, __HIP_MEMORY_SCOPE_AGENT); }
__device__ __forceinline__ unsigned xb_add(unsigned* p, unsigned v) { return __hip_atomic_fetch_add(p, v, __ATOMIC_RELAXED, __HIP_MEMORY_SCOPE_AGENT); }
__device__ __forceinline__ unsigned xb_xcc_id() { return (unsigned)__builtin_amdgcn_s_getreg((3 << 11) | 20) & 0xFu; }
#define XB_SPIN(cond, bar) do { unsigned _sp = 0; while (cond) { __builtin_amdgcn_s_sleep(1); \
    if ((++_sp & 255u) == 0u) { if (xb_ld(&(bar)[XB_TMO])) break; if (_sp > XB_SPIN_CAP) { atomicAdd(&(bar)[XB_TMO], 1u); break; } } } } while (0)
struct XcdBarrier { unsigned* bar; unsigned x; volatile LAS unsigned* st; };
__device__ __forceinline__ XcdBarrier xcd_barrier_post(unsigned* bar, volatile LAS unsigned* st) {
    XcdBarrier b; b.bar = bar; b.x = xb_xcc_id(); b.st = st;
    if (threadIdx.x == 0) (void)xb_add(&bar[XB_XCNT(b.x)], 1u);
    return b;
}
__device__ __forceinline__ void xcd_barrier_complete(unsigned* bar, unsigned x, unsigned& nloc, unsigned& nx) {
    const unsigned G = gridDim.x * gridDim.y * gridDim.z;
    unsigned sum, cnt, mine, sp = 0u;
    for (;;) {
        sum = 0u; cnt = 0u; mine = 0u;
#pragma unroll
        for (unsigned j = 0; j < 16; ++j) { const unsigned c = xb_ld(&bar[XB_XCNT(j)]); sum += c; cnt += (c > 0u) ? 1u : 0u; mine = (j == x) ? c : mine; }
        if (sum == G) break;
        __builtin_amdgcn_s_sleep(1);
        if ((++sp & 255u) == 0u) { if (xb_ld(&bar[XB_TMO])) break; if (sp > XB_SPIN_CAP) { atomicAdd(&bar[XB_TMO], 1u); break; } }
    }
    nloc = mine > 0u ? mine : 1u; nx = cnt > 0u ? cnt : 1u;
}
__device__ __forceinline__ void xcd_barrier(const XcdBarrier& b) {
    asm volatile("s_waitcnt vmcnt(0)" ::: "memory");
    __syncthreads();
    if (threadIdx.x == 0) {
        unsigned* bar = b.bar;
        __builtin_amdgcn_s_waitcnt(0);
        unsigned nloc = b.st[0], nx = b.st[1];
        if (nloc == 0u) { xcd_barrier_complete(bar, b.x, nloc, nx); b.st[0] = nloc; b.st[1] = nx; }
        const unsigned old = xb_add(&bar[XB_XSUB(b.x)], 1u);
        const unsigned gen = old / nloc;
        if (old + 1u == (gen + 1u) * nloc) {
            __builtin_amdgcn_fence(__ATOMIC_RELEASE, "agent");
            asm volatile("s_waitcnt vmcnt(0)" ::: "memory");
            const unsigned og = xb_add(&bar[XB_TOP], 1u);
            const unsigned tg = og / nx;
            if (og + 1u == (tg + 1u) * nx) xb_add(&bar[XB_TOPGEN], 1u);
            else XB_SPIN(xb_ld(&bar[XB_TOPGEN]) == tg, bar);
            __builtin_amdgcn_fence(__ATOMIC_ACQUIRE, "agent");
            xb_add(&bar[XB_XGEN(b.x)], 1u);
            asm volatile("s_waitcnt vmcnt(0)" ::: "memory");
        } else {
            XB_SPIN(xb_ld(&bar[XB_XGEN(b.x)]) == gen, bar);
            __builtin_amdgcn_fence(__ATOMIC_ACQUIRE, "agent");
            asm volatile("s_waitcnt vmcnt(0)" ::: "memory");
        }
    }
    __syncthreads();
}

struct Args { const void* in[18]; float* out; unsigned char* ws; int ph_lo, ph_hi, li, pad; };
struct Frame {
    LAS unsigned char* lds; int tid, lane, wave, G, bid;
    unsigned char* ws;
};

__device__ __forceinline__ void transpose_item(const float* W, int N, bf16* WT, int Kout, size_t rb, int k0, int n0, LAS bf16* scr, int lane) {
    const int kr = lane >> 4, nc = (lane & 15) * 4;
    f32x4 v[16];
#pragma unroll
    for (int i = 0; i < 16; ++i) v[i] = *(const GAS f32x4*)(W + (size_t)(k0 + 4 * i + kr) * N + n0 + nc);
#pragma unroll
    for (int i = 0; i < 16; ++i) { const int k = 4 * i + kr;
        const unsigned p0 = pg8::cvt_pk_bf16(v[i][0], v[i][1]), p1 = pg8::cvt_pk_bf16(v[i][2], v[i][3]);
        scr[(nc + 0) * 68 + k] = (bf16)(p0 & 0xffffu); scr[(nc + 1) * 68 + k] = (bf16)(p0 >> 16);
        scr[(nc + 2) * 68 + k] = (bf16)(p1 & 0xffffu); scr[(nc + 3) * 68 + k] = (bf16)(p1 >> 16); }
    asm volatile("s_waitcnt lgkmcnt(0)" ::: "memory");
    const int c = lane & 7;
#pragma unroll
    for (int j = 0; j < 8; ++j) { const int n = (lane >> 3) + 8 * j;
        const LAS v2u* s = (const LAS v2u*)(scr + n * 68 + 8 * c); const v2u a = s[0], b = s[1];
        v4u o; o.x = a.x; o.y = a.y; o.z = b.x; o.w = b.y;
        *(GAS v4u*)(WT + (rb + n) * (size_t)Kout + k0 + 8 * c) = o; }
    asm volatile("s_waitcnt lgkmcnt(0)" ::: "memory");
}
__device__ __forceinline__ void p0_prologue(const Frame& F, const Args& a) {
    const float* w_ada = (const float*)a.in[3]; const float* cvec = (const float*)a.in[1]; const int* pos = (const int*)a.in[2];
    const float* w_in = (const float*)a.in[8]; const float* w_out = (const float*)a.in[9];
    const float* w_gate = (const float*)a.in[12]; const float* w_up = (const float*)a.in[13]; const float* w_down = (const float*)a.in[14];
    const float* ws_gate = (const float*)a.in[15]; const float* ws_up = (const float*)a.in[16]; const float* ws_down = (const float*)a.in[17];
    bf16* WinT = (bf16*)(F.ws + WS_WIN); bf16* WoutT = (bf16*)(F.ws + WS_WOUT); bf16* WguT = (bf16*)(F.ws + WS_WGU); bf16* WdT = (bf16*)(F.ws + WS_WD);
    float2* ropem = (float2*)(F.ws + WS_ROPEM); float2* roper = (float2*)(F.ws + WS_ROPER); float* modp = (float*)(F.ws + WS_MODP);
    LAS bf16* scr = (LAS bf16*)(F.lds + F.wave * 8704);
    LAS double* sinv = (LAS double*)(F.lds + 8 * 8704);
    if (F.tid < 144) sinv[F.tid] = F.tid < 16 ? pow(500000.0, -(double)F.tid / 16.0) : pow(10000.0, -(double)(F.tid - 16) / 127.0);
    __syncthreads();
    const int gw = F.bid * NWAVES + F.wave, NGW = F.G * NWAVES, lane = F.lane;
    constexpr int I_MOD = 16 * 48, I_ROPE = (M * 144) / 64;
    constexpr int I_IN = 32 * 112, I_OUT = 32 * 32, I_GU = 65 * 2 * 32 * 8, I_DN = 65 * 8 * 32;
    constexpr int NITEMS = I_MOD + I_ROPE + I_IN + I_OUT + I_GU + I_DN;
    for (int it = gw; it < NITEMS; it += NGW) {
        int r = it;
        if (r < I_MOD) {
            const int kc = r / 48, n0 = (r % 48) * 256 + lane * 4;
            f32x4 a0 = {0.f, 0.f, 0.f, 0.f}, a1 = {0.f, 0.f, 0.f, 0.f};
#pragma unroll 8
            for (int k = kc * 128; k < kc * 128 + 128; ++k) { const f32x4 w = *(const GAS f32x4*)(w_ada + (size_t)k * (6 * D) + n0);
                const float c0 = cvec[k], c1 = cvec[D + k]; a0 += w * silu_f(c0); a1 += w * silu_f(c1); }
            *(f32x4*)(modp + (size_t)(kc * 2 + 0) * (6 * D) + n0) = a0; *(f32x4*)(modp + (size_t)(kc * 2 + 1) * (6 * D) + n0) = a1;
            continue; }
        r -= I_MOD;
        if (r < I_ROPE) {
            const int idx = r * 64 + lane; float2* dst; int m, f;
            if (idx < M * 16) { m = idx >> 4; f = idx & 15; dst = ropem + idx; } else { const int j = idx - M * 16; m = j >> 7; f = 16 + (j & 127); dst = roper + j; }
            const double rev = (double)pos[m] * sinv[f] * 0.15915494309189535; const float fr = (float)(rev - floor(rev));
            *dst = make_float2(__builtin_amdgcn_cosf(fr), __builtin_amdgcn_sinf(fr));
            continue; }
        r -= I_ROPE;
        if (r < I_IN) { transpose_item(w_in, NPROJ, WinT, D, (size_t)(r % 112) * 64, (r / 112) * 64, (r % 112) * 64, scr, lane); continue; }
        r -= I_IN;
        if (r < I_OUT) { transpose_item(w_out, D, WoutT, D, (size_t)(r % 32) * 64, (r / 32) * 64, (r % 32) * 64, scr, lane); continue; }
        r -= I_OUT;
        if (r < I_GU) {
            const int eu = r / 256, e = eu >> 1, up = eu & 1, q = r % 256, kb = q / 8, nb = q % 8, n0 = nb * 64;
            const float* W = e < 64 ? (up ? w_up : w_gate) + (size_t)e * D * EH : (up ? ws_up : ws_gate);
            const size_t rb = (size_t)e * 1024 + (n0 >> 7) * 256 + up * 128 + (n0 & 127);
            transpose_item(W, EH, WguT, D, rb, kb * 64, n0, scr, lane); continue; }
        r -= I_GU;
        { const int e = r / 256, q = r % 256, kb = q / 32, nb = q % 32;
          const float* W = e < 64 ? w_down + (size_t)e * EH * D : ws_down;
          transpose_item(W, D, WdT, EH, (size_t)e * D + nb * 64, kb * 64, nb * 64, scr, lane); }
    }
}
__device__ __forceinline__ void norm_rows(const Frame& F, const float* x, const float* g, const LAS float* smod  , bf16* xn, float* rstd_out, int m_lo, int m_step, int m_hi) {
    for (int m = m_lo; m < m_hi; m += m_step) {
        const int b = m / T, lane = F.lane;
        const GAS f32x4* xr = (const GAS f32x4*)(x + (size_t)m * D);
        f32x4 v[8]; float s = 0.f;
#pragma unroll
        for (int j = 0; j < 8; ++j) { v[j] = xr[lane + 64 * j]; s += v[j][0] * v[j][0] + v[j][1] * v[j][1] + v[j][2] * v[j][2] + v[j][3] * v[j][3]; }
        s = wave_sum(s);
        const float rstd = rsqrtf(s * (1.f / D) + NORM_EPS);
        if (rstd_out && lane == 0) rstd_out[m] = rstd;
#pragma unroll
        for (int j = 0; j < 8; ++j) { const int col = (lane + 64 * j) * 4;
            const f32x4 gg = *(const f32x4*)(g + col), h4 = *(const LAS f32x4*)(smod + (b * 2 + 0) * D + col), s4 = *(const LAS f32x4*)(smod + (b * 2 + 1) * D + col);
            const f32x4 o = v[j] * rstd * gg * (s4 + 1.f) + h4;
            v2u w; w.x = pg8::cvt_pk_bf16(o[0], o[1]); w.y = pg8::cvt_pk_bf16(o[2], o[3]);
            *(v2u*)(xn + (size_t)m * D + col) = w; }
    }
}
__device__ __forceinline__ void p1_norm(const Frame& F, const Args& a) {
    const float* x = (const float*)a.in[0]; const float* b_ada = (const float*)a.in[4]; const float* g = (const float*)a.in[5];
    const float* modp = (const float*)(F.ws + WS_MODP); float* mod = (float*)(F.ws + WS_MOD); bf16* xn = (bf16*)(F.ws + WS_XN);
    LAS float* smod = (LAS float*)F.lds;
    for (int i = F.tid; i < 2 * 2 * D; i += NWAVES * 64) { const int b = i / (2 * D), which = (i / D) & 1, col = i % D, n = which * D + col;
        float s = b_ada[n];
#pragma unroll
        for (int kc = 0; kc < 16; ++kc) s += modp[(size_t)(kc * 2 + b) * (6 * D) + n];
        smod[i] = s; }
    if (F.bid < 48) { const int i = F.bid * 512 + F.tid, b = i / (6 * D), n = i % (6 * D);
        float s = b_ada[n];
#pragma unroll
        for (int kc = 0; kc < 16; ++kc) s += modp[(size_t)(kc * 2 + b) * (6 * D) + n];
        mod[i] = s; }
    __syncthreads();
    norm_rows(F, x, g, smod, xn, nullptr, F.bid * NWAVES + F.wave, F.G * NWAVES, M);
    __syncthreads();
}
__device__ __forceinline__ void p10_final(const Frame& F, const Args& a) {
    const float* x1 = (const float*)(F.ws + WS_X1); const bf16* yslot = (const bf16*)(F.ws + WS_YSLOT); const float* mod = (const float*)(F.ws + WS_MOD);
    const float* gout = (const float*)a.in[7]; float* out = a.out; const int lane = F.lane;
    for (int m = F.bid * NWAVES + F.wave; m < M; m += F.G * NWAVES) {
        const float* gate = mod + (m / T) * 6 * D + 5 * D;
        f32x4 v[8]; float s = 0.f;
#pragma unroll
        for (int j = 0; j < 8; ++j) { const int col = (lane + 64 * j) * 4;
            f32x4 y = {0.f, 0.f, 0.f, 0.f};
#pragma unroll
            for (int k = 0; k < 9; ++k) { const v2u u = *(const GAS v2u*)(yslot + ((size_t)m * 9 + k) * D + col);
                y[0] += __uint_as_float(u.x << 16); y[1] += __uint_as_float(u.x & 0xffff0000u); y[2] += __uint_as_float(u.y << 16); y[3] += __uint_as_float(u.y & 0xffff0000u); }
            const f32x4 xv = *(const GAS f32x4*)(x1 + (size_t)m * D + col), g4 = *(const f32x4*)(gate + col);
            v[j] = xv + g4 * y; s += v[j][0] * v[j][0] + v[j][1] * v[j][1] + v[j][2] * v[j][2] + v[j][3] * v[j][3]; }
        s = wave_sum(s);
        const float rstd = rsqrtf(s * (1.f / D) + NORM_EPS);
#pragma unroll
        for (int j = 0; j < 8; ++j) { const int col = (lane + 64 * j) * 4; const f32x4 gg = *(const f32x4*)(gout + col);
            *(f32x4*)(out + (size_t)m * D + col) = v[j] * rstd * gg; }
    }
}
__device__ __forceinline__ int moe_tables(const Frame& F, const unsigned* cnt) {
    LAS int* tile_e = (LAS int*)(F.lds + TILE_E_OFF); LAS int* tile_s = (LAS int*)(F.lds + TILE_S_OFF); LAS int* ecnt = (LAS int*)(F.lds + ECNT_OFF);
    if (F.tid < 65) ecnt[F.tid] = F.tid < 64 ? (int)__hip_atomic_load(cnt + F.tid, RLX_AGENT) : M;
    __syncthreads();
    if (F.tid == 0) { int s = 0; for (int e = 0; e < 65; ++e) { tile_s[e] = s; s += (ecnt[e] + 255) >> 8; } tile_s[65] = s; }
    __syncthreads();
    const int total = tile_s[65];
    if (F.tid < 65) { for (int p = tile_s[F.tid]; p < tile_s[F.tid + 1]; ++p) tile_e[p] = F.tid; }
    __syncthreads();
    return total;
}
__device__ __forceinline__ void route_row(float lg, const float* bias, int m, unsigned* cnt, int* ltok, float* lw, int lane) {
    const float score = 1.f / (1.f + __expf(-lg));
    const float biased = score + bias[lane];
    float m1 = biased;
    m1 = fmaxf(m1, __shfl_xor(m1, 1)); m1 = fmaxf(m1, __shfl_xor(m1, 2)); m1 = fmaxf(m1, __shfl_xor(m1, 4));
    const unsigned long long eq = __ballot(biased == m1);
    const unsigned gb = (unsigned)(eq >> (lane & ~7)) & 0xffu;
    const int first = __ffs(gb) - 1;
    float v2 = ((lane & 7) == first) ? -3e38f : biased;
    v2 = fmaxf(v2, __shfl_xor(v2, 1)); v2 = fmaxf(v2, __shfl_xor(v2, 2)); v2 = fmaxf(v2, __shfl_xor(v2, 4));
    const float gs = m1 + v2; const int g = lane >> 3;
    int grank = 0;
#pragma unroll
    for (int j = 0; j < 8; ++j) { const float o = __shfl(gs, j * 8); grank += (o > gs || (o == gs && j < g)) ? 1 : 0; }
    const float masked = grank < 4 ? biased : NEGF;
    int rank = 0;
#pragma unroll
    for (int j = 0; j < 64; ++j) { const float o = __shfl(masked, j); rank += (o > masked || (o == masked && j < lane)) ? 1 : 0; }
    const bool selx = rank < 8;
    const float ssum = wave_sum(selx ? score : 0.f);
    if (selx) { const unsigned p = atomicAdd(&cnt[lane], 1u); ltok[lane * M + p] = m * 16 + rank; lw[lane * M + p] = score / ssum * 2.5f; }
    if (lane == 0) { ltok[64 * M + m] = m * 16 + 8; lw[64 * M + m] = 1.f; }
}
__device__ __forceinline__ void p7_route(const Frame& F, const Args& a) {
    const float* x1 = (const float*)(F.ws + WS_X1); const float* g = (const float*)a.in[6]; const float* mod = (const float*)(F.ws + WS_MOD);
    const float* w_router = (const float*)a.in[10]; const float* rbias = (const float*)a.in[11];
    bf16* xn = (bf16*)(F.ws + WS_XN); unsigned* cnt = (unsigned*)(F.ws + WS_CTL) + CW_CNT; int* ltok = (int*)(F.ws + WS_LTOK); float* lw = (float*)(F.ws + WS_LW);
    LAS float* smod = (LAS float*)F.lds; LAS float* srstd = (LAS float*)(F.lds + 32768); LAS float* slog = (LAS float*)(F.lds + 33792);
    float* sm = (float*)(F.lds + 50176);
    for (int i = F.tid; i < 2 * 2 * D; i += NWAVES * 64) { const int b = i / (2 * D), which = (i / D) & 1, col = i % D; smod[i] = mod[b * 6 * D + (3 + which) * D + col]; }
    __syncthreads();
    for (int tile = F.bid; tile < M / 64; tile += F.G) {
        const int m0 = tile * 64, b = m0 / T;
        norm_rows(F, x1, g, smod, xn, (float*)(F.ws + WS_RSTD), m0 + F.wave * 8, 1, m0 + F.wave * 8 + 8);
        for (int r = 0; r < 8; ++r) { if (F.lane == 0) srstd[F.wave * 8 + r] = ((const float*)(F.ws + WS_RSTD))[m0 + F.wave * 8 + r]; }
        __syncthreads();
        nv::ngemm_tile(sm, D,
            [&](int r, int k) { return x1[(size_t)(m0 + r) * D + k] * srstd[r] * g[k] * (1.f + smod[(b * 2 + 1) * D + k]) + smod[(b * 2 + 0) * D + k]; },
            [&](int k, int c) { return c < 64 ? w_router[(size_t)k * 64 + c] : 0.f; },
            [&](int r0, int c0, const float (&acc)[4][4]) {
                if (c0 < 64) {
#pragma unroll
                    for (int i = 0; i < 4; ++i)
#pragma unroll
                        for (int j = 0; j < 4; ++j) slog[(r0 + i) * 64 + c0 + j] = acc[i][j]; } });
        __syncthreads();
        for (int r = 0; r < 8; ++r) { const int row = F.wave * 8 + r; route_row(slog[row * 64 + F.lane], rbias, m0 + row, cnt, ltok, lw, F.lane); }
        __syncthreads();
    }
}

__global__ void __launch_bounds__(NWAVES * 64, 2) mk_fwd(Args args) {
    extern __shared__ __attribute__((aligned(16))) unsigned char lds_raw[];
    Frame F;
    F.lds = (LAS unsigned char*)lds_raw; F.tid = threadIdx.x; F.lane = F.tid & 63; F.wave = __builtin_amdgcn_readfirstlane(F.tid >> 6);
    F.G = gridDim.x; F.bid = blockIdx.x; F.ws = args.ws;
    volatile LAS unsigned* MISC = (volatile LAS unsigned*)(F.lds + MISC_OFF);
    if (F.tid < 64) MISC[F.tid] = 0u;
    __syncthreads();
    unsigned* ctl = (unsigned*)(F.ws + WS_CTL);
    const int lo = args.ph_lo, hi = args.ph_hi;
    XcdBarrier bar; bar.bar = ctl + CW_BAR + args.li * XCD_BAR_WORDS; bar.x = 0; bar.st = nullptr;
    if (hi - lo > 1) bar = xcd_barrier_post(ctl + CW_BAR + args.li * XCD_BAR_WORDS, MISC + 8);
#define IN(k) (lo <= (k) && (k) < hi)
#define SEAM(k) do { if (IN(k) && IN((k) + 1)) xcd_barrier(bar); } while (0)
    LAS unsigned char* ring = F.lds; LAS unsigned char* tab = F.lds + TAB_OFF;
    if (IN(0)) { p0_prologue(F, args); __syncthreads(); } SEAM(0);
    if (IN(1)) { p1_norm(F, args); } SEAM(1);
    if (IN(2)) {
        pg8::Gemm g{(const bf16*)(F.ws + WS_XN), (const bf16*)(F.ws + WS_WIN), D}; pg8::StaticOrder S; S.init(M, NPROJ, F.G, F.bid);
        pg8::EpiProj E{(bf16*)(F.ws + WS_PROJ), (const float2*)(F.ws + WS_ROPEM), (const float2*)(F.ws + WS_ROPER), (float*)(F.ws + WS_KMEAN)};
        pg8::gemm_phase<pg8::EpiProj, pg8::StaticOrder, false, true>(ring, tab, g, S, E);
    } SEAM(2);
    if (IN(6)) {
        pg8::Gemm g{(const bf16*)(F.ws + WS_MIX), (const bf16*)(F.ws + WS_WOUT), D}; pg8::StaticOrder S; S.init(M, D, F.G, F.bid);
        pg8::EpiOut E{(const float*)args.in[0], (const float*)(F.ws + WS_MOD), (float*)(F.ws + WS_X1)};
        pg8::gemm_phase<pg8::EpiOut, pg8::StaticOrder, false, false>(ring, tab, g, S, E);
    } SEAM(6);
    if (IN(7)) { p7_route(F, args); } SEAM(7);
    if (IN(8)) {
        const int total = moe_tables(F, ctl + CW_CNT);
        pg8::MoeOrder S; S.nM = total; S.nN = 4; S.nwg = total * 4; S.G = F.G; S.c = F.bid;
        S.tile_e = (const LAS int*)(F.lds + TILE_E_OFF); S.tile_start = (const LAS int*)(F.lds + TILE_S_OFF); S.ecount = (const LAS int*)(F.lds + ECNT_OFF); S.ltok = (const int*)(F.ws + WS_LTOK);
        pg8::Gemm g{(const bf16*)(F.ws + WS_XN), (const bf16*)(F.ws + WS_WGU), D};
        pg8::EpiAct E{(bf16*)(F.ws + WS_ACT)};
        pg8::gemm_phase<pg8::EpiAct, pg8::MoeOrder, true, true>(ring, tab, g, S, E);
    } SEAM(8);
    if (IN(9)) {
        const int total = moe_tables(F, ctl + CW_CNT);
        pg8::MoeOrder S; S.nM = total; S.nN = 8; S.nwg = total * 8; S.G = F.G; S.c = F.bid;
        S.tile_e = (const LAS int*)(F.lds + TILE_E_OFF); S.tile_start = (const LAS int*)(F.lds + TILE_S_OFF); S.ecount = (const LAS int*)(F.lds + ECNT_OFF); S.ltok = (const int*)(F.ws + WS_LTOK);
        pg8::Gemm g{(const bf16*)(F.ws + WS_ACT), (const bf16*)(F.ws + WS_WD), EH};
        pg8::EpiDown E{(bf16*)(F.ws + WS_YSLOT), (const int*)(F.ws + WS_LTOK), (const float*)(F.ws + WS_LW)};
        pg8::gemm_phase<pg8::EpiDown, pg8::MoeOrder, false, true>(ring, tab, g, S, E);
    } SEAM(9);
    if (IN(10)) { p10_final(F, args); }
#undef IN
#undef SEAM
}

#ifndef MK_MASK
#define MK_MASK 0x7C7
#endif
extern "C" void kernel_launch(void* const* d_in, const int* in_sizes, int n_in, void* d_out, int out_size, void* d_ws, size_t ws_size, hipStream_t stream) {
    static int grid = 0;
    if (grid == 0) {
        if (n_in != 18 || ws_size < WS_END) { fprintf(stderr, "kernel_launch: bad args n_in %d ws %zu\n", n_in, ws_size); grid = -1; return; }
        int dev = 0, cus = 0, per_cu = 0;
        if (hipGetDevice(&dev) != hipSuccess || hipDeviceGetAttribute(&cus, hipDeviceAttributeMultiprocessorCount, dev) != hipSuccess) { grid = -1; return; }
        if (hipFuncSetAttribute((const void*)mk_fwd, hipFuncAttributeMaxDynamicSharedMemorySize, LDS_BYTES) != hipSuccess) { fprintf(stderr, "kernel_launch: hipFuncSetAttribute failed\n"); grid = -1; return; }
        if (hipOccupancyMaxActiveBlocksPerMultiprocessor(&per_cu, (const void*)mk_fwd, NWAVES * 64, LDS_BYTES) != hipSuccess || per_cu < 1) { fprintf(stderr, "kernel_launch: occupancy query says %d\n", per_cu); per_cu = 1; }
        (void)hipGetLastError();
        grid = cus;
    }
    if (grid < 0) return;
    const float* x = (const float*)d_in[0]; const float* c = (const float*)d_in[1]; const int* pos = (const int*)d_in[2];
    const float* w_ada = (const float*)d_in[3]; const float* b_ada = (const float*)d_in[4];
    const float* norm_mix = (const float*)d_in[5]; const float* norm_ffn = (const float*)d_in[6]; const float* norm_out = (const float*)d_in[7];
    const float* w_in = (const float*)d_in[8]; const float* w_out = (const float*)d_in[9]; const float* w_router = (const float*)d_in[10]; const float* rbias = (const float*)d_in[11];
    const float* w_gate = (const float*)d_in[12]; const float* w_up = (const float*)d_in[13]; const float* w_down = (const float*)d_in[14];
    const float* ws_gate = (const float*)d_in[15]; const float* ws_up = (const float*)d_in[16]; const float* ws_down = (const float*)d_in[17];
    unsigned char* ws = (unsigned char*)d_ws;
    unsigned* ctl = (unsigned*)(ws + WS_CTL); float* mod = (float*)(ws + WS_MOD); float* kmean = (float*)(ws + WS_KMEAN); float* rstd = (float*)(ws + WS_RSTD);
    int* ltok = (int*)(ws + WS_LTOK); float* lw = (float*)(ws + WS_LW); float2* ropem = (float2*)(ws + WS_ROPEM); float2* roper = (float2*)(ws + WS_ROPER);
    float* logits = (float*)(ws + WS_LOGITS); float* x1 = (float*)(ws + WS_X1); bf16* xn = (bf16*)(ws + WS_XN); bf16* act = (bf16*)(ws + WS_ACT);
    bf16* proj = (bf16*)(ws + WS_PROJ); bf16* mix = (bf16*)(ws + WS_MIX); bf16* yslot = (bf16*)(ws + WS_YSLOT); float* projf = (float*)(ws + WS_PROJF);
    const size_t PS = (size_t)M * 1024;
    (void)hipMemsetAsync(ws + WS_CTL, 0, CTL_ZERO_BYTES, stream);
    Args a{};
    for (int i = 0; i < 18; ++i) a.in[i] = d_in[i];
    a.out = (float*)d_out; a.ws = ws;
    const unsigned mask = MK_MASK; int li = 0;
    const int max_rt = (M * 9 + 65 * 256) / 64;
    for (int p = 0; p <= 10;) {
        if ((mask >> p) & 1u) {
            int q = p; while (q <= 10 && ((mask >> q) & 1u)) ++q;
            a.ph_lo = p; a.ph_hi = q; a.li = li++;
            hipLaunchKernelGGL(mk_fwd, dim3(grid), dim3(NWAVES * 64), LDS_BYTES, stream, a);
            p = q; continue;
        }
        switch (p) {
        case 0: nv::k_rope<<<(M * 128 + 255) / 256, 256, 0, stream>>>(pos, ropem, roper); break;
        case 1: nv::k_mod<<<6 * D / 256, 256, 0, stream>>>(c, w_ada, b_ada, mod); nv::k_norm_mod<<<M / 8, 512, 0, stream>>>(x, norm_mix, mod, 0, D, xn, nullptr); break;
        case 2: nv::k_proj<<<(M / 64) * (NPROJ / 128), 512, 0, stream>>>(xn, w_in, projf);
                nv::k_rot<<<(unsigned)(((size_t)M * NPROJ + 255) / 256), 256, 0, stream>>>(projf, ropem, roper, proj);
                nv::k_kmean<<<NB * 16 * 1024 / 256, 256, 0, stream>>>(proj + PS, kmean); break;
        case 3: nv::k_moba<<<M, 512, 0, stream>>>(proj, proj + PS, proj + 2 * PS, kmean, mix);
                nv::k_ret<<<M / 2, 512, 0, stream>>>(proj + 3 * PS, proj + 4 * PS, proj + 5 * PS, proj + 6 * PS, mix); break;
        case 6: nv::k_outproj<<<(M / 64) * (D / 128), 512, 0, stream>>>(mix, w_out, x, mod, x1); break;
        case 7: nv::k_norm_mod<<<M / 8, 512, 0, stream>>>(x1, norm_ffn, mod, 3 * D, 4 * D, xn, rstd);
                nv::k_logits<<<M / 64, 512, 0, stream>>>(x1, rstd, norm_ffn, mod, w_router, logits);
                nv::k_route<<<M / 8, 512, 0, stream>>>(logits, rbias, ctl + CW_CNT, ltok, lw); break;
        case 8: nv::k_gateup<<<max_rt * 8, 512, 0, stream>>>(xn, ctl + CW_CNT, ltok, w_gate, w_up, ws_gate, ws_up, act); break;
        case 9: nv::k_down<<<max_rt * 16, 512, 0, stream>>>(act, ctl + CW_CNT, ltok, lw, w_down, ws_down, yslot); break;
        case 10: nv::k_final<<<M / 8, 512, 0, stream>>>(x1, yslot, mod, norm_out, (float*)d_out); break;
        default: break;
        }
        ++p;
    }
}
```

```cpp
#include <hip/hip_runtime.h>
#include <cstdio>
#include <cstdint>

constexpr int NB = 2, T = 4096, D = 2048, M = NB * T;
constexpr int NPROJ = 7168;
constexpr int NE = 64, EH = 512;
constexpr float NORM_EPS = 1e-6f;
constexpr float NEGF = -1e30f;

constexpr size_t MiB = 1u << 20;
constexpr size_t WS_CTL = 0, CTL_ZERO_BYTES = 1 * MiB;
constexpr size_t WS_KMEAN = 512 * 1024;
constexpr size_t WS_MODP = 1 * MiB;
constexpr size_t WS_MOD = 3 * MiB;
constexpr size_t WS_RSTD = 5 * MiB;
constexpr size_t WS_LTOK = 6 * MiB;
constexpr size_t WS_LW = 9 * MiB;
constexpr size_t WS_ROPEM = 12 * MiB;
constexpr size_t WS_ROPER = 13 * MiB;
constexpr size_t WS_LOGITS = 21 * MiB;
constexpr size_t WS_WGU = 24 * MiB;
constexpr size_t WS_WD = 284 * MiB;
constexpr size_t WS_X1 = 414 * MiB;
constexpr size_t WS_XN = 478 * MiB;
constexpr size_t WS_ACT = 510 * MiB;
constexpr size_t WS_WIN = 600 * MiB;
constexpr size_t WS_WOUT = 628 * MiB;
constexpr size_t WS_PROJ = 636 * MiB;
constexpr size_t WS_MIX = 748 * MiB;
constexpr size_t WS_U = 780 * MiB;
constexpr size_t WS_S = 844 * MiB;
constexpr size_t WS_YSLOT = 600 * MiB;
constexpr size_t WS_PROJF = 780 * MiB;
constexpr size_t WS_END = 1024 * MiB;
constexpr int CW_CNT = 1024;
constexpr int CW_BAR = 4096;

typedef unsigned short bf16;
__device__ __forceinline__ float bf2f(bf16 v) { return __uint_as_float(((unsigned)v) << 16); }
__device__ __forceinline__ bf16 f2bf(float f) { unsigned u = __float_as_uint(f); return (bf16)((u + 0x7fffu + ((u >> 16) & 1u)) >> 16); }
__device__ __forceinline__ float wave_sum(float v) {
#pragma unroll
    for (int o = 1; o < 64; o <<= 1) v += __shfl_xor(v, o);
    return v;
}
__device__ __forceinline__ float wave_max(float v) {
#pragma unroll
    for (int o = 1; o < 64; o <<= 1) v = fmaxf(v, __shfl_xor(v, o));
    return v;
}
__device__ __forceinline__ int lane_id() { int r; asm volatile("v_mbcnt_lo_u32_b32 %0, -1, 0\n\tv_mbcnt_hi_u32_b32 %0, -1, %0" : "=v"(r)); return r; }
__device__ __forceinline__ float silu_f(float x) { return x / (1.f + __expf(-x)); }

namespace nv {

__global__ void k_rope(const int* pos, float2* ropem, float2* roper) {
    int i = blockIdx.x * blockDim.x + threadIdx.x;
    if (i < M * 16) { int m = i >> 4, f = i & 15; double inv = pow(500000.0, -(double)f / 16.0); double a = (double)pos[m] * inv; ropem[i] = make_float2((float)cos(a), (float)sin(a)); }
    if (i < M * 128) { int m = i >> 7, f = i & 127; double inv = pow(10000.0, -(double)f / 127.0); double a = (double)pos[m] * inv; roper[i] = make_float2((float)cos(a), (float)sin(a)); }
}
__global__ void k_mod(const float* c, const float* w_ada, const float* b_ada, float* mod) {
    __shared__ float sc[2][D];
    for (int i = threadIdx.x; i < 2 * D; i += blockDim.x) sc[i / D][i % D] = silu_f(c[i]);
    __syncthreads();
    int n = blockIdx.x * blockDim.x + threadIdx.x;
    if (n >= 6 * D) return;
    float a0 = 0.f, a1 = 0.f;
    for (int k = 0; k < D; ++k) { float w = w_ada[(size_t)k * (6 * D) + n]; a0 += sc[0][k] * w; a1 += sc[1][k] * w; }
    mod[n] = a0 + b_ada[n]; mod[6 * D + n] = a1 + b_ada[n];
}
__global__ void k_norm_mod(const float* x, const float* g, const float* mod, int shift_off, int scale_off, bf16* xn, float* rstd_out) {
    int wave = threadIdx.x >> 6, lane = threadIdx.x & 63;
    int m = blockIdx.x * (blockDim.x >> 6) + wave; if (m >= M) return;
    int b = m / T;
    const float4* xr = (const float4*)(x + (size_t)m * D);
    float4 v[8]; float s = 0.f;
#pragma unroll
    for (int j = 0; j < 8; ++j) { v[j] = xr[lane + 64 * j]; s += v[j].x * v[j].x + v[j].y * v[j].y + v[j].z * v[j].z + v[j].w * v[j].w; }
    s = wave_sum(s);
    float rstd = rsqrtf(s * (1.f / D) + NORM_EPS);
    if (rstd_out && lane == 0) rstd_out[m] = rstd;
    const float* sh = mod + b * 6 * D + shift_off; const float* scv = mod + b * 6 * D + scale_off;
#pragma unroll
    for (int j = 0; j < 8; ++j) {
        int col = (lane + 64 * j) * 4;
        float4 gg = *(const float4*)(g + col), s4 = *(const float4*)(scv + col), h4 = *(const float4*)(sh + col);
        float o0 = v[j].x * rstd * gg.x * (1.f + s4.x) + h4.x, o1 = v[j].y * rstd * gg.y * (1.f + s4.y) + h4.y;
        float o2 = v[j].z * rstd * gg.z * (1.f + s4.z) + h4.z, o3 = v[j].w * rstd * gg.w * (1.f + s4.w) + h4.w;
        ushort4 o; o.x = f2bf(o0); o.y = f2bf(o1); o.z = f2bf(o2); o.w = f2bf(o3);
        *(ushort4*)(xn + (size_t)m * D + col) = o;
    }
}

template <class FA, class FB, class FE>
__device__ __forceinline__ void ngemm_tile(float* sm, int K, FA fa, FB fb, FE fe, int tid = threadIdx.x) {
    float* As = sm; float* Bs = sm + 16 * 68;
    const int ty = tid >> 5, tx = tid & 31;
    float acc[4][4];
#pragma unroll
    for (int i = 0; i < 4; ++i)
#pragma unroll
        for (int j = 0; j < 4; ++j) acc[i][j] = 0.f;
    for (int k0 = 0; k0 < K; k0 += 16) {
#pragma unroll
        for (int i = tid; i < 1024; i += 512) { int r = i >> 4, k = i & 15; As[k * 68 + r] = fa(r, k0 + k); }
#pragma unroll
        for (int i = tid; i < 2048; i += 512) { int k = i >> 7, c = i & 127; Bs[k * 132 + c] = fb(k0 + k, c); }
        __syncthreads();
#pragma unroll
        for (int k = 0; k < 16; ++k) {
            float4 a = *(float4*)&As[k * 68 + ty * 4]; float4 b = *(float4*)&Bs[k * 132 + tx * 4];
            float av[4] = {a.x, a.y, a.z, a.w}, bv[4] = {b.x, b.y, b.z, b.w};
#pragma unroll
            for (int i = 0; i < 4; ++i)
#pragma unroll
                for (int j = 0; j < 4; ++j) acc[i][j] += av[i] * bv[j];
        }
        __syncthreads();
    }
    fe(ty * 4, tx * 4, acc);
}
constexpr int NG_SM = 16 * 68 + 16 * 132;

__global__ void __launch_bounds__(512) k_proj(const bf16* xn, const float* w_in, float* projf) {
    __shared__ __attribute__((aligned(16))) float sm[NG_SM];
    const int m0 = (blockIdx.x / (NPROJ / 128)) * 64, n0 = (blockIdx.x % (NPROJ / 128)) * 128;
    ngemm_tile(sm, D,
        [&](int r, int k) { return bf2f(xn[(size_t)(m0 + r) * D + k]); },
        [&](int k, int c) { return w_in[(size_t)k * NPROJ + n0 + c]; },
        [&](int r0, int c0, const float (&acc)[4][4]) {
#pragma unroll
            for (int i = 0; i < 4; ++i) *(float4*)(projf + (size_t)(m0 + r0 + i) * NPROJ + n0 + c0) = make_float4(acc[i][0], acc[i][1], acc[i][2], acc[i][3]);
        });
}
__global__ void k_rot(const float* projf, const float2* ropem, const float2* roper, bf16* proj) {
    size_t i = (size_t)blockIdx.x * blockDim.x + threadIdx.x;
    if (i >= (size_t)M * NPROJ) return;
    int m = (int)(i / NPROJ), col = (int)(i % NPROJ), t = col >> 10, cc = col & 1023;
    const float* row = projf + (size_t)m * NPROJ;
    float x = row[col], val = x;
    if (t == 0 || t == 1) {
        int d = cc & 127;
        if (d < 32) { int f = d & 15; float2 cs = ropem[m * 16 + f]; float xp = row[col + (d < 16 ? 16 : -16)]; val = d < 16 ? x * cs.x - xp * cs.y : x * cs.x + xp * cs.y; }
    } else if (t == 3 || t == 4) {
        int d = cc & 255, f = d & 127; float2 cs = roper[m * 128 + f]; float xp = row[col + (d < 128 ? 128 : -128)];
        val = d < 128 ? x * cs.x - xp * cs.y : x * cs.x + xp * cs.y;
        if (t == 4) val *= 0.0625f;
    }
    proj[(size_t)t * M * 1024 + (size_t)m * 1024 + cc] = f2bf(val);
}
__global__ void k_kmean(const bf16* ka, float* kmean) {
    int i = blockIdx.x * blockDim.x + threadIdx.x; if (i >= NB * 16 * 1024) return;
    int col = i & 1023, bb = i >> 10;
    float s = 0.f;
    for (int r = 0; r < 256; ++r) s += bf2f(ka[(size_t)(bb * 256 + r) * 1024 + col]);
    kmean[i] = s * (1.f / 256.f);
}
__global__ void __launch_bounds__(512) k_moba(const bf16* qa, const bf16* ka, const bf16* va, const float* kmean, bf16* mix) {
    __shared__ float sq[8][128];
    __shared__ float sp[8][1024];
    __shared__ float sg[8][16];
    const int m = blockIdx.x, h = threadIdx.x >> 6, lane = threadIdx.x & 63;
    const int b = m / T, t = m % T, qb = t >> 8;
    float q0 = bf2f(qa[(size_t)m * 1024 + h * 128 + lane]), q1 = bf2f(qa[(size_t)m * 1024 + h * 128 + lane + 64]);
    sq[h][lane] = q0; sq[h][lane + 64] = q1;
    for (int n = 0; n < qb; ++n) {
        const float* km = kmean + ((size_t)(b * 16 + n) * 1024 + h * 128);
        float g = wave_sum(q0 * km[lane] + q1 * km[lane + 64]);
        if (lane == 0) sg[h][n] = g;
    }
    __syncthreads();
    int sel[4]; bool val[4];
    {
        unsigned chosen = 0u;
#pragma unroll
        for (int s = 0; s < 3; ++s) {
            float best = -3e38f; int bi = -1;
            for (int n = 0; n < qb; ++n) if (!((chosen >> n) & 1u) && sg[h][n] > best) { best = sg[h][n]; bi = n; }
            val[s] = bi >= 0; sel[s] = bi >= 0 ? bi : 0; if (bi >= 0) chosen |= 1u << bi;
        }
        sel[3] = qb; val[3] = true;
    }
    const float scale = 0.08838834764831845f;
    float sc[4][4]; float mx = -3e38f;
#pragma unroll
    for (int j = 0; j < 4; ++j)
#pragma unroll
        for (int i = 0; i < 4; ++i) {
            float s = NEGF;
            if (val[j]) {
                int key = sel[j] * 256 + lane + 64 * i;
                if (j < 3 || key <= t) {
                    const uint4* kr = (const uint4*)(ka + (size_t)(b * T + key) * 1024 + h * 128);
                    float a = 0.f;
#pragma unroll 4
                    for (int c = 0; c < 16; ++c) { uint4 kk = kr[c]; const float* qq = &sq[h][c * 8];
                        a += qq[0] * __uint_as_float(kk.x << 16) + qq[1] * __uint_as_float(kk.x & 0xffff0000u) + qq[2] * __uint_as_float(kk.y << 16) + qq[3] * __uint_as_float(kk.y & 0xffff0000u)
                           + qq[4] * __uint_as_float(kk.z << 16) + qq[5] * __uint_as_float(kk.z & 0xffff0000u) + qq[6] * __uint_as_float(kk.w << 16) + qq[7] * __uint_as_float(kk.w & 0xffff0000u); }
                    s = a * scale;
                }
            }
            sc[j][i] = s; mx = fmaxf(mx, s);
        }
    mx = wave_max(mx);
    float sum = 0.f;
#pragma unroll
    for (int j = 0; j < 4; ++j)
#pragma unroll
        for (int i = 0; i < 4; ++i) { float p = __expf(sc[j][i] - mx); sc[j][i] = p; sum += p; }
    sum = wave_sum(sum);
    const float inv = 1.f / sum;
#pragma unroll
    for (int j = 0; j < 4; ++j)
#pragma unroll
        for (int i = 0; i < 4; ++i) sp[h][j * 256 + lane + 64 * i] = sc[j][i] * inv;
    __syncthreads();
    float o0 = 0.f, o1 = 0.f;
#pragma unroll
    for (int j = 0; j < 4; ++j) {
        if (!val[j]) continue;
        const int nk = (j < 3) ? 256 : (t & 255) + 1;
        const bf16* vb = va + (size_t)(b * T + sel[j] * 256) * 1024 + h * 128;
        for (int i = 0; i < nk; ++i) { float p = sp[h][j * 256 + i]; o0 += p * bf2f(vb[(size_t)i * 1024 + lane]); o1 += p * bf2f(vb[(size_t)i * 1024 + lane + 64]); }
    }
    mix[(size_t)m * D + h * 128 + lane] = f2bf(o0); mix[(size_t)m * D + h * 128 + lane + 64] = f2bf(o1);
}
__global__ void __launch_bounds__(512) k_ret(const bf16* qr, const bf16* kr, const bf16* vr, const bf16* gr, bf16* mix) {
    __shared__ float sq[8][256];
    __shared__ float sp[8][1024];
    const int w = threadIdx.x >> 6, lane = threadIdx.x & 63;
    const int m = blockIdx.x * 2 + (w >> 2), h = w & 3, b = m / T, t = m % T;
    for (int j = 0; j < 4; ++j) sq[w][lane + 64 * j] = bf2f(qr[(size_t)m * 1024 + h * 256 + lane + 64 * j]);
    __syncthreads();
    const float gamma = 1.f - exp2f(-5.f - (float)h), lg2 = log2f(gamma);
    float o[4] = {0.f, 0.f, 0.f, 0.f};
    for (int s0 = 0; s0 <= t; s0 += 1024) {
        const int send = min(s0 + 1023, t);
        if ((float)(t - send) * lg2 < -100.f) continue;
#pragma unroll 1
        for (int i = 0; i < 16; ++i) {
            int s = s0 + lane + 64 * i; float p = 0.f;
            if (s <= t) {
                const uint4* kk4 = (const uint4*)(kr + (size_t)(b * T + s) * 1024 + h * 256);
                float a = 0.f;
#pragma unroll 4
                for (int c = 0; c < 32; ++c) { uint4 kk = kk4[c]; const float* qq = &sq[w][c * 8];
                    a += qq[0] * __uint_as_float(kk.x << 16) + qq[1] * __uint_as_float(kk.x & 0xffff0000u) + qq[2] * __uint_as_float(kk.y << 16) + qq[3] * __uint_as_float(kk.y & 0xffff0000u)
                       + qq[4] * __uint_as_float(kk.z << 16) + qq[5] * __uint_as_float(kk.z & 0xffff0000u) + qq[6] * __uint_as_float(kk.w << 16) + qq[7] * __uint_as_float(kk.w & 0xffff0000u); }
                p = a * exp2f((float)(t - s) * lg2);
            }
            sp[w][lane + 64 * i] = p;
        }
        __builtin_amdgcn_wave_barrier();
        const int nk = send - s0 + 1;
        const bf16* vb = vr + (size_t)(b * T + s0) * 1024 + h * 256;
        for (int i = 0; i < nk; ++i) { float p = sp[w][i];
#pragma unroll
            for (int j = 0; j < 4; ++j) o[j] += p * bf2f(vb[(size_t)i * 1024 + lane + 64 * j]); }
        __builtin_amdgcn_wave_barrier();
    }
    float mu = wave_sum(o[0] + o[1] + o[2] + o[3]) * (1.f / 256.f);
    float vs = 0.f;
#pragma unroll
    for (int j = 0; j < 4; ++j) { o[j] -= mu; vs += o[j] * o[j]; }
    float rs = rsqrtf(wave_sum(vs) * (1.f / 256.f) + NORM_EPS);
#pragma unroll
    for (int j = 0; j < 4; ++j) { float g = bf2f(gr[(size_t)m * 1024 + h * 256 + lane + 64 * j]); mix[(size_t)m * D + 1024 + h * 256 + lane + 64 * j] = f2bf(o[j] * rs * silu_f(g)); }
}
__global__ void __launch_bounds__(512) k_outproj(const bf16* mix, const float* w_out, const float* x, const float* mod, float* x1) {
    __shared__ __attribute__((aligned(16))) float sm[NG_SM];
    const int m0 = (blockIdx.x / (D / 128)) * 64, n0 = (blockIdx.x % (D / 128)) * 128;
    const float* gate = mod + (m0 / T) * 6 * D + 2 * D;
    ngemm_tile(sm, D,
        [&](int r, int k) { return bf2f(mix[(size_t)(m0 + r) * D + k]); },
        [&](int k, int c) { return w_out[(size_t)k * D + n0 + c]; },
        [&](int r0, int c0, const float (&acc)[4][4]) {
#pragma unroll
            for (int i = 0; i < 4; ++i) { size_t off = (size_t)(m0 + r0 + i) * D + n0 + c0; float4 xv = *(const float4*)(x + off), g4 = *(const float4*)(gate + n0 + c0);
                *(float4*)(x1 + off) = make_float4(xv.x + g4.x * acc[i][0], xv.y + g4.y * acc[i][1], xv.z + g4.z * acc[i][2], xv.w + g4.w * acc[i][3]); }
        });
}
__global__ void __launch_bounds__(512) k_logits(const float* x1, const float* rstd, const float* g, const float* mod, const float* w_router, float* logits) {
    __shared__ __attribute__((aligned(16))) float sm[NG_SM];
    const int m0 = blockIdx.x * 64, b = m0 / T;
    const float* sh = mod + b * 6 * D + 3 * D; const float* scv = mod + b * 6 * D + 4 * D;
    ngemm_tile(sm, D,
        [&](int r, int k) { return x1[(size_t)(m0 + r) * D + k] * rstd[m0 + r] * g[k] * (1.f + scv[k]) + sh[k]; },
        [&](int k, int c) { return c < 64 ? w_router[(size_t)k * 64 + c] : 0.f; },
        [&](int r0, int c0, const float (&acc)[4][4]) {
            if (c0 < 64) {
#pragma unroll
                for (int i = 0; i < 4; ++i) *(float4*)(logits + (size_t)(m0 + r0 + i) * 64 + c0) = make_float4(acc[i][0], acc[i][1], acc[i][2], acc[i][3]); }
        });
}
__global__ void k_route(const float* logits, const float* bias, unsigned* cnt, int* ltok, float* lw) {
    const int wave = threadIdx.x >> 6, lane = threadIdx.x & 63;
    const int m = blockIdx.x * (blockDim.x >> 6) + wave; if (m >= M) return;
    const float lg = logits[(size_t)m * 64 + lane];
    const float score = 1.f / (1.f + __expf(-lg));
    const float biased = score + bias[lane];
    float m1 = biased;
    m1 = fmaxf(m1, __shfl_xor(m1, 1)); m1 = fmaxf(m1, __shfl_xor(m1, 2)); m1 = fmaxf(m1, __shfl_xor(m1, 4));
    unsigned long long eq = __ballot(biased == m1);
    unsigned gb = (unsigned)(eq >> (lane & ~7)) & 0xffu;
    int first = __ffs(gb) - 1;
    float v2 = ((lane & 7) == first) ? -3e38f : biased;
    v2 = fmaxf(v2, __shfl_xor(v2, 1)); v2 = fmaxf(v2, __shfl_xor(v2, 2)); v2 = fmaxf(v2, __shfl_xor(v2, 4));
    const float gs = m1 + v2; const int g = lane >> 3;
    int grank = 0;
#pragma unroll
    for (int j = 0; j < 8; ++j) { float o = __shfl(gs, j * 8); grank += (o > gs || (o == gs && j < g)) ? 1 : 0; }
    const float masked = grank < 4 ? biased : NEGF;
    int rank = 0;
#pragma unroll
    for (int j = 0; j < 64; ++j) { float o = __shfl(masked, j); rank += (o > masked || (o == masked && j < lane)) ? 1 : 0; }
    const bool selx = rank < 8;
    const float ssum = wave_sum(selx ? score : 0.f);
    if (selx) {
        unsigned pos = atomicAdd(&cnt[lane], 1u);
        ltok[lane * M + pos] = m * 16 + rank; lw[lane * M + pos] = score / ssum * 2.5f;
    }
    if (lane == 0) { ltok[64 * M + m] = m * 16 + 8; lw[64 * M + m] = 1.f; }
}
__device__ __forceinline__ int expert_count(const unsigned* cnt, int e) { return e < 64 ? (int)cnt[e] : M; }
__device__ __forceinline__ int find_expert(const unsigned* cnt, int R0, int& local, int& count) {
    int start = 0;
    for (int e = 0; e < 65; ++e) { int c = expert_count(cnt, e); int pc = (c + 255) / 256 * 256; if (R0 < start + pc) { local = R0 - start; count = c; return e; } start += pc; }
    return -1;
}
__global__ void __launch_bounds__(512) k_gateup(const bf16* xn, const unsigned* cnt, const int* ltok, const float* wg, const float* wu, const float* wsg, const float* wsu, bf16* act) {
    __shared__ __attribute__((aligned(16))) float sm[NG_SM];
    __shared__ int stok[64];
    const int R0 = (blockIdx.x / 8) * 64, j0 = (blockIdx.x % 8) * 64;
    int local, count; const int e = find_expert(cnt, R0, local, count);
    if (e < 0 || local >= count) return;
    if (threadIdx.x < 64) { int r = local + threadIdx.x; stok[threadIdx.x] = r < count ? (ltok[e * M + r] >> 4) : (ltok[e * M + count - 1] >> 4); }
    __syncthreads();
    const float* G = e < 64 ? wg + (size_t)e * D * EH : wsg; const float* U = e < 64 ? wu + (size_t)e * D * EH : wsu;
    ngemm_tile(sm, D,
        [&](int r, int k) { return bf2f(xn[(size_t)stok[r] * D + k]); },
        [&](int k, int c) { return (c & 1) ? U[(size_t)k * EH + j0 + (c >> 1)] : G[(size_t)k * EH + j0 + (c >> 1)]; },
        [&](int r0, int c0, const float (&acc)[4][4]) {
#pragma unroll
            for (int i = 0; i < 4; ++i) { bf16* o = act + (size_t)(R0 + r0 + i) * EH + j0 + (c0 >> 1);
                o[0] = f2bf(silu_f(acc[i][0]) * acc[i][1]); o[1] = f2bf(silu_f(acc[i][2]) * acc[i][3]); }
        });
}
__global__ void __launch_bounds__(512) k_down(const bf16* act, const unsigned* cnt, const int* ltok, const float* lw, const float* wd, const float* wsd, bf16* yslot) {
    __shared__ __attribute__((aligned(16))) float sm[NG_SM];
    __shared__ int stok[64]; __shared__ float sw[64];
    const int R0 = (blockIdx.x / 16) * 64, n0 = (blockIdx.x % 16) * 128;
    int local, count; const int e = find_expert(cnt, R0, local, count);
    if (e < 0 || local >= count) return;
    if (threadIdx.x < 64) { int r = local + threadIdx.x; stok[threadIdx.x] = r < count ? ltok[e * M + r] : -1; sw[threadIdx.x] = r < count ? lw[e * M + r] : 0.f; }
    __syncthreads();
    const float* W = e < 64 ? wd + (size_t)e * EH * D : wsd;
    ngemm_tile(sm, EH,
        [&](int r, int k) { return bf2f(act[(size_t)(R0 + r) * EH + k]); },
        [&](int k, int c) { return W[(size_t)k * D + n0 + c]; },
        [&](int r0, int c0, const float (&acc)[4][4]) {
#pragma unroll
            for (int i = 0; i < 4; ++i) { int tk = stok[r0 + i]; if (tk < 0) continue; float w = sw[r0 + i];
                bf16* o = yslot + ((size_t)(tk >> 4) * 9 + (tk & 15)) * D + n0 + c0;
                ushort4 v; v.x = f2bf(acc[i][0] * w); v.y = f2bf(acc[i][1] * w); v.z = f2bf(acc[i][2] * w); v.w = f2bf(acc[i][3] * w); *(ushort4*)o = v; }
        });
}
__global__ void k_final(const float* x1, const bf16* yslot, const float* mod, const float* gout, float* out) {
    int wave = threadIdx.x >> 6, lane = threadIdx.x & 63;
    int m = blockIdx.x * (blockDim.x >> 6) + wave; if (m >= M) return;
    const float* gate = mod + (m / T) * 6 * D + 5 * D;
    float4 v[8]; float s = 0.f;
#pragma unroll
    for (int j = 0; j < 8; ++j) {
        int col = (lane + 64 * j) * 4;
        float y0 = 0.f, y1 = 0.f, y2 = 0.f, y3 = 0.f;
#pragma unroll
        for (int k = 0; k < 9; ++k) { ushort4 u = *(const ushort4*)(yslot + ((size_t)m * 9 + k) * D + col); y0 += bf2f(u.x); y1 += bf2f(u.y); y2 += bf2f(u.z); y3 += bf2f(u.w); }
        float4 xv = *(const float4*)(x1 + (size_t)m * D + col), g4 = *(const float4*)(gate + col);
        v[j] = make_float4(xv.x + g4.x * y0, xv.y + g4.y * y1, xv.z + g4.z * y2, xv.w + g4.w * y3);
        s += v[j].x * v[j].x + v[j].y * v[j].y + v[j].z * v[j].z + v[j].w * v[j].w;
    }
    s = wave_sum(s);
    float rstd = rsqrtf(s * (1.f / D) + NORM_EPS);
#pragma unroll
    for (int j = 0; j < 8; ++j) { int col = (lane + 64 * j) * 4; float4 gg = *(const float4*)(gout + col);
        *(float4*)(out + (size_t)m * D + col) = make_float4(v[j].x * rstd * gg.x, v[j].y * rstd * gg.y, v[j].z * rstd * gg.z, v[j].w * rstd * gg.w); }
}
}

#define LAS __attribute__((address_space(3)))
#define GAS __attribute__((address_space(1)))
namespace pg8 {
typedef unsigned short bf16_t;
typedef short bf16x8 __attribute__((ext_vector_type(8)));
typedef float f32x4 __attribute__((ext_vector_type(4)));
typedef unsigned u32x4 __attribute__((ext_vector_type(4)));
constexpr int BM = 256, BK = 64, HALF = 128, HTB = HALF * BK * 2, STAGE_BYTES = 8 * HTB, NXCD = 8, WGM = 8;

__host__ __device__ __forceinline__ int lds_byte(int r, int c) { const int st = (r >> 4) * 2 + (c >> 5), rr = r & 15, cc = c & 31, ob = rr * 64 + cc * 2; return st * 1024 + (ob ^ (((ob >> 9) & 1) << 5)); }
__host__ __device__ __forceinline__ void stage_rc(int b, int& R, int& C) { const int st = b / 1024, sb = b % 1024, swz = sb ^ (((sb >> 9) & 1) << 5); R = (st >> 1) * 16 + swz / 64; C = (st & 1) * 32 + (swz % 64) / 2; }
__host__ __device__ __forceinline__ int perm32(int rho) { const int n = rho >> 4, i = rho & 15; return 8 * (i >> 2) + 4 * n + (i & 3); }

struct Unit { int pm, pn, pb, e, r0, cnt; };
struct Gemm { const bf16_t* A; const bf16_t* Bt; int K; };

__device__ __forceinline__ void tile_of(int L, int nM, int nN, int& pm, int& pn) {
    const int nwg = nM * nN; int wgid = L;
    { const int q = nwg / NXCD, r = nwg % NXCD, xcd = wgid % NXCD, off = wgid / NXCD; wgid = (xcd < r ? xcd * (q + 1) : r * (q + 1) + (xcd - r) * q) + off; }
    const int nig = WGM * nN, gid = wgid / nig, fm = gid * WGM, gsz = (nM - fm) < WGM ? (nM - fm) : WGM;
    pm = fm + ((wgid % nig) % gsz); pn = (wgid % nig) / gsz;
}
struct StaticOrder {
    int nM, nN, nwg, G, c;
    __device__ __forceinline__ void init(int Mrows, int N, int G_, int c_) { nM = Mrows / BM; nN = N / BM; nwg = nM * nN; G = G_; c = c_; }
    __device__ __forceinline__ bool next(int i, Unit& u) const {
        const int L = i * G + c; if (L >= nwg) return false;
        tile_of(L, nM, nN, u.pm, u.pn); u.pb = u.pn; u.e = 0; u.r0 = 0; u.cnt = 256; return true;
    }
    __device__ __forceinline__ void rows(const Unit&, const int*& lp, int& cnt) const { lp = nullptr; cnt = 256; }
};
struct MoeOrder {
    int nM, nN, nwg, G, c; const LAS int* tile_e; const LAS int* tile_start; const LAS int* ecount; const int* ltok;
    __device__ __forceinline__ bool next(int i, Unit& u) const {
        const int L = i * G + c; if (L >= nwg) return false;
        tile_of(L, nM, nN, u.pm, u.pn);
        const int e = tile_e[u.pm], jl = u.pm - tile_start[e], rem = ecount[e] - jl * 256;
        u.e = e; u.r0 = jl * 256; u.cnt = rem < 256 ? rem : 256; u.pb = e * nN + u.pn; return true;
    }
    __device__ __forceinline__ void rows(const Unit& u, const int*& lp, int& cnt) const { lp = ltok + (size_t)u.e * 8192 + u.r0; cnt = u.cnt; }
};

__device__ __forceinline__ unsigned cvt_pk_bf16(float lo, float hi) { unsigned r; asm volatile("v_cvt_pk_bf16_f32 %0, %1, %2" : "=v"(r) : "v"(lo), "v"(hi)); return r; }

template <class Epi, class Sched, bool GATHER, bool ALIGN_EPI>
__device__ __forceinline__ void gemm_phase(LAS unsigned char* lds, LAS unsigned char* tab, const Gemm g, const Sched& S, const Epi& E, const int wid) {
    const int lane = lane_id(), tid = wid * 64 + lane, wr = wid >> 2, wc = wid & 3, fr = lane & 15, fq = lane >> 4;
    const int K = g.K, nt = K / BK;
    unsigned voffA[2][2], voffB[2];
#pragma unroll
    for (int i = 0; i < 2; ++i) { int R, C; stage_rc(tid * 16 + i * 8192, R, C); const int Rb = Epi::PERM ? ((R & ~31) + perm32(R & 31)) : R;
        voffA[0][i] = (unsigned)(R * K + C) * 2u; voffA[1][i] = (unsigned)((R + HALF) * K + C) * 2u; voffB[i] = (unsigned)(Rb * K + C) * 2u; }
    const size_t kstep = (size_t)(BK * 2);
    const size_t hstep = (size_t)HALF * K * 2;
    const size_t tstep = 2 * hstep;
    const unsigned ldsw = (unsigned)wid * 1024u;
    const int aoff = lds_byte(wr * 64 + fr, fq * 8), boff = lds_byte(wc * 32 + fr, fq * 8);
#define PG8_SA(b, h) (((b) * 2 + (h)) * HTB)
#define PG8_SB(b, h) ((4 + (b) * 2 + (h)) * HTB)
#define PG8_STAGE(bufoff, gbase, voff) do { _Pragma("unroll") for (int _i = 0; _i < 2; ++_i) \
        __builtin_amdgcn_global_load_lds((const unsigned*)((const char*)(gbase) + (voff)[_i]), (LAS unsigned*)(lds + (bufoff) + ldsw + _i * 8192), 16, 0, 0); } while (0)
#define PG8_LDA(dst, b, h) do { _Pragma("unroll") for (int m = 0; m < 4; ++m) _Pragma("unroll") for (int k = 0; k < 2; ++k) dst[m][k] = *(const LAS bf16x8*)(lds + PG8_SA(b, h) + aoff + m * 2048 + k * 1024); } while (0)
#define PG8_LDB(dst, b, h) do { _Pragma("unroll") for (int n = 0; n < 2; ++n) _Pragma("unroll") for (int k = 0; k < 2; ++k) dst[n][k] = *(const LAS bf16x8*)(lds + PG8_SB(b, h) + boff + n * 2048 + k * 1024); } while (0)
#define PG8_MMA(ai, bj, At, Bt) do { __builtin_amdgcn_s_setprio(1); _Pragma("unroll") for (int m = 0; m < 4; ++m) _Pragma("unroll") for (int n = 0; n < 2; ++n) _Pragma("unroll") for (int k = 0; k < 2; ++k) \
        acc[ai][bj][m][n] = __builtin_amdgcn_mfma_f32_16x16x32_bf16(Bt[n][k], At[m][k], acc[ai][bj][m][n], 0, 0, 0); __builtin_amdgcn_s_setprio(0); } while (0)
#define PG8_WAIT_V(n) asm volatile("s_waitcnt vmcnt(" #n ")" ::: "memory")
#define PG8_WAIT_L(n) asm volatile("s_waitcnt lgkmcnt(" #n ")" ::: "memory")
#define PG8_BAR __builtin_amdgcn_s_barrier()
#define PG8_SCHED __builtin_amdgcn_sched_barrier(0)
    Unit cur, nxt; int ui = 0;
    if (!S.next(0, cur)) return;
    if constexpr (GATHER) {
        const int* lp; int cnt; S.rows(cur, lp, cnt);
#pragma unroll
        for (int h = 0; h < 2; ++h)
#pragma unroll
            for (int i = 0; i < 2; ++i) { int R, C; stage_rc(tid * 16 + i * 8192, R, C); const int r = h * HALF + R; const int tk = r < cnt ? (lp[r] >> 4) : 0; voffA[h][i] = (unsigned)(tk * K + C) * 2u; }
    }
    f32x4 acc[2][2][4][2];
#pragma unroll
    for (int a = 0; a < 2; ++a)
#pragma unroll
        for (int b = 0; b < 2; ++b)
#pragma unroll
            for (int m = 0; m < 4; ++m)
#pragma unroll
                for (int n = 0; n < 2; ++n) acc[a][b][m][n] = (f32x4){0.f, 0.f, 0.f, 0.f};
    bf16x8 At[4][2], B0[2][2], B1[2][2];
    const char* cA = GATHER ? (const char*)g.A : (const char*)g.A + (size_t)cur.pm * tstep; const char* cB = (const char*)g.Bt + (size_t)cur.pb * tstep;
    PG8_STAGE(PG8_SB(0, 0), cB, voffB); PG8_STAGE(PG8_SB(0, 1), cB + hstep, voffB); PG8_STAGE(PG8_SA(0, 0), cA, voffA[0]); PG8_STAGE(PG8_SA(0, 1), cA, voffA[1]);
    if (wr == 1) PG8_BAR;
    PG8_WAIT_V(2); PG8_BAR;
    PG8_STAGE(PG8_SB(1, 0), cB + kstep, voffB); PG8_STAGE(PG8_SA(1, 0), cA + kstep, voffA[0]); PG8_STAGE(PG8_SB(1, 1), cB + hstep + kstep, voffB);
    PG8_WAIT_V(6); PG8_BAR;
    for (;;) {
        const bool has_next = S.next(ui + 1, nxt);
        int ncnt = 256;
        if constexpr (GATHER) { if (has_next) { const int* nlp; S.rows(nxt, nlp, ncnt);
            if (wid == 0) __builtin_amdgcn_global_load_lds((const unsigned*)(nlp + lane * 4), (LAS unsigned*)tab, 16, 0, 0); } }
        const char* nA = has_next ? (GATHER ? (const char*)g.A : (const char*)g.A + (size_t)nxt.pm * tstep) : cA; const char* nB = has_next ? (const char*)g.Bt + (size_t)nxt.pb * tstep : cB;
        for (int t = 0; t < nt; t += 2) {
            const bool last = (t == nt - 2);
            const char* a1 = cA + (size_t)(t + 1) * kstep;
            const char* a2 = last ? nA : cA + (size_t)(t + 2) * kstep; const char* b2 = last ? nB : cB + (size_t)(t + 2) * kstep;
            const char* a3 = a2 + kstep; const char* b3 = b2 + kstep;
            PG8_LDB(B0, 0, 0); PG8_LDB(B1, 0, 1); PG8_SCHED; PG8_LDA(At, 0, 0); PG8_STAGE(PG8_SA(1, 1), a1, voffA[1]);
            if constexpr (GATHER) { if (last && has_next) {
#pragma unroll
                for (int h = 0; h < 2; ++h)
#pragma unroll
                    for (int i = 0; i < 2; ++i) { int R, C; stage_rc(tid * 16 + i * 8192, R, C); const int r = h * HALF + R; const int v = ((const LAS int*)tab)[r]; const int tk = r < ncnt ? (v >> 4) : 0; voffA[h][i] = (unsigned)(tk * K + C) * 2u; } } }
            PG8_WAIT_V(8); PG8_WAIT_L(0); PG8_BAR; PG8_MMA(0, 0, At, B0); PG8_MMA(0, 1, At, B1); PG8_BAR; PG8_SCHED;
            PG8_LDA(At, 0, 1); PG8_STAGE(PG8_SB(0, 0), b2, voffB); PG8_STAGE(PG8_SB(0, 1), b2 + hstep, voffB); PG8_STAGE(PG8_SA(0, 0), a2, voffA[0]);
            PG8_WAIT_V(8); PG8_WAIT_L(0); PG8_BAR; PG8_MMA(1, 0, At, B0); PG8_MMA(1, 1, At, B1); PG8_BAR; PG8_SCHED;
            PG8_LDB(B0, 1, 0); PG8_LDB(B1, 1, 1); PG8_SCHED; PG8_LDA(At, 1, 0); PG8_STAGE(PG8_SA(0, 1), a2, voffA[1]);
            PG8_WAIT_V(8); PG8_WAIT_L(0); PG8_BAR; PG8_MMA(0, 0, At, B0); PG8_MMA(0, 1, At, B1); PG8_BAR; PG8_SCHED;
            PG8_LDA(At, 1, 1); PG8_STAGE(PG8_SB(1, 0), b3, voffB); PG8_STAGE(PG8_SB(1, 1), b3 + hstep, voffB); PG8_STAGE(PG8_SA(1, 0), a3, voffA[0]);
            PG8_WAIT_V(8); PG8_WAIT_L(0); PG8_BAR; PG8_MMA(1, 0, At, B0); PG8_MMA(1, 1, At, B1); PG8_BAR; PG8_SCHED;
        }
        if constexpr (ALIGN_EPI) { if (wr == 0) PG8_BAR; }
        E(acc, cur, wr, wc, fr, fq);
        if (!has_next) break;
#pragma unroll
        for (int a = 0; a < 2; ++a)
#pragma unroll
            for (int b = 0; b < 2; ++b)
#pragma unroll
                for (int m = 0; m < 4; ++m)
#pragma unroll
                    for (int n = 0; n < 2; ++n) acc[a][b][m][n] = (f32x4){0.f, 0.f, 0.f, 0.f};
        cur = nxt; cA = nA; cB = nB; ++ui;
        if constexpr (ALIGN_EPI) { if (wr == 1) PG8_BAR; }
    }
    PG8_WAIT_V(0);
    if constexpr (!ALIGN_EPI) { if (wr == 0) PG8_BAR; }
    PG8_BAR;
#undef PG8_SA
#undef PG8_SB
#undef PG8_STAGE
#undef PG8_LDA
#undef PG8_LDB
#undef PG8_MMA
#undef PG8_WAIT_V
#undef PG8_WAIT_L
#undef PG8_BAR
#undef PG8_SCHED
}
}
namespace pg8 {
struct EpiProj {
    static constexpr bool PERM = true;
    bf16_t* O; const float2* ropem; const float2* roper; float* kmean;
    __device__ __forceinline__ void operator()(const f32x4 (&acc)[2][2][4][2], const Unit& u, int wr, int wc, int fr, int fq) const {
        const int t = u.pn >> 2, coltile = (u.pn & 3) * BM;
        bf16_t* base = O + (size_t)t * M * 1024;
        const int row0 = u.pm * BM + wr * 64 + fr, col0 = coltile + wc * 32 + 8 * fq;
        const bool moba_rot = (t < 2) && (wc == 0);
        const bool ret_rot = (t == 3) || (t == 4);
        const float osc = (t == 4) ? 0.0625f : 1.f;
        float ks[2][8];
#pragma unroll
        for (int bj = 0; bj < 2; ++bj)
#pragma unroll
            for (int j = 0; j < 8; ++j) ks[bj][j] = 0.f;
#pragma unroll
        for (int ai = 0; ai < 2; ++ai)
#pragma unroll
            for (int m = 0; m < 4; ++m) {
                const int row = row0 + ai * HALF + m * 16;
                float v[2][8];
#pragma unroll
                for (int bj = 0; bj < 2; ++bj)
#pragma unroll
                    for (int j = 0; j < 8; ++j) v[bj][j] = acc[ai][bj][m][j >> 2][j & 3];
                if (moba_rot) {
                    const f32x4* cs4 = (const f32x4*)(ropem + (size_t)row * 16 + 8 * (fq & 1));
                    f32x4 cs[4];
#pragma unroll
                    for (int q = 0; q < 4; ++q) cs[q] = cs4[q];
#pragma unroll
                    for (int bj = 0; bj < 2; ++bj)
#pragma unroll
                        for (int j = 0; j < 8; ++j) { const float c = cs[j >> 1][(j & 1) * 2], s = cs[j >> 1][(j & 1) * 2 + 1]; const float xp = __shfl_xor(v[bj][j], 32);
                            v[bj][j] = (fq < 2) ? v[bj][j] * c - xp * s : v[bj][j] * c + xp * s; }
                } else if (ret_rot) {
                    const f32x4* cs4 = (const f32x4*)(roper + (size_t)row * 128 + wc * 32 + 8 * fq);
                    f32x4 cs[4];
#pragma unroll
                    for (int q = 0; q < 4; ++q) cs[q] = cs4[q];
#pragma unroll
                    for (int j = 0; j < 8; ++j) { const float c = cs[j >> 1][(j & 1) * 2], s = cs[j >> 1][(j & 1) * 2 + 1]; const float x1 = v[0][j], x2 = v[1][j];
                        v[0][j] = (x1 * c - x2 * s) * osc; v[1][j] = (x2 * c + x1 * s) * osc; }
                }
#pragma unroll
                for (int bj = 0; bj < 2; ++bj) {
                    u32x4 w; w.x = cvt_pk_bf16(v[bj][0], v[bj][1]); w.y = cvt_pk_bf16(v[bj][2], v[bj][3]); w.z = cvt_pk_bf16(v[bj][4], v[bj][5]); w.w = cvt_pk_bf16(v[bj][6], v[bj][7]);
                    *(u32x4*)(base + (size_t)row * 1024 + col0 + bj * HALF) = w;
#pragma unroll
                    for (int j = 0; j < 8; ++j) ks[bj][j] += v[bj][j];
                }
            }
        if (t == 1) {
#pragma unroll
            for (int bj = 0; bj < 2; ++bj)
#pragma unroll
                for (int j = 0; j < 8; ++j) { float s = ks[bj][j]; s += __shfl_xor(s, 1); s += __shfl_xor(s, 2); s += __shfl_xor(s, 4); s += __shfl_xor(s, 8);
                    if (fr == 0) atomicAdd(kmean + (size_t)u.pm * 1024 + col0 + bj * HALF + j, s * (1.f / 256.f)); }
        }
    }
};
struct EpiOut {
    static constexpr bool PERM = false;
    const float* x; const float* mod; float* x1;
    __device__ __forceinline__ void operator()(const f32x4 (&acc)[2][2][4][2], const Unit& u, int wr, int wc, int fr, int fq) const {
        const int row0 = u.pm * BM + wr * 64 + fr, col0 = u.pn * BM + wc * 32 + 4 * fq;
        const float* gate = mod + (u.pm / 16) * 6 * D + 2 * D;
#pragma unroll
        for (int bj = 0; bj < 2; ++bj)
#pragma unroll
            for (int n = 0; n < 2; ++n) { const int col = col0 + bj * HALF + n * 16; const f32x4 g4 = *(const f32x4*)(gate + col);
#pragma unroll
                for (int ai = 0; ai < 2; ++ai)
#pragma unroll
                    for (int m = 0; m < 4; ++m) { const size_t off = (size_t)(row0 + ai * HALF + m * 16) * D + col; const f32x4 xv = *(const f32x4*)(x + off);
                        *(f32x4*)(x1 + off) = xv + g4 * acc[ai][bj][m][n]; } }
    }
};
struct EpiAct {
    static constexpr bool PERM = true;
    bf16_t* act;
    __device__ __forceinline__ void operator()(const f32x4 (&acc)[2][2][4][2], const Unit& u, int wr, int wc, int fr, int fq) const {
        const int row0 = u.pm * BM + wr * 64 + fr, col0 = u.pn * HALF + wc * 32 + 8 * fq;
#pragma unroll
        for (int ai = 0; ai < 2; ++ai)
#pragma unroll
            for (int m = 0; m < 4; ++m) { float o[8];
#pragma unroll
                for (int j = 0; j < 8; ++j) { const float gt = acc[ai][0][m][j >> 2][j & 3], up = acc[ai][1][m][j >> 2][j & 3]; o[j] = gt / (1.f + __expf(-gt)) * up; }
                u32x4 w; w.x = cvt_pk_bf16(o[0], o[1]); w.y = cvt_pk_bf16(o[2], o[3]); w.z = cvt_pk_bf16(o[4], o[5]); w.w = cvt_pk_bf16(o[6], o[7]);
                *(u32x4*)(act + (size_t)(row0 + ai * HALF + m * 16) * EH + col0) = w; }
    }
};
struct EpiDown {
    static constexpr bool PERM = true;
    bf16_t* yslot; const int* ltok; const float* lw;
    __device__ __forceinline__ void operator()(const f32x4 (&acc)[2][2][4][2], const Unit& u, int wr, int wc, int fr, int fq) const {
        const int col0 = u.pn * BM + wc * 32 + 8 * fq;
        const int* lt = ltok + (size_t)u.e * 8192 + u.r0; const float* lwp = lw + (size_t)u.e * 8192 + u.r0;
#pragma unroll
        for (int ai = 0; ai < 2; ++ai)
#pragma unroll
            for (int m = 0; m < 4; ++m) { const int r = ai * HALF + wr * 64 + m * 16 + fr;
                if (r < u.cnt) { const int tk = lt[r]; const float w = lwp[r]; bf16_t* orow = yslot + ((size_t)(tk >> 4) * 9 + (tk & 15)) * D + col0;
#pragma unroll
                    for (int bj = 0; bj < 2; ++bj) { const f32x4 v0 = acc[ai][bj][m][0] * w, v1 = acc[ai][bj][m][1] * w;
                        u32x4 o; o.x = cvt_pk_bf16(v0[0], v0[1]); o.y = cvt_pk_bf16(v0[2], v0[3]); o.z = cvt_pk_bf16(v1[0], v1[1]); o.w = cvt_pk_bf16(v1[2], v1[3]);
                        *(u32x4*)(orow + bj * HALF) = o; } } }
    }
};
}
namespace att {
typedef short bf16x8 __attribute__((ext_vector_type(8)));
typedef short s16x4 __attribute__((ext_vector_type(4)));
typedef float f32x16 __attribute__((ext_vector_type(16)));
typedef float f32x4 __attribute__((ext_vector_type(4)));
typedef unsigned u32x4 __attribute__((ext_vector_type(4)));
constexpr int DH = 128, QP = 1024, OP = 2048;
constexpr float SCALE = 0.08838834764831845f, THR = 8.f;
constexpr int NW = 8, QBLK = 32, KVBLK = 64, QB = NW * QBLK;
constexpr int SHM_V = KVBLK * DH * 2, SHM_K = KVBLK * DH * 2;
constexpr int LDS_BYTES = 2 * SHM_V + 2 * SHM_K + NW * 64 * 4;
#define KSWZ(row, colB) ((row) * 256 + ((colB) ^ (((row) & 7) << 4)))
#define SBAR() __builtin_amdgcn_sched_barrier(0)
__device__ __forceinline__ int v_st(int k, int c) { const int kk = (k & ~0xC) | ((k & 4) << 1) | ((k & 8) >> 1); return ((kk >> 3) * 4 + (c >> 5)) * 512 + ((kk & 7) * 32 + (c & 31)) * 2; }
__device__ __forceinline__ int v_rd_base(int lane) { return ((lane & 3) << 3) | (((lane >> 2) & 3) << 6) | (((lane >> 4) & 1) << 5) | (((lane >> 5) & 1) << 8); }
constexpr int v_rd_off(int d0, int ks, int half) { return d0 * 512 + ks * 4096 + half * 2048; }
__device__ __forceinline__ int crow(int r, int hi) { return (r & 3) + 8 * (r >> 2) + 4 * hi; }
__device__ __forceinline__ unsigned cvtpk(float lo, float hi) { unsigned r; asm volatile("v_cvt_pk_bf16_f32 %0, %1, %2" : "=v"(r) : "v"(lo), "v"(hi)); return r; }
__device__ __forceinline__ bf16x8 load8(const bf16* p) { return *reinterpret_cast<const bf16x8*>(p); }
__device__ __forceinline__ void mask_tile(f32x16& p0, f32x16& p1, int dq) {
    const float NEG = -__builtin_inff();
#pragma unroll
    for (int r = 0; r < 16; ++r) { const int c = (r & 3) + 8 * (r >> 2);
        if (dq - c < 0) p0[r] = NEG;
        if (dq - c - 32 < 0) p1[r] = NEG; }
}
__device__ __forceinline__ void partialSM(f32x16& p0, f32x16& p1, float& m_reg, float& mn, float& alpha) {
    float pmax = p0[0];
#pragma unroll
    for (int r = 1; r < 16; ++r) pmax = fmaxf(pmax, p0[r]);
#pragma unroll
    for (int r = 0; r < 16; ++r) pmax = fmaxf(pmax, p1[r]);
    { auto rr = __builtin_amdgcn_permlane32_swap(__float_as_uint(pmax), __float_as_uint(pmax), false, false);
      pmax = fmaxf(__uint_as_float(rr[0]), __uint_as_float(rr[1])); }
    constexpr float C2 = 1.4426950408889634f * SCALE;
    if (__builtin_expect(__all((pmax - m_reg) * SCALE <= THR), 1)) { mn = m_reg; alpha = 1.f; }
    else { mn = fmaxf(m_reg, pmax); alpha = __builtin_amdgcn_exp2f((m_reg - mn) * C2); m_reg = mn; }
    const float mnL = -mn * C2;
#pragma unroll
    for (int r = 0; r < 16; ++r) p0[r] = fmaf(p0[r], C2, mnL);
#pragma unroll
    for (int r = 0; r < 16; ++r) p1[r] = fmaf(p1[r], C2, mnL);
#pragma unroll
    for (int r = 0; r < 16; ++r) p0[r] = __builtin_amdgcn_exp2f(p0[r]);
}
__device__ __forceinline__ void finishSM(f32x16& p0, f32x16& p1, float alpha, float& l_reg, bf16x8& pa0, bf16x8& pa1, bf16x8& pa2, bf16x8& pa3) {
#pragma unroll
    for (int r = 0; r < 16; ++r) p1[r] = __builtin_amdgcn_exp2f(p1[r]);
    float ps = 0;
#pragma unroll
    for (int r = 0; r < 16; ++r) ps += p0[r];
#pragma unroll
    for (int r = 0; r < 16; ++r) ps += p1[r];
    { auto rr = __builtin_amdgcn_permlane32_swap(__float_as_uint(ps), __float_as_uint(ps), false, false);
      ps = __uint_as_float(rr[0]) + __uint_as_float(rr[1]); }
    l_reg = l_reg * alpha + ps;
#define PK4(P, B_, OUT) do { unsigned a0 = cvtpk(P[B_+0], P[B_+1]), a1 = cvtpk(P[B_+2], P[B_+3]);                          \
        unsigned b0 = cvtpk(P[B_+4], P[B_+5]), b1 = cvtpk(P[B_+6], P[B_+7]);                                             \
        auto r0 = __builtin_amdgcn_permlane32_swap(a0, b0, false, false); auto r1 = __builtin_amdgcn_permlane32_swap(a1, b1, false, false); \
        u32x4 w = {r0[0], r1[0], r0[1], r1[1]}; OUT = *reinterpret_cast<bf16x8*>(&w); } while (0)
    PK4(p0, 0, pa0); PK4(p0, 8, pa1); PK4(p1, 0, pa2); PK4(p1, 8, pa3);
#undef PK4
}
template <int KB>
__device__ __forceinline__ void qkt(f32x16& p0, f32x16& p1, const char* K_lds, int r32, int hi, const bf16x8* qr) {
    p0 = f32x16{}; p1 = f32x16{};
    const char* kb[4];
#pragma unroll
    for (int dd = 0; dd < 4; ++dd) kb[dd] = K_lds + KB * SHM_K + KSWZ(r32, (dd * 16 + hi * 8) * 2);
#pragma unroll
    for (int d0 = 0; d0 < 8; ++d0) { const char* a = kb[d0 & 3] + (d0 >> 2) * 128;
        bf16x8 b0 = *reinterpret_cast<const bf16x8*>(a);
        bf16x8 b1 = *reinterpret_cast<const bf16x8*>(a + 32 * 256);
        p0 = __builtin_amdgcn_mfma_f32_32x32x16_bf16(b0, qr[d0], p0, 0, 0, 0);
        p1 = __builtin_amdgcn_mfma_f32_32x32x16_bf16(b1, qr[d0], p1, 0, 0, 0); }
}
template <int VB>
__device__ __forceinline__ void pv_tile(f32x16* o, int vb0, bf16x8 pa0, bf16x8 pa1, bf16x8 pa2, bf16x8 pa3) {
#define TRRD(dst, off) asm volatile("ds_read_b64_tr_b16 %0, %1 offset:%2" : "=&v"(dst) : "v"(vb0), "i"(off) : "memory")
#define PV_D0(d0) do { s16x4 l0, l1, l2, l3, h0, h1, h2, h3; constexpr int b_ = VB * SHM_V + v_rd_off(d0, 0, 0); \
        TRRD(l0, b_); TRRD(h0, b_ + 2048); TRRD(l1, b_ + 4096); TRRD(h1, b_ + 6144); TRRD(l2, b_ + 8192); TRRD(h2, b_ + 10240); TRRD(l3, b_ + 12288); TRRD(h3, b_ + 14336); \
        asm volatile("s_waitcnt lgkmcnt(0)" ::: "memory"); SBAR(); \
        o[d0] = __builtin_amdgcn_mfma_f32_32x32x16_bf16(pa0, (bf16x8){l0[0], l0[1], l0[2], l0[3], h0[0], h0[1], h0[2], h0[3]}, o[d0], 0, 0, 0);   \
        o[d0] = __builtin_amdgcn_mfma_f32_32x32x16_bf16(pa1, (bf16x8){l1[0], l1[1], l1[2], l1[3], h1[0], h1[1], h1[2], h1[3]}, o[d0], 0, 0, 0);   \
        o[d0] = __builtin_amdgcn_mfma_f32_32x32x16_bf16(pa2, (bf16x8){l2[0], l2[1], l2[2], l2[3], h2[0], h2[1], h2[2], h2[3]}, o[d0], 0, 0, 0);   \
        o[d0] = __builtin_amdgcn_mfma_f32_32x32x16_bf16(pa3, (bf16x8){l3[0], l3[1], l3[2], l3[3], h3[0], h3[1], h3[2], h3[3]}, o[d0], 0, 0, 0); } while (0)
    PV_D0(0); PV_D0(1); PV_D0(2); PV_D0(3);
#undef PV_D0
#undef TRRD
}
struct BlockRef { const unsigned char* ws; int item; };
__device__ __forceinline__ int it_bh(int item) { return (item & 7) * 2 + ((item >> 3) & 1); }
__device__ __forceinline__ int it_qb(int item) { return 15 - (item >> 4); }
__device__ __forceinline__ const bf16* it_Q(const BlockRef& r) { const int bh = it_bh(r.item), b = bh >> 3, h = bh & 7; return (const bf16*)(r.ws + WS_PROJ) + (size_t)(b * T + it_qb(r.item) * 256) * 1024 + h * 128; }
__device__ __forceinline__ const bf16* it_K(const BlockRef& r) { const int bh = it_bh(r.item), b = bh >> 3, h = bh & 7; return (const bf16*)(r.ws + WS_PROJ) + (size_t)M * 1024 + (size_t)(b * T) * 1024 + h * 128; }
__device__ __forceinline__ const bf16* it_V(const BlockRef& r) { return it_K(r) + (size_t)M * 1024; }
__device__ __forceinline__ bf16* it_O(const BlockRef& r) { const int bh = it_bh(r.item), b = bh >> 3, h = bh & 7; return (bf16*)(r.ws + WS_MIX) + (size_t)(b * T + it_qb(r.item) * 256) * D + h * 128; }
__device__ __forceinline__ const float* it_KM(const BlockRef& r) { const int bh = it_bh(r.item), b = bh >> 3, h = bh & 7; return (const float*)(r.ws + WS_KMEAN) + (size_t)(b * 16) * 1024 + h * 128; }
struct Seam { bf16x8 qr[8]; bf16x8 st_v0, st_v1, st_k0, st_k1; };
#define ROW(p, k0, rr) ((p) + (size_t)((k0) + (rr)) * QP + sc)
#define VMW() asm volatile("s_waitcnt vmcnt(0)" ::: "memory")
#define VMWN(n) asm volatile("s_waitcnt vmcnt(%0)" :: "i"(n) : "memory")
#define SLOAD_H(Kp, Vp, k0) do { S.st_v0 = load8(ROW(Vp, k0, sr)); S.st_v1 = load8(ROW(Vp, k0, 32 + sr));              \
                         S.st_k0 = load8(ROW(Kp, k0, sr)); S.st_k1 = load8(ROW(Kp, k0, 32 + sr)); } while (0)
#define SWRITE_HK(bf) do { *(bf16x8*)(K_lds + (bf) * SHM_K + kws) = S.st_k0; *(bf16x8*)(K_lds + (bf) * SHM_K + kws + 32 * 256) = S.st_k1; } while (0)
#define SWRITE_HV(bf) do { *(bf16x8*)(V_lds + (bf) * SHM_V + vst0) = S.st_v0; *(bf16x8*)(V_lds + (bf) * SHM_V + vst1) = S.st_v1; } while (0)
#define SWRITE_H(bf) do { SWRITE_HV(bf); SWRITE_HK(bf); } while (0)
__device__ __forceinline__ void moba_prime(const BlockRef& cur, char* lds, Seam& S, const int wid) {
    const int lane = lane_id(), tid = wid * 64 + lane, r32 = lane & 31, hi = lane >> 5;
    const int sr = tid >> 4, sc = (tid & 15) * 8, kws = KSWZ(sr, sc * 2); char* K_lds = lds + 2 * SHM_V;
#pragma unroll
    for (int d0 = 0; d0 < 8; ++d0) S.qr[d0] = load8(it_Q(cur) + (size_t)(wid * QBLK + r32) * QP + d0 * 16 + hi * 8);
    SLOAD_H(it_K(cur), it_V(cur), 0); VMW(); SWRITE_HK(0);
    __syncthreads();
}
__device__ __forceinline__ void moba_block(const BlockRef& cur, const BlockRef& nxt, char* lds, Seam& S, const int wid) {
    const int lane = lane_id(), tid = wid * 64 + lane, r32 = lane & 31, hi = lane >> 5;
    const int qb = it_qb(cur.item), P0 = qb * 256;
    const int NT = (P0 + QB) / KVBLK;
    const int qlo = P0 + wid * QBLK, qm = qlo + r32 - 4 * hi;
    char* V_lds = lds; char* K_lds = lds + 2 * SHM_V;
    float* ws = (float*)(lds + 2 * SHM_V + 2 * SHM_K) + wid * 64; float* li_l = ws, * al_l = ws + 32;
    unsigned selmask = 0u;
    if (qb > 0) {
        float v0 = -__builtin_inff(), v1 = v0, v2 = v0; int i0 = -1, i1 = -1, i2 = -1;
#pragma unroll 1
        for (int n = 0; n < qb; ++n) {
            const float* km = it_KM(cur) + (size_t)n * 1024 + hi * 8;
            float g = 0.f;
#pragma unroll
            for (int d0 = 0; d0 < 8; ++d0) { const f32x4 ka = *(const f32x4*)(km + d0 * 16), kb4 = *(const f32x4*)(km + d0 * 16 + 4);
#pragma unroll
                for (int j = 0; j < 4; ++j) { g += __uint_as_float(((unsigned)(unsigned short)S.qr[d0][j]) << 16) * ka[j]; g += __uint_as_float(((unsigned)(unsigned short)S.qr[d0][4 + j]) << 16) * kb4[j]; } }
            g += __shfl_xor(g, 32);
            const bool b2 = g > v2, b1 = g > v1, b0 = g > v0;
            const float nv2 = b1 ? v1 : (b2 ? g : v2); const int ni2 = b1 ? i1 : (b2 ? n : i2);
            const float nv1 = b0 ? v0 : (b1 ? g : v1); const int ni1 = b0 ? i0 : (b1 ? n : i1);
            v2 = nv2; i2 = ni2; v1 = nv1; i1 = ni1; if (b0) { v0 = g; i0 = n; }
        }
        if (i0 >= 0) selmask |= 1u << i0; if (i1 >= 0) selmask |= 1u << i1; if (i2 >= 0) selmask |= 1u << i2;
    }
    float m_reg = -1e30f, l_reg = 0; f32x16 o[4] = {};
    const int sr = tid >> 4, sc = (tid & 15) * 8, vst0 = v_st(sr, sc), vst1 = v_st(32 + sr, sc), kws = KSWZ(sr, sc * 2);
    const int vb0 = (int)(uintptr_t)V_lds + v_rd_base(lane);
    const bf16* Kh = it_K(cur); const bf16* Vh = Kh + (size_t)M * 1024;
#define RESC(a) do { if (__any((a) < 1.f)) { if (hi == 0) al_l[r32] = (a); asm volatile("s_waitcnt lgkmcnt(0)" ::: "memory");              \
                     for (int d_ = 0; d_ < 4; ++d_) for (int r = 0; r < 16; ++r) o[d_][r] *= al_l[crow(r, hi)]; } } while (0)
#define KBASE(t) ((t) * KVBLK)
#define MASKT(P0_, P1_, t) do { const int kb_ = KBASE(t); const int nb_ = kb_ >> 8;                                              \
        if (nb_ < qb) { if (!((selmask >> nb_) & 1u)) { const float NEG_ = -__builtin_inff();                                   \
            _Pragma("unroll") for (int r = 0; r < 16; ++r) { P0_[r] = NEG_; P1_[r] = NEG_; } } }                                  \
        else if (kb_ + KVBLK - 1 > qlo) mask_tile(P0_, P1_, qm - kb_); } while (0)
    constexpr int NQL = 8;
#define SEAM_K0() do { VMWN(NQL); SWRITE_HK(0); SBAR(); } while (0)
    f32x16 pA0, pA1, pB0, pB1; float mnA, mnB, alA, alB; bf16x8 pa0, pa1, pa2, pa3;
    SWRITE_HV(0); SBAR();
    if (NT > 1) { SLOAD_H(Kh, Vh, KBASE(1)); }
    SBAR(); qkt<0>(pA0, pA1, K_lds, r32, hi, S.qr);
    MASKT(pA0, pA1, 0); partialSM(pA0, pA1, m_reg, mnA, alA);
    if (NT > 1) { VMW(); SWRITE_H(1); }
    __syncthreads();
#define HALF_STEP(PX0, PX1, mnX, alX, PY0, PY1, alY, t, KB, VB, SB) do {                                                      \
        SBAR(); qkt<KB>(PX0, PX1, K_lds, r32, hi, S.qr);                                                                      \
        finishSM(PY0, PY1, alY, l_reg, pa0, pa1, pa2, pa3); SBAR();                                                           \
        if ((t) + 1 < NT) { SLOAD_H(Kh, Vh, KBASE((t) + 1)); SBAR(); }                                                        \
        pv_tile<VB>(o, vb0, pa0, pa1, pa2, pa3); MASKT(PX0, PX1, (t)); partialSM(PX0, PX1, m_reg, mnX, alX);                  \
        __syncthreads();                                                                                                      \
        if ((t) + 1 < NT) { VMW(); SWRITE_H(SB); }                                                                            \
        RESC(alX); __syncthreads(); } while (0)
    for (int t = 1; t + 1 < NT; t += 2) {
        HALF_STEP(pB0, pB1, mnB, alB, pA0, pA1, alA, t, 1, 0, 0);
        HALF_STEP(pA0, pA1, mnA, alA, pB0, pB1, alB, t + 1, 0, 1, 1);
    }
    const bool even = (NT & 1) == 0;
    if (even) { SBAR(); qkt<1>(pB0, pB1, K_lds, r32, hi, S.qr); SBAR(); }
    SLOAD_H(it_K(nxt), it_V(nxt), 0); SBAR();
#pragma unroll
    for (int d0 = 0; d0 < 8; ++d0) S.qr[d0] = load8(it_Q(nxt) + (size_t)(wid * QBLK + r32) * QP + d0 * 16 + hi * 8);
    SBAR();
    finishSM(pA0, pA1, alA, l_reg, pa0, pa1, pa2, pa3); SBAR();
    pv_tile<0>(o, vb0, pa0, pa1, pa2, pa3);
    if (even) { MASKT(pB0, pB1, NT - 1); partialSM(pB0, pB1, m_reg, mnB, alB); __syncthreads(); RESC(alB);
        finishSM(pB0, pB1, alB, l_reg, pa0, pa1, pa2, pa3); SBAR(); pv_tile<1>(o, vb0, pa0, pa1, pa2, pa3); }
    SBAR(); SEAM_K0();
    if (hi == 0) li_l[r32] = l_reg; asm volatile("s_waitcnt lgkmcnt(0)" ::: "memory");
    float rli[16];
#pragma unroll
    for (int r = 0; r < 16; ++r) rli[r] = __builtin_amdgcn_rcpf(li_l[crow(r, hi)]);
    bf16* Ob = it_O(cur) + (size_t)(wid * QBLK + 4 * hi) * OP + r32;
#pragma unroll
    for (int r = 0; r < 16; ++r) { bf16* p = Ob; asm volatile("" : "+v"(p));
        p += (size_t)((r & 3) + 8 * (r >> 2)) * OP;
#pragma unroll
        for (int d0 = 0; d0 < 4; ++d0) { const float v = o[d0][r] * rli[r];
            const float vn = __shfl_xor(v, 1);
            if ((r32 & 1) == 0) *(unsigned*)(p + d0 * 32) = cvtpk(v, vn); } }
    __syncthreads();
#undef RESC
#undef KBASE
#undef MASKT
#undef SEAM_K0
#undef HALF_STEP
}
#undef ROW
#undef VMW
#undef VMWN
#undef SLOAD_H
#undef SWRITE_HK
#undef SWRITE_HV
#undef SWRITE_H
#undef KSWZ
#undef SBAR
}
constexpr int NWAVES = 8;
constexpr int RING_BYTES = 143360;
constexpr int TAB_OFF = RING_BYTES;
constexpr int TILE_E_OFF = TAB_OFF + 1024;
constexpr int TILE_S_OFF = TILE_E_OFF + 2048;
constexpr int ECNT_OFF = TILE_S_OFF + 512;
constexpr int MISC_OFF = ECNT_OFF + 512;
constexpr int LDS_BYTES = MISC_OFF + 256;
static_assert(LDS_BYTES <= 160 * 1024 && LDS_BYTES > 80 * 1024, "one workgroup per CU");

typedef float f32x4 __attribute__((ext_vector_type(4)));
typedef unsigned v4u __attribute__((ext_vector_type(4)));
typedef unsigned v2u __attribute__((ext_vector_type(2)));
typedef GAS unsigned gu32;
#define RLX_AGENT __ATOMIC_RELAXED, __HIP_MEMORY_SCOPE_AGENT

#define XB_TMO      128
#define XB_XCNT(j)  (256  + 64 * (j))
#define XB_XSUB(j)  (1280 + 64 * (j))
#define XB_XGEN(j)  (2304 + 64 * (j))
#define XB_TOP      3328
#define XB_TOPGEN   3392
#define XCD_BAR_WORDS 3456
#define XB_SPIN_CAP (1u << 20)
__device__ __forceinline__ unsigned xb_ld(unsigned* p)              { return __hip_atomic_load(p, __ATOMIC_RELAXED, __HIP_MEMORY_SCOPE_AGENT); }
__device__ __forceinline__ unsigned xb_add(unsigned* p, unsigned v) { return __hip_atomic_fetch_add(p, v, __ATOMIC_RELAXED, __HIP_MEMORY_SCOPE_AGENT); }
__device__ __forceinline__ unsigned xb_xcc_id() { return (unsigned)__builtin_amdgcn_s_getreg((3 << 11) | 20) & 0xFu; }
#define XB_SPIN(cond, bar) do { unsigned _sp = 0; while (cond) { __builtin_amdgcn_s_sleep(1); \
    if ((++_sp & 255u) == 0u) { if (xb_ld(&(bar)[XB_TMO])) break; if (_sp > XB_SPIN_CAP) { atomicAdd(&(bar)[XB_TMO], 1u); break; } } } } while (0)
struct XcdBarrier { unsigned* bar; unsigned x; volatile LAS unsigned* st; };
__device__ __forceinline__ XcdBarrier xcd_barrier_post(unsigned* bar, volatile LAS unsigned* st, int tid) {
    XcdBarrier b; b.bar = bar; b.x = xb_xcc_id(); b.st = st;
    if (tid == 0) (void)xb_add(&bar[XB_XCNT(b.x)], 1u);
    return b;
}
__device__ __forceinline__ void xcd_barrier_complete(unsigned* bar, unsigned x, unsigned& nloc, unsigned& nx) {
    const unsigned G = gridDim.x * gridDim.y * gridDim.z;
    unsigned sum, cnt, mine, sp = 0u;
    for (;;) {
        sum = 0u; cnt = 0u; mine = 0u;
#pragma unroll
        for (unsigned j = 0; j < 16; ++j) { const unsigned c = xb_ld(&bar[XB_XCNT(j)]); sum += c; cnt += (c > 0u) ? 1u : 0u; mine = (j == x) ? c : mine; }
        if (sum == G) break;
        __builtin_amdgcn_s_sleep(1);
        if ((++sp & 255u) == 0u) { if (xb_ld(&bar[XB_TMO])) break; if (sp > XB_SPIN_CAP) { atomicAdd(&bar[XB_TMO], 1u); break; } }
    }
    nloc = mine > 0u ? mine : 1u; nx = cnt > 0u ? cnt : 1u;
}
__device__ __forceinline__ void xcd_barrier(const XcdBarrier& b, int tid) {
    asm volatile("s_waitcnt vmcnt(0)" ::: "memory");
    __syncthreads();
    if (tid == 0) {
        unsigned* bar = b.bar;
        __builtin_amdgcn_s_waitcnt(0);
        unsigned nloc = b.st[0], nx = b.st[1];
        if (nloc == 0u) { xcd_barrier_complete(bar, b.x, nloc, nx); b.st[0] = nloc; b.st[1] = nx; }
        const unsigned old = xb_add(&bar[XB_XSUB(b.x)], 1u);
        const unsigned gen = old / nloc;
        if (old + 1u == (gen + 1u) * nloc) {
            __builtin_amdgcn_fence(__ATOMIC_RELEASE, "agent");
            asm volatile("s_waitcnt vmcnt(0)" ::: "memory");
            const unsigned og = xb_add(&bar[XB_TOP], 1u);
            const unsigned tg = og / nx;
            if (og + 1u == (tg + 1u) * nx) xb_add(&bar[XB_TOPGEN], 1u);
            else XB_SPIN(xb_ld(&bar[XB_TOPGEN]) == tg, bar);
            __builtin_amdgcn_fence(__ATOMIC_ACQUIRE, "agent");
            xb_add(&bar[XB_XGEN(b.x)], 1u);
            asm volatile("s_waitcnt vmcnt(0)" ::: "memory");
        } else {
            XB_SPIN(xb_ld(&bar[XB_XGEN(b.x)]) == gen, bar);
            __builtin_amdgcn_fence(__ATOMIC_ACQUIRE, "agent");
            asm volatile("s_waitcnt vmcnt(0)" ::: "memory");
        }
    }
    __syncthreads();
}

struct Args { const void* in[18]; float* out; unsigned char* ws; int ph_lo, ph_hi, li, pad; };
struct Frame {
    LAS unsigned char* lds; int wave, G, bid;
    unsigned char* ws;
};

__device__ __forceinline__ void transpose_item(const float* W, int N, bf16* WT, int Kout, size_t rb, int k0, int n0, LAS bf16* scr, int lane) {
    const int kr = lane >> 4, nc = (lane & 15) * 4;
    f32x4 v[16];
#pragma unroll
    for (int i = 0; i < 16; ++i) v[i] = *(const GAS f32x4*)(W + (size_t)(k0 + 4 * i + kr) * N + n0 + nc);
#pragma unroll
    for (int i = 0; i < 16; ++i) { const int k = 4 * i + kr;
        const unsigned p0 = pg8::cvt_pk_bf16(v[i][0], v[i][1]), p1 = pg8::cvt_pk_bf16(v[i][2], v[i][3]);
        scr[(nc + 0) * 68 + k] = (bf16)(p0 & 0xffffu); scr[(nc + 1) * 68 + k] = (bf16)(p0 >> 16);
        scr[(nc + 2) * 68 + k] = (bf16)(p1 & 0xffffu); scr[(nc + 3) * 68 + k] = (bf16)(p1 >> 16); }
    asm volatile("s_waitcnt lgkmcnt(0)" ::: "memory");
    const int c = lane & 7;
#pragma unroll
    for (int j = 0; j < 8; ++j) { const int n = (lane >> 3) + 8 * j;
        const LAS v2u* s = (const LAS v2u*)(scr + n * 68 + 8 * c); const v2u a = s[0], b = s[1];
        v4u o; o.x = a.x; o.y = a.y; o.z = b.x; o.w = b.y;
        *(GAS v4u*)(WT + (rb + n) * (size_t)Kout + k0 + 8 * c) = o; }
    asm volatile("s_waitcnt lgkmcnt(0)" ::: "memory");
}
namespace ret {
typedef short bf16x8 __attribute__((ext_vector_type(8)));
typedef short s16x4 __attribute__((ext_vector_type(4)));
typedef float f32x16 __attribute__((ext_vector_type(16)));
typedef float f32x4 __attribute__((ext_vector_type(4)));
typedef unsigned u32x4 __attribute__((ext_vector_type(4)));
constexpr int VSTR = 528;
constexpr int PSTR = 272;
constexpr int IMG = 128 * VSTR;
__device__ __forceinline__ int crow(int r, int hi) { return (r & 3) + 8 * (r >> 2) + 4 * hi; }
__device__ __forceinline__ s16x4 vtr(const LAS char* p) { return __builtin_bit_cast(s16x4, __builtin_amdgcn_ds_read_tr16_b64_v4i16((LAS s16x4*)p)); }
__device__ __forceinline__ bf16x8 tr_frag(const LAS char* img, int str, int k0, int c0, int lane) {
    const int g = lane >> 4, h = g >> 1, i = lane & 15, q = i >> 2, p = i & 3;
    const LAS char* a = img + (k0 + 8 * h + q) * str + (c0 + 16 * (g & 1) + 4 * p) * 2;
    const s16x4 lo = vtr(a), hi = vtr(a + 4 * str);
    return (bf16x8){lo[0], lo[1], lo[2], lo[3], hi[0], hi[1], hi[2], hi[3]};
}
__device__ __forceinline__ unsigned cvtpk(float lo, float hi) { unsigned r; asm volatile("v_cvt_pk_bf16_f32 %0, %1, %2" : "=v"(r) : "v"(lo), "v"(hi)); return r; }
__device__ __forceinline__ float gamma_log2(int h) { return log2f(1.f - exp2f(-5.f - (float)h)); }
__device__ __forceinline__ void stage_chunk(LAS char* img, const bf16* src, int tid, bool scale, float lg) {
#pragma unroll
    for (int i = 0; i < 8; ++i) { const int row = (tid >> 5) + 16 * i, pc = tid & 31;
        u32x4 v = *(const GAS u32x4*)(src + (size_t)row * 1024 + pc * 8);
        if (scale) { const float z = exp2f(lg * (float)(127 - row));
            u32x4 o;
#pragma unroll
            for (int j = 0; j < 4; ++j) o[j] = cvtpk(__uint_as_float(v[j] << 16) * z, __uint_as_float(v[j] & 0xffff0000u) * z);
            v = o; }
        *(LAS u32x4*)(img + row * VSTR + pc * 16) = v; }
}
__device__ __forceinline__ void ret_state(const unsigned char* ws, LAS unsigned char* lds, int item, int wid) {
    const int lane = lane_id(), tid = wid * 64 + lane, hi = lane >> 5, c = lane & 31;
    const int bh = item >> 5, ch = item & 31, b = bh >> 2, h = bh & 3;
    const bf16* proj = (const bf16*)(ws + WS_PROJ); const size_t PS = (size_t)M * 1024;
    const bf16* kr = proj + 4 * PS + (size_t)(b * T + ch * 128) * 1024 + h * 256; const bf16* vr = proj + 5 * PS + (size_t)(b * T + ch * 128) * 1024 + h * 256;
    LAS char* vimg = (LAS char*)lds; LAS char* kimg = vimg + IMG;
    const float lg = gamma_log2(h);
    stage_chunk(vimg, vr, tid, false, 0.f); stage_chunk(kimg, kr, tid, true, lg);
    __syncthreads();
    f32x16 acc[8];
#pragma unroll
    for (int j = 0; j < 8; ++j) acc[j] = f32x16{};
#pragma unroll 2
    for (int ks = 0; ks < 8; ++ks) {
        const bf16x8 a = tr_frag(vimg, VSTR, ks * 16, wid * 32, lane);
#pragma unroll
        for (int j = 0; j < 8; ++j) { const bf16x8 bb = tr_frag(kimg, VSTR, ks * 16, j * 32, lane); acc[j] = __builtin_amdgcn_mfma_f32_32x32x16_bf16(a, bb, acc[j], 0, 0, 0); }
    }
    float* ut = (float*)(ws + WS_U) + (size_t)item * 65536;
#pragma unroll
    for (int j = 0; j < 8; ++j)
#pragma unroll
        for (int r = 0; r < 16; ++r) ut[(size_t)(wid * 32 + crow(r, hi)) * 256 + j * 32 + c] = acc[j][r];
    __syncthreads();
}
__device__ __forceinline__ void ret_scan(const unsigned char* ws, int gtid, int gthreads) {
    const float* ut = (const float*)(ws + WS_U); bf16* st = (bf16*)(ws + WS_S);
    for (int e = gtid; e < 8 * 16384; e += gthreads) {
        const int bh = e >> 14, off = (e & 16383) * 4; const float dec = exp2f(128.f * gamma_log2(bh & 3));
        f32x4 s = {0.f, 0.f, 0.f, 0.f};
        f32x4 u = *(const GAS f32x4*)(ut + (size_t)(bh * 32) * 65536 + off);
#pragma unroll 4
        for (int ch = 0; ch < 32; ++ch) {
            f32x4 un = u; if (ch + 1 < 32) un = *(const GAS f32x4*)(ut + (size_t)(bh * 32 + ch + 1) * 65536 + off);
            v2u w; w.x = cvtpk(s[0], s[1]); w.y = cvtpk(s[2], s[3]);
            *(GAS v2u*)(st + (size_t)(bh * 32 + ch) * 65536 + off) = w;
            s = s * dec + u; u = un;
        }
    }
}
__device__ __forceinline__ void ret_out(const unsigned char* ws, LAS unsigned char* lds, int item, int wid) {
    const int lane = lane_id(), tid = wid * 64 + lane, hi = lane >> 5, c = lane & 31, r32 = c;
    const int bh = item >> 5, ch = item & 31, b = bh >> 2, h = bh & 3;
    const bf16* proj = (const bf16*)(ws + WS_PROJ); const size_t PS = (size_t)M * 1024; const size_t row0 = (size_t)(b * T + ch * 128);
    const bf16* qr = proj + 3 * PS + row0 * 1024 + h * 256; const bf16* kr = proj + 4 * PS + row0 * 1024 + h * 256;
    const bf16* vr = proj + 5 * PS + row0 * 1024 + h * 256; const bf16* gr = proj + 6 * PS + row0 * 1024 + h * 256;
    const bf16* st = (const bf16*)(ws + WS_S) + (size_t)item * 65536;
    LAS char* vimg = (LAS char*)lds; LAS char* pimg = vimg + IMG; LAS float* stat = (LAS float*)(pimg + 128 * PSTR);
    const float lg = gamma_log2(h);
    const int rb = wid & 3, half = wid >> 2;
    stage_chunk(vimg, vr, tid, false, 0.f);
    bf16x8 qf[16];
#pragma unroll
    for (int ks = 0; ks < 16; ++ks) qf[ks] = *(const GAS bf16x8*)(qr + (size_t)(rb * 32 + r32) * 1024 + ks * 16 + hi * 8);
#pragma unroll
    for (int jj = 0; jj < 2; ++jj) { const int cb = 2 * half + jj;
        f32x16 p = f32x16{};
        if (cb <= rb) {
#pragma unroll
            for (int ks = 0; ks < 16; ++ks) { const bf16x8 kf = *(const GAS bf16x8*)(kr + (size_t)(cb * 32 + r32) * 1024 + ks * 16 + hi * 8);
                p = __builtin_amdgcn_mfma_f32_32x32x16_bf16(qf[ks], kf, p, 0, 0, 0); }
        }
#pragma unroll
        for (int r = 0; r < 16; ++r) { const int tq = rb * 32 + crow(r, hi), tk = cb * 32 + c, df = tq - tk;
            const float v = df >= 0 ? p[r] * exp2f(lg * (float)df) : 0.f;
            *(LAS bf16*)(pimg + tq * PSTR + tk * 2) = f2bf(v); }
    }
    __syncthreads();
    f32x16 accP[4], accS[4];
#pragma unroll
    for (int j = 0; j < 4; ++j) { accP[j] = f32x16{}; accS[j] = f32x16{}; }
    for (int ks = 0; ks < 2 * rb + 2; ++ks) {
        const bf16x8 a = *(const LAS bf16x8*)(pimg + (rb * 32 + r32) * PSTR + (ks * 16 + hi * 8) * 2);
#pragma unroll
        for (int j = 0; j < 4; ++j) { const bf16x8 bb = tr_frag(vimg, VSTR, ks * 16, (half * 4 + j) * 32, lane); accP[j] = __builtin_amdgcn_mfma_f32_32x32x16_bf16(a, bb, accP[j], 0, 0, 0); }
    }
    const bf16* qr2 = qr + (size_t)(rb * 32 + r32) * 1024 + hi * 8; asm volatile("" : "+v"(qr2));
#pragma unroll
    for (int ks = 0; ks < 16; ++ks) {
        const bf16x8 qa = *(const GAS bf16x8*)(qr2 + ks * 16);
#pragma unroll
        for (int j = 0; j < 4; ++j) { const bf16x8 sf = *(const GAS bf16x8*)(st + (size_t)((half * 4 + j) * 32 + r32) * 256 + ks * 16 + hi * 8);
            accS[j] = __builtin_amdgcn_mfma_f32_32x32x16_bf16(qa, sf, accS[j], 0, 0, 0); }
    }
    float s1[16], s2[16];
#pragma unroll
    for (int r = 0; r < 16; ++r) { const float xi = exp2f(lg * (float)(crow(r, hi) + rb * 32 + 1)); float a1 = 0.f, a2 = 0.f;
#pragma unroll
        for (int j = 0; j < 4; ++j) { const float v = accP[j][r] + xi * accS[j][r]; accP[j][r] = v; a1 += v; a2 += v * v; }
        s1[r] = a1; s2[r] = a2; }
#pragma unroll
    for (int r = 0; r < 16; ++r) {
#pragma unroll
        for (int o = 1; o < 32; o <<= 1) { s1[r] += __shfl_xor(s1[r], o); s2[r] += __shfl_xor(s2[r], o); }
        if (c == 0) { stat[(half * 128 + rb * 32 + crow(r, hi)) * 2 + 0] = s1[r]; stat[(half * 128 + rb * 32 + crow(r, hi)) * 2 + 1] = s2[r]; } }
    __syncthreads();
    bf16* mixo = (bf16*)(ws + WS_MIX) + row0 * D + 1024 + h * 256;
#pragma unroll
    for (int r = 0; r < 16; ++r) { const int row = rb * 32 + crow(r, hi);
        const float t1 = stat[row * 2] + stat[(128 + row) * 2], t2 = stat[row * 2 + 1] + stat[(128 + row) * 2 + 1];
        const float mu = t1 * (1.f / 256.f), var = t2 * (1.f / 256.f) - mu * mu, rs = rsqrtf(fmaxf(var, 0.f) + NORM_EPS);
#pragma unroll
        for (int j = 0; j < 4; ++j) { const int col = (half * 4 + j) * 32 + c;
            const float g = bf2f(gr[(size_t)row * 1024 + col]);
            const float v = (accP[j][r] - mu) * rs * (g / (1.f + __expf(-g)));
            const float vn = __shfl_xor(v, 1);
            if ((c & 1) == 0) *(unsigned*)(mixo + (size_t)row * D + col) = cvtpk(v, vn); } }
    __syncthreads();
}
}
__device__ __forceinline__ void p0_prologue(const Frame& F, const Args& a) {
    const int lane = lane_id(), tid = F.wave * 64 + lane; (void)tid;
    const float* w_ada = (const float*)a.in[3]; const float* cvec = (const float*)a.in[1]; const int* pos = (const int*)a.in[2];
    const float* w_in = (const float*)a.in[8]; const float* w_out = (const float*)a.in[9];
    const float* w_gate = (const float*)a.in[12]; const float* w_up = (const float*)a.in[13]; const float* w_down = (const float*)a.in[14];
    const float* ws_gate = (const float*)a.in[15]; const float* ws_up = (const float*)a.in[16]; const float* ws_down = (const float*)a.in[17];
    bf16* WinT = (bf16*)(F.ws + WS_WIN); bf16* WoutT = (bf16*)(F.ws + WS_WOUT); bf16* WguT = (bf16*)(F.ws + WS_WGU); bf16* WdT = (bf16*)(F.ws + WS_WD);
    float2* ropem = (float2*)(F.ws + WS_ROPEM); float2* roper = (float2*)(F.ws + WS_ROPER); float* modp = (float*)(F.ws + WS_MODP);
    LAS bf16* scr = (LAS bf16*)(F.lds + F.wave * 8704);
    LAS double* sinv = (LAS double*)(F.lds + 8 * 8704);
    if (tid < 144) sinv[tid] = tid < 16 ? pow(500000.0, -(double)tid / 16.0) : pow(10000.0, -(double)(tid - 16) / 127.0);
    __syncthreads();
    const int gw = F.bid * NWAVES + F.wave, NGW = F.G * NWAVES;
    constexpr int I_MOD = 16 * 48, I_ROPE = (M * 144) / 64;
    constexpr int I_IN = 32 * 112, I_OUT = 32 * 32, I_GU = 65 * 2 * 32 * 8, I_DN = 65 * 8 * 32;
    constexpr int NITEMS = I_MOD + I_ROPE + I_IN + I_OUT + I_GU + I_DN;
    for (int it = gw; it < NITEMS; it += NGW) {
        int r = it;
        if (r < I_MOD) {
            const int kc = r / 48, n0 = (r % 48) * 256 + lane * 4;
            f32x4 a0 = {0.f, 0.f, 0.f, 0.f}, a1 = {0.f, 0.f, 0.f, 0.f};
#pragma unroll 8
            for (int k = kc * 128; k < kc * 128 + 128; ++k) { const f32x4 w = *(const GAS f32x4*)(w_ada + (size_t)k * (6 * D) + n0);
                const float c0 = cvec[k], c1 = cvec[D + k]; a0 += w * silu_f(c0); a1 += w * silu_f(c1); }
            *(f32x4*)(modp + (size_t)(kc * 2 + 0) * (6 * D) + n0) = a0; *(f32x4*)(modp + (size_t)(kc * 2 + 1) * (6 * D) + n0) = a1;
            continue; }
        r -= I_MOD;
        if (r < I_ROPE) {
            const int idx = r * 64 + lane; float2* dst; int m, f;
            if (idx < M * 16) { m = idx >> 4; f = idx & 15; dst = ropem + idx; } else { const int j = idx - M * 16; m = j >> 7; f = 16 + (j & 127); dst = roper + j; }
            const double rev = (double)pos[m] * sinv[f] * 0.15915494309189535; const float fr = (float)(rev - floor(rev));
            *dst = make_float2(__builtin_amdgcn_cosf(fr), __builtin_amdgcn_sinf(fr));
            continue; }
        r -= I_ROPE;
        if (r < I_IN) { transpose_item(w_in, NPROJ, WinT, D, (size_t)(r % 112) * 64, (r / 112) * 64, (r % 112) * 64, scr, lane); continue; }
        r -= I_IN;
        if (r < I_OUT) { transpose_item(w_out, D, WoutT, D, (size_t)(r % 32) * 64, (r / 32) * 64, (r % 32) * 64, scr, lane); continue; }
        r -= I_OUT;
        if (r < I_GU) {
            const int eu = r / 256, e = eu >> 1, up = eu & 1, q = r % 256, kb = q / 8, nb = q % 8, n0 = nb * 64;
            const float* W = e < 64 ? (up ? w_up : w_gate) + (size_t)e * D * EH : (up ? ws_up : ws_gate);
            const size_t rb = (size_t)e * 1024 + (n0 >> 7) * 256 + up * 128 + (n0 & 127);
            transpose_item(W, EH, WguT, D, rb, kb * 64, n0, scr, lane); continue; }
        r -= I_GU;
        { const int e = r / 256, q = r % 256, kb = q / 32, nb = q % 32;
          const float* W = e < 64 ? w_down + (size_t)e * EH * D : ws_down;
          transpose_item(W, D, WdT, EH, (size_t)e * D + nb * 64, kb * 64, nb * 64, scr, lane); }
    }
}
__device__ __forceinline__ void norm_rows(const Frame& F, const float* x, const float* g, const LAS float* smod  , bf16* xn, float* rstd_out, int m_lo, int m_step, int m_hi) {
    const int lane = lane_id(), tid = F.wave * 64 + lane; (void)tid;
    for (int m = m_lo; m < m_hi; m += m_step) {
        const int b = m / T;
        const GAS f32x4* xr = (const GAS f32x4*)(x + (size_t)m * D);
        f32x4 v[8]; float s = 0.f;
#pragma unroll
        for (int j = 0; j < 8; ++j) { v[j] = xr[lane + 64 * j]; s += v[j][0] * v[j][0] + v[j][1] * v[j][1] + v[j][2] * v[j][2] + v[j][3] * v[j][3]; }
        s = wave_sum(s);
        const float rstd = rsqrtf(s * (1.f / D) + NORM_EPS);
        if (rstd_out && lane == 0) rstd_out[m] = rstd;
#pragma unroll
        for (int j = 0; j < 8; ++j) { const int col = (lane + 64 * j) * 4;
            const f32x4 gg = *(const f32x4*)(g + col), h4 = *(const LAS f32x4*)(smod + (b * 2 + 0) * D + col), s4 = *(const LAS f32x4*)(smod + (b * 2 + 1) * D + col);
            const f32x4 o = v[j] * rstd * gg * (s4 + 1.f) + h4;
            v2u w; w.x = pg8::cvt_pk_bf16(o[0], o[1]); w.y = pg8::cvt_pk_bf16(o[2], o[3]);
            *(v2u*)(xn + (size_t)m * D + col) = w; }
    }
}
__device__ __forceinline__ void p1_norm(const Frame& F, const Args& a) {
    const int lane = lane_id(), tid = F.wave * 64 + lane; (void)tid;
    const float* x = (const float*)a.in[0]; const float* b_ada = (const float*)a.in[4]; const float* g = (const float*)a.in[5];
    const float* modp = (const float*)(F.ws + WS_MODP); float* mod = (float*)(F.ws + WS_MOD); bf16* xn = (bf16*)(F.ws + WS_XN);
    LAS float* smod = (LAS float*)F.lds;
    for (int i = tid; i < 2 * 2 * D; i += NWAVES * 64) { const int b = i / (2 * D), which = (i / D) & 1, col = i % D, n = which * D + col;
        float s = b_ada[n];
#pragma unroll
        for (int kc = 0; kc < 16; ++kc) s += modp[(size_t)(kc * 2 + b) * (6 * D) + n];
        smod[i] = s; }
    if (F.bid < 48) { const int i = F.bid * 512 + tid, b = i / (6 * D), n = i % (6 * D);
        float s = b_ada[n];
#pragma unroll
        for (int kc = 0; kc < 16; ++kc) s += modp[(size_t)(kc * 2 + b) * (6 * D) + n];
        mod[i] = s; }
    __syncthreads();
    norm_rows(F, x, g, smod, xn, nullptr, F.bid * NWAVES + F.wave, F.G * NWAVES, M);
    __syncthreads();
}
__device__ __forceinline__ void p10_final(const Frame& F, const Args& a) {
    const int lane = lane_id(), tid = F.wave * 64 + lane; (void)tid;
    const float* x1 = (const float*)(F.ws + WS_X1); const bf16* yslot = (const bf16*)(F.ws + WS_YSLOT); const float* mod = (const float*)(F.ws + WS_MOD);
    const float* gout = (const float*)a.in[7]; float* out = a.out;
    for (int m = F.bid * NWAVES + F.wave; m < M; m += F.G * NWAVES) {
        const float* gate = mod + (m / T) * 6 * D + 5 * D;
        f32x4 v[8]; float s = 0.f;
#pragma unroll
        for (int j = 0; j < 8; ++j) { const int col = (lane + 64 * j) * 4;
            f32x4 y = {0.f, 0.f, 0.f, 0.f};
#pragma unroll
            for (int k = 0; k < 9; ++k) { const v2u u = *(const GAS v2u*)(yslot + ((size_t)m * 9 + k) * D + col);
                y[0] += __uint_as_float(u.x << 16); y[1] += __uint_as_float(u.x & 0xffff0000u); y[2] += __uint_as_float(u.y << 16); y[3] += __uint_as_float(u.y & 0xffff0000u); }
            const f32x4 xv = *(const GAS f32x4*)(x1 + (size_t)m * D + col), g4 = *(const f32x4*)(gate + col);
            v[j] = xv + g4 * y; s += v[j][0] * v[j][0] + v[j][1] * v[j][1] + v[j][2] * v[j][2] + v[j][3] * v[j][3]; }
        s = wave_sum(s);
        const float rstd = rsqrtf(s * (1.f / D) + NORM_EPS);
#pragma unroll
        for (int j = 0; j < 8; ++j) { const int col = (lane + 64 * j) * 4; const f32x4 gg = *(const f32x4*)(gout + col);
            *(f32x4*)(out + (size_t)m * D + col) = v[j] * rstd * gg; }
    }
}
__device__ __forceinline__ int moe_tables(const Frame& F, const unsigned* cnt) {
    const int lane = lane_id(), tid = F.wave * 64 + lane; (void)tid;
    LAS int* tile_e = (LAS int*)(F.lds + TILE_E_OFF); LAS int* tile_s = (LAS int*)(F.lds + TILE_S_OFF); LAS int* ecnt = (LAS int*)(F.lds + ECNT_OFF);
    if (tid < 65) ecnt[tid] = tid < 64 ? (int)__hip_atomic_load(cnt + tid, RLX_AGENT) : M;
    __syncthreads();
    if (tid == 0) { int s = 0; for (int e = 0; e < 65; ++e) { tile_s[e] = s; s += (ecnt[e] + 255) >> 8; } tile_s[65] = s; }
    __syncthreads();
    const int total = tile_s[65];
    if (tid < 65) { for (int p = tile_s[tid]; p < tile_s[tid + 1]; ++p) tile_e[p] = tid; }
    __syncthreads();
    return total;
}
__device__ __forceinline__ void route_row(float lg, const float* bias, int m, unsigned* cnt, int* ltok, float* lw, int lane) {
    const float score = 1.f / (1.f + __expf(-lg));
    const float biased = score + bias[lane];
    float m1 = biased;
    m1 = fmaxf(m1, __shfl_xor(m1, 1)); m1 = fmaxf(m1, __shfl_xor(m1, 2)); m1 = fmaxf(m1, __shfl_xor(m1, 4));
    const unsigned long long eq = __ballot(biased == m1);
    const unsigned gb = (unsigned)(eq >> (lane & ~7)) & 0xffu;
    const int first = __ffs(gb) - 1;
    float v2 = ((lane & 7) == first) ? -3e38f : biased;
    v2 = fmaxf(v2, __shfl_xor(v2, 1)); v2 = fmaxf(v2, __shfl_xor(v2, 2)); v2 = fmaxf(v2, __shfl_xor(v2, 4));
    const float gs = m1 + v2; const int g = lane >> 3;
    int grank = 0;
#pragma unroll
    for (int j = 0; j < 8; ++j) { const float o = __shfl(gs, j * 8); grank += (o > gs || (o == gs && j < g)) ? 1 : 0; }
    const float masked = grank < 4 ? biased : NEGF;
    int rank = 0;
#pragma unroll
    for (int j = 0; j < 64; ++j) { const float o = __shfl(masked, j); rank += (o > masked || (o == masked && j < lane)) ? 1 : 0; }
    const bool selx = rank < 8;
    const float ssum = wave_sum(selx ? score : 0.f);
    if (selx) { const unsigned p = atomicAdd(&cnt[lane], 1u); ltok[lane * M + p] = m * 16 + rank; lw[lane * M + p] = score / ssum * 2.5f; }
    if (lane == 0) { ltok[64 * M + m] = m * 16 + 8; lw[64 * M + m] = 1.f; }
}
__device__ __forceinline__ void p7_route(const Frame& F, const Args& a) {
    const int lane = lane_id(), tid = F.wave * 64 + lane; (void)tid;
    const float* x1 = (const float*)(F.ws + WS_X1); const float* g = (const float*)a.in[6]; const float* mod = (const float*)(F.ws + WS_MOD);
    const float* w_router = (const float*)a.in[10]; const float* rbias = (const float*)a.in[11];
    bf16* xn = (bf16*)(F.ws + WS_XN); unsigned* cnt = (unsigned*)(F.ws + WS_CTL) + CW_CNT; int* ltok = (int*)(F.ws + WS_LTOK); float* lw = (float*)(F.ws + WS_LW);
    LAS float* smod = (LAS float*)F.lds; LAS float* srstd = (LAS float*)(F.lds + 32768); LAS float* slog = (LAS float*)(F.lds + 33792);
    float* sm = (float*)(F.lds + 50176);
    for (int i = tid; i < 2 * 2 * D; i += NWAVES * 64) { const int b = i / (2 * D), which = (i / D) & 1, col = i % D; smod[i] = mod[b * 6 * D + (3 + which) * D + col]; }
    __syncthreads();
    for (int tile = F.bid; tile < M / 64; tile += F.G) {
        const int m0 = tile * 64, b = m0 / T;
        norm_rows(F, x1, g, smod, xn, (float*)(F.ws + WS_RSTD), m0 + F.wave * 8, 1, m0 + F.wave * 8 + 8);
        for (int r = 0; r < 8; ++r) { if (lane == 0) srstd[F.wave * 8 + r] = ((const float*)(F.ws + WS_RSTD))[m0 + F.wave * 8 + r]; }
        __syncthreads();
        nv::ngemm_tile(sm, D,
            [&](int r, int k) { return x1[(size_t)(m0 + r) * D + k] * srstd[r] * g[k] * (1.f + smod[(b * 2 + 1) * D + k]) + smod[(b * 2 + 0) * D + k]; },
            [&](int k, int c) { return c < 64 ? w_router[(size_t)k * 64 + c] : 0.f; },
            [&](int r0, int c0, const float (&acc)[4][4]) {
                if (c0 < 64) {
#pragma unroll
                    for (int i = 0; i < 4; ++i)
#pragma unroll
                        for (int j = 0; j < 4; ++j) slog[(r0 + i) * 64 + c0 + j] = acc[i][j]; } }, tid);
        __syncthreads();
        for (int r = 0; r < 8; ++r) { const int row = F.wave * 8 + r; route_row(slog[row * 64 + lane], rbias, m0 + row, cnt, ltok, lw, lane); }
        __syncthreads();
    }
}

__device__ __forceinline__ void p3_attention(const Frame& F) {
    char* lds = (char*)F.lds;
    att::Seam S; bool first = true;
    for (int it = F.bid; it < 256; it += F.G) {
        const att::BlockRef cur{F.ws, it}, nxt{F.ws, (it + F.G < 256) ? it + F.G : it};
        if (first) { att::moba_prime(cur, lds, S, F.wave); first = false; }
        att::moba_block(cur, nxt, lds, S, F.wave);
    }
    const int nl = F.G / 2;
    if (F.bid >= F.G - nl) for (int ri = F.bid - (F.G - nl); ri < 256; ri += nl) ret::ret_state(F.ws, F.lds, ri, F.wave);
}

__global__ void __launch_bounds__(NWAVES * 64, 2) mk_fwd(Args args) {
    extern __shared__ __attribute__((aligned(16))) unsigned char lds_raw[];
    Frame F;
    F.lds = (LAS unsigned char*)lds_raw; F.wave = __builtin_amdgcn_readfirstlane(threadIdx.x >> 6);
    F.G = gridDim.x; F.bid = blockIdx.x; F.ws = args.ws;
    volatile LAS unsigned* MISC = (volatile LAS unsigned*)(F.lds + MISC_OFF);
    { const int l0 = lane_id(); if (F.wave == 0) MISC[l0] = 0u; }
    __syncthreads();
    unsigned* ctl = (unsigned*)(F.ws + WS_CTL);
    const int lo = args.ph_lo, hi = args.ph_hi;
    XcdBarrier bar; bar.bar = ctl + CW_BAR + args.li * XCD_BAR_WORDS; bar.x = 0; bar.st = nullptr;
    if (hi - lo > 1) bar = xcd_barrier_post(ctl + CW_BAR + args.li * XCD_BAR_WORDS, MISC + 8, F.wave * 64 + lane_id());
#define IN(k) (lo <= (k) && (k) < hi)
#define SEAM(k) do { if (IN(k) && IN((k) + 1)) xcd_barrier(bar, F.wave * 64 + lane_id()); } while (0)
    LAS unsigned char* ring = F.lds; LAS unsigned char* tab = F.lds + TAB_OFF;
    if (IN(0)) { p0_prologue(F, args); __syncthreads(); } SEAM(0);
    if (IN(1)) { p1_norm(F, args); } SEAM(1);
    if (IN(2)) {
        pg8::Gemm g{(const bf16*)(F.ws + WS_XN), (const bf16*)(F.ws + WS_WIN), D}; pg8::StaticOrder S; S.init(M, NPROJ, F.G, F.bid);
        pg8::EpiProj E{(bf16*)(F.ws + WS_PROJ), (const float2*)(F.ws + WS_ROPEM), (const float2*)(F.ws + WS_ROPER), (float*)(F.ws + WS_KMEAN)};
        pg8::gemm_phase<pg8::EpiProj, pg8::StaticOrder, false, true>(ring, tab, g, S, E, F.wave);
    } SEAM(2);
    if (IN(3)) { p3_attention(F); } SEAM(3);
    if (IN(4)) { ret::ret_scan(F.ws, F.bid * (NWAVES * 64) + F.wave * 64 + lane_id(), F.G * NWAVES * 64); } SEAM(4);
    if (IN(5)) { for (int item = F.bid; item < 256; item += F.G) ret::ret_out(F.ws, F.lds, item, F.wave); } SEAM(5);
    if (IN(6)) {
        pg8::Gemm g{(const bf16*)(F.ws + WS_MIX), (const bf16*)(F.ws + WS_WOUT), D}; pg8::StaticOrder S; S.init(M, D, F.G, F.bid);
        pg8::EpiOut E{(const float*)args.in[0], (const float*)(F.ws + WS_MOD), (float*)(F.ws + WS_X1)};
        pg8::gemm_phase<pg8::EpiOut, pg8::StaticOrder, false, false>(ring, tab, g, S, E, F.wave);
    } SEAM(6);
    if (IN(7)) { p7_route(F, args); } SEAM(7);
    if (IN(8)) {
        const int total = moe_tables(F, ctl + CW_CNT);
        pg8::MoeOrder S; S.nM = total; S.nN = 4; S.nwg = total * 4; S.G = F.G; S.c = F.bid;
        S.tile_e = (const LAS int*)(F.lds + TILE_E_OFF); S.tile_start = (const LAS int*)(F.lds + TILE_S_OFF); S.ecount = (const LAS int*)(F.lds + ECNT_OFF); S.ltok = (const int*)(F.ws + WS_LTOK);
        pg8::Gemm g{(const bf16*)(F.ws + WS_XN), (const bf16*)(F.ws + WS_WGU), D};
        pg8::EpiAct E{(bf16*)(F.ws + WS_ACT)};
        pg8::gemm_phase<pg8::EpiAct, pg8::MoeOrder, true, true>(ring, tab, g, S, E, F.wave);
    } SEAM(8);
    if (IN(9)) {
        const int total = moe_tables(F, ctl + CW_CNT);
        pg8::MoeOrder S; S.nM = total; S.nN = 8; S.nwg = total * 8; S.G = F.G; S.c = F.bid;
        S.tile_e = (const LAS int*)(F.lds + TILE_E_OFF); S.tile_start = (const LAS int*)(F.lds + TILE_S_OFF); S.ecount = (const LAS int*)(F.lds + ECNT_OFF); S.ltok = (const int*)(F.ws + WS_LTOK);
        pg8::Gemm g{(const bf16*)(F.ws + WS_ACT), (const bf16*)(F.ws + WS_WD), EH};
        pg8::EpiDown E{(bf16*)(F.ws + WS_YSLOT), (const int*)(F.ws + WS_LTOK), (const float*)(F.ws + WS_LW)};
        pg8::gemm_phase<pg8::EpiDown, pg8::MoeOrder, false, true>(ring, tab, g, S, E, F.wave);
    } SEAM(9);
    if (IN(10)) { p10_final(F, args); }
#undef IN
#undef SEAM
}

#ifndef MK_MASK
#define MK_MASK 0x7FF
#endif
extern "C" void kernel_launch(void* const* d_in, const int* in_sizes, int n_in, void* d_out, int out_size, void* d_ws, size_t ws_size, hipStream_t stream) {
    static int grid = 0;
    if (grid == 0) {
        if (n_in != 18 || ws_size < WS_END) { fprintf(stderr, "kernel_launch: bad args n_in %d ws %zu\n", n_in, ws_size); grid = -1; return; }
        int dev = 0, cus = 0, per_cu = 0;
        if (hipGetDevice(&dev) != hipSuccess || hipDeviceGetAttribute(&cus, hipDeviceAttributeMultiprocessorCount, dev) != hipSuccess) { grid = -1; return; }
        if (hipFuncSetAttribute((const void*)mk_fwd, hipFuncAttributeMaxDynamicSharedMemorySize, LDS_BYTES) != hipSuccess) { fprintf(stderr, "kernel_launch: hipFuncSetAttribute failed\n"); grid = -1; return; }
        if (hipOccupancyMaxActiveBlocksPerMultiprocessor(&per_cu, (const void*)mk_fwd, NWAVES * 64, LDS_BYTES) != hipSuccess || per_cu < 1) { fprintf(stderr, "kernel_launch: occupancy query says %d\n", per_cu); per_cu = 1; }
        (void)hipGetLastError();
        grid = cus;
    }
    if (grid < 0) return;
    const float* x = (const float*)d_in[0]; const float* c = (const float*)d_in[1]; const int* pos = (const int*)d_in[2];
    const float* w_ada = (const float*)d_in[3]; const float* b_ada = (const float*)d_in[4];
    const float* norm_mix = (const float*)d_in[5]; const float* norm_ffn = (const float*)d_in[6]; const float* norm_out = (const float*)d_in[7];
    const float* w_in = (const float*)d_in[8]; const float* w_out = (const float*)d_in[9]; const float* w_router = (const float*)d_in[10]; const float* rbias = (const float*)d_in[11];
    const float* w_gate = (const float*)d_in[12]; const float* w_up = (const float*)d_in[13]; const float* w_down = (const float*)d_in[14];
    const float* ws_gate = (const float*)d_in[15]; const float* ws_up = (const float*)d_in[16]; const float* ws_down = (const float*)d_in[17];
    unsigned char* ws = (unsigned char*)d_ws;
    unsigned* ctl = (unsigned*)(ws + WS_CTL); float* mod = (float*)(ws + WS_MOD); float* kmean = (float*)(ws + WS_KMEAN); float* rstd = (float*)(ws + WS_RSTD);
    int* ltok = (int*)(ws + WS_LTOK); float* lw = (float*)(ws + WS_LW); float2* ropem = (float2*)(ws + WS_ROPEM); float2* roper = (float2*)(ws + WS_ROPER);
    float* logits = (float*)(ws + WS_LOGITS); float* x1 = (float*)(ws + WS_X1); bf16* xn = (bf16*)(ws + WS_XN); bf16* act = (bf16*)(ws + WS_ACT);
    bf16* proj = (bf16*)(ws + WS_PROJ); bf16* mix = (bf16*)(ws + WS_MIX); bf16* yslot = (bf16*)(ws + WS_YSLOT); float* projf = (float*)(ws + WS_PROJF);
    const size_t PS = (size_t)M * 1024;
    (void)hipMemsetAsync(ws + WS_CTL, 0, CTL_ZERO_BYTES, stream);
    Args a{};
    for (int i = 0; i < 18; ++i) a.in[i] = d_in[i];
    a.out = (float*)d_out; a.ws = ws;
    const unsigned mask = MK_MASK; int li = 0;
    const int max_rt = (M * 9 + 65 * 256) / 64;
    for (int p = 0; p <= 10;) {
        if ((mask >> p) & 1u) {
            int q = p; while (q <= 10 && ((mask >> q) & 1u)) ++q;
            a.ph_lo = p; a.ph_hi = q; a.li = li++;
            hipLaunchKernelGGL(mk_fwd, dim3(grid), dim3(NWAVES * 64), LDS_BYTES, stream, a);
            p = q; continue;
        }
        switch (p) {
        case 0: nv::k_rope<<<(M * 128 + 255) / 256, 256, 0, stream>>>(pos, ropem, roper); break;
        case 1: nv::k_mod<<<6 * D / 256, 256, 0, stream>>>(c, w_ada, b_ada, mod); nv::k_norm_mod<<<M / 8, 512, 0, stream>>>(x, norm_mix, mod, 0, D, xn, nullptr); break;
        case 2: nv::k_proj<<<(M / 64) * (NPROJ / 128), 512, 0, stream>>>(xn, w_in, projf);
                nv::k_rot<<<(unsigned)(((size_t)M * NPROJ + 255) / 256), 256, 0, stream>>>(projf, ropem, roper, proj);
                nv::k_kmean<<<NB * 16 * 1024 / 256, 256, 0, stream>>>(proj + PS, kmean); break;
        case 3: nv::k_moba<<<M, 512, 0, stream>>>(proj, proj + PS, proj + 2 * PS, kmean, mix); break;
        case 5: nv::k_ret<<<M / 2, 512, 0, stream>>>(proj + 3 * PS, proj + 4 * PS, proj + 5 * PS, proj + 6 * PS, mix); break;
        case 6: nv::k_outproj<<<(M / 64) * (D / 128), 512, 0, stream>>>(mix, w_out, x, mod, x1); break;
        case 7: nv::k_norm_mod<<<M / 8, 512, 0, stream>>>(x1, norm_ffn, mod, 3 * D, 4 * D, xn, rstd);
                nv::k_logits<<<M / 64, 512, 0, stream>>>(x1, rstd, norm_ffn, mod, w_router, logits);
                nv::k_route<<<M / 8, 512, 0, stream>>>(logits, rbias, ctl + CW_CNT, ltok, lw); break;
        case 8: nv::k_gateup<<<max_rt * 8, 512, 0, stream>>>(xn, ctl + CW_CNT, ltok, w_gate, w_up, ws_gate, ws_up, act); break;
        case 9: nv::k_down<<<max_rt * 16, 512, 0, stream>>>(act, ctl + CW_CNT, ltok, lw, w_down, ws_down, yslot); break;
        case 10: nv::k_final<<<M / 8, 512, 0, stream>>>(x1, yslot, mod, norm_out, (float*)d_out); break;
        default: break;
        }
        ++p;
    }
}
```

```cpp
#include <hip/hip_runtime.h>
#include <cstdio>
#include <cstdint>

constexpr int NB = 2, T = 4096, D = 2048, M = NB * T;
constexpr int NPROJ = 7168;
constexpr int NE = 64, EH = 512;
constexpr float NORM_EPS = 1e-6f;
constexpr float NEGF = -1e30f;

constexpr size_t MiB = 1u << 20;
constexpr size_t WS_CTL = 0, CTL_ZERO_BYTES = 1 * MiB;
constexpr size_t WS_KMEAN = 512 * 1024;
constexpr size_t WS_MODP = 1 * MiB;
constexpr size_t WS_MOD = 3 * MiB;
constexpr size_t WS_RSTD = 5 * MiB;
constexpr size_t WS_LTOK = 6 * MiB;
constexpr size_t WS_LW = 9 * MiB;
constexpr size_t WS_ROPEM = 12 * MiB;
constexpr size_t WS_ROPER = 13 * MiB;
constexpr size_t WS_LOGITS = 21 * MiB;
constexpr size_t WS_WGU = 24 * MiB;
constexpr size_t WS_WD = 284 * MiB;
constexpr size_t WS_X1 = 414 * MiB;
constexpr size_t WS_XN = 478 * MiB;
constexpr size_t WS_ACT = 510 * MiB;
constexpr size_t WS_WIN = 600 * MiB;
constexpr size_t WS_WOUT = 628 * MiB;
constexpr size_t WS_PROJ = 636 * MiB;
constexpr size_t WS_MIX = 748 * MiB;
constexpr size_t WS_U = 780 * MiB;
constexpr size_t WS_S = 844 * MiB;
constexpr size_t WS_YSLOT = 600 * MiB;
constexpr size_t WS_PROJF = 780 * MiB;
constexpr size_t WS_END = 1024 * MiB;
constexpr int CW_CNT = 1024;
constexpr int CW_BAR = 4096;

typedef unsigned short bf16;
__device__ __forceinline__ float bf2f(bf16 v) { return __uint_as_float(((unsigned)v) << 16); }
__device__ __forceinline__ bf16 f2bf(float f) { unsigned u = __float_as_uint(f); return (bf16)((u + 0x7fffu + ((u >> 16) & 1u)) >> 16); }
__device__ __forceinline__ float wave_sum(float v) {
#pragma unroll
    for (int o = 1; o < 64; o <<= 1) v += __shfl_xor(v, o);
    return v;
}
__device__ __forceinline__ float wave_max(float v) {
#pragma unroll
    for (int o = 1; o < 64; o <<= 1) v = fmaxf(v, __shfl_xor(v, o));
    return v;
}
__device__ __forceinline__ int lane_id() { int r; asm volatile("v_mbcnt_lo_u32_b32 %0, -1, 0\n\tv_mbcnt_hi_u32_b32 %0, -1, %0" : "=v"(r)); return r; }
__device__ __forceinline__ float silu_f(float x) { return x / (1.f + __expf(-x)); }

namespace nv {

__global__ void k_rope(const int* pos, float2* ropem, float2* roper) {
    int i = blockIdx.x * blockDim.x + threadIdx.x;
    if (i < M * 16) { int m = i >> 4, f = i & 15; double inv = pow(500000.0, -(double)f / 16.0); double a = (double)pos[m] * inv; ropem[i] = make_float2((float)cos(a), (float)sin(a)); }
    if (i < M * 128) { int m = i >> 7, f = i & 127; double inv = pow(10000.0, -(double)f / 127.0); double a = (double)pos[m] * inv; roper[i] = make_float2((float)cos(a), (float)sin(a)); }
}
__global__ void k_mod(const float* c, const float* w_ada, const float* b_ada, float* mod) {
    __shared__ float sc[2][D];
    for (int i = threadIdx.x; i < 2 * D; i += blockDim.x) sc[i / D][i % D] = silu_f(c[i]);
    __syncthreads();
    int n = blockIdx.x * blockDim.x + threadIdx.x;
    if (n >= 6 * D) return;
    float a0 = 0.f, a1 = 0.f;
    for (int k = 0; k < D; ++k) { float w = w_ada[(size_t)k * (6 * D) + n]; a0 += sc[0][k] * w; a1 += sc[1][k] * w; }
    mod[n] = a0 + b_ada[n]; mod[6 * D + n] = a1 + b_ada[n];
}
__global__ void k_norm_mod(const float* x, const float* g, const float* mod, int shift_off, int scale_off, bf16* xn, float* rstd_out) {
    int wave = threadIdx.x >> 6, lane = threadIdx.x & 63;
    int m = blockIdx.x * (blockDim.x >> 6) + wave; if (m >= M) return;
    int b = m / T;
    const float4* xr = (const float4*)(x + (size_t)m * D);
    float4 v[8]; float s = 0.f;
#pragma unroll
    for (int j = 0; j < 8; ++j) { v[j] = xr[lane + 64 * j]; s += v[j].x * v[j].x + v[j].y * v[j].y + v[j].z * v[j].z + v[j].w * v[j].w; }
    s = wave_sum(s);
    float rstd = rsqrtf(s * (1.f / D) + NORM_EPS);
    if (rstd_out && lane == 0) rstd_out[m] = rstd;
    const float* sh = mod + b * 6 * D + shift_off; const float* scv = mod + b * 6 * D + scale_off;
#pragma unroll
    for (int j = 0; j < 8; ++j) {
        int col = (lane + 64 * j) * 4;
        float4 gg = *(const float4*)(g + col), s4 = *(const float4*)(scv + col), h4 = *(const float4*)(sh + col);
        float o0 = v[j].x * rstd * gg.x * (1.f + s4.x) + h4.x, o1 = v[j].y * rstd * gg.y * (1.f + s4.y) + h4.y;
        float o2 = v[j].z * rstd * gg.z * (1.f + s4.z) + h4.z, o3 = v[j].w * rstd * gg.w * (1.f + s4.w) + h4.w;
        ushort4 o; o.x = f2bf(o0); o.y = f2bf(o1); o.z = f2bf(o2); o.w = f2bf(o3);
        *(ushort4*)(xn + (size_t)m * D + col) = o;
    }
}

template <class FA, class FB, class FE>
__device__ __forceinline__ void ngemm_tile(float* sm, int K, FA fa, FB fb, FE fe, int tid = threadIdx.x) {
    float* As = sm; float* Bs = sm + 16 * 68;
    const int ty = tid >> 5, tx = tid & 31;
    float acc[4][4];
#pragma unroll
    for (int i = 0; i < 4; ++i)
#pragma unroll
        for (int j = 0; j < 4; ++j) acc[i][j] = 0.f;
    for (int k0 = 0; k0 < K; k0 += 16) {
#pragma unroll
        for (int i = tid; i < 1024; i += 512) { int r = i >> 4, k = i & 15; As[k * 68 + r] = fa(r, k0 + k); }
#pragma unroll
        for (int i = tid; i < 2048; i += 512) { int k = i >> 7, c = i & 127; Bs[k * 132 + c] = fb(k0 + k, c); }
        __syncthreads();
#pragma unroll
        for (int k = 0; k < 16; ++k) {
            float4 a = *(float4*)&As[k * 68 + ty * 4]; float4 b = *(float4*)&Bs[k * 132 + tx * 4];
            float av[4] = {a.x, a.y, a.z, a.w}, bv[4] = {b.x, b.y, b.z, b.w};
#pragma unroll
            for (int i = 0; i < 4; ++i)
#pragma unroll
                for (int j = 0; j < 4; ++j) acc[i][j] += av[i] * bv[j];
        }
        __syncthreads();
    }
    fe(ty * 4, tx * 4, acc);
}
constexpr int NG_SM = 16 * 68 + 16 * 132;

__global__ void __launch_bounds__(512) k_proj(const bf16* xn, const float* w_in, float* projf) {
    __shared__ __attribute__((aligned(16))) float sm[NG_SM];
    const int m0 = (blockIdx.x / (NPROJ / 128)) * 64, n0 = (blockIdx.x % (NPROJ / 128)) * 128;
    ngemm_tile(sm, D,
        [&](int r, int k) { return bf2f(xn[(size_t)(m0 + r) * D + k]); },
        [&](int k, int c) { return w_in[(size_t)k * NPROJ + n0 + c]; },
        [&](int r0, int c0, const float (&acc)[4][4]) {
#pragma unroll
            for (int i = 0; i < 4; ++i) *(float4*)(projf + (size_t)(m0 + r0 + i) * NPROJ + n0 + c0) = make_float4(acc[i][0], acc[i][1], acc[i][2], acc[i][3]);
        });
}
__global__ void k_rot(const float* projf, const float2* ropem, const float2* roper, bf16* proj) {
    size_t i = (size_t)blockIdx.x * blockDim.x + threadIdx.x;
    if (i >= (size_t)M * NPROJ) return;
    int m = (int)(i / NPROJ), col = (int)(i % NPROJ), t = col >> 10, cc = col & 1023;
    const float* row = projf + (size_t)m * NPROJ;
    float x = row[col], val = x;
    if (t == 0 || t == 1) {
        int d = cc & 127;
        if (d < 32) { int f = d & 15; float2 cs = ropem[m * 16 + f]; float xp = row[col + (d < 16 ? 16 : -16)]; val = d < 16 ? x * cs.x - xp * cs.y : x * cs.x + xp * cs.y; }
    } else if (t == 3 || t == 4) {
        int d = cc & 255, f = d & 127; float2 cs = roper[m * 128 + f]; float xp = row[col + (d < 128 ? 128 : -128)];
        val = d < 128 ? x * cs.x - xp * cs.y : x * cs.x + xp * cs.y;
        if (t == 4) val *= 0.0625f;
    }
    proj[(size_t)t * M * 1024 + (size_t)m * 1024 + cc] = f2bf(val);
}
__global__ void k_kmean(const bf16* ka, float* kmean) {
    int i = blockIdx.x * blockDim.x + threadIdx.x; if (i >= NB * 16 * 1024) return;
    int col = i & 1023, bb = i >> 10;
    float s = 0.f;
    for (int r = 0; r < 256; ++r) s += bf2f(ka[(size_t)(bb * 256 + r) * 1024 + col]);
    kmean[i] = s * (1.f / 256.f);
}
__global__ void __launch_bounds__(512) k_moba(const bf16* qa, const bf16* ka, const bf16* va, const float* kmean, bf16* mix) {
    __shared__ float sq[8][128];
    __shared__ float sp[8][1024];
    __shared__ float sg[8][16];
    const int m = blockIdx.x, h = threadIdx.x >> 6, lane = threadIdx.x & 63;
    const int b = m / T, t = m % T, qb = t >> 8;
    float q0 = bf2f(qa[(size_t)m * 1024 + h * 128 + lane]), q1 = bf2f(qa[(size_t)m * 1024 + h * 128 + lane + 64]);
    sq[h][lane] = q0; sq[h][lane + 64] = q1;
    for (int n = 0; n < qb; ++n) {
        const float* km = kmean + ((size_t)(b * 16 + n) * 1024 + h * 128);
        float g = wave_sum(q0 * km[lane] + q1 * km[lane + 64]);
        if (lane == 0) sg[h][n] = g;
    }
    __syncthreads();
    int sel[4]; bool val[4];
    {
        unsigned chosen = 0u;
#pragma unroll
        for (int s = 0; s < 3; ++s) {
            float best = -3e38f; int bi = -1;
            for (int n = 0; n < qb; ++n) if (!((chosen >> n) & 1u) && sg[h][n] > best) { best = sg[h][n]; bi = n; }
            val[s] = bi >= 0; sel[s] = bi >= 0 ? bi : 0; if (bi >= 0) chosen |= 1u << bi;
        }
        sel[3] = qb; val[3] = true;
    }
    const float scale = 0.08838834764831845f;
    float sc[4][4]; float mx = -3e38f;
#pragma unroll
    for (int j = 0; j < 4; ++j)
#pragma unroll
        for (int i = 0; i < 4; ++i) {
            float s = NEGF;
            if (val[j]) {
                int key = sel[j] * 256 + lane + 64 * i;
                if (j < 3 || key <= t) {
                    const uint4* kr = (const uint4*)(ka + (size_t)(b * T + key) * 1024 + h * 128);
                    float a = 0.f;
#pragma unroll 4
                    for (int c = 0; c < 16; ++c) { uint4 kk = kr[c]; const float* qq = &sq[h][c * 8];
                        a += qq[0] * __uint_as_float(kk.x << 16) + qq[1] * __uint_as_float(kk.x & 0xffff0000u) + qq[2] * __uint_as_float(kk.y << 16) + qq[3] * __uint_as_float(kk.y & 0xffff0000u)
                           + qq[4] * __uint_as_float(kk.z << 16) + qq[5] * __uint_as_float(kk.z & 0xffff0000u) + qq[6] * __uint_as_float(kk.w << 16) + qq[7] * __uint_as_float(kk.w & 0xffff0000u); }
                    s = a * scale;
                }
            }
            sc[j][i] = s; mx = fmaxf(mx, s);
        }
    mx = wave_max(mx);
    float sum = 0.f;
#pragma unroll
    for (int j = 0; j < 4; ++j)
#pragma unroll
        for (int i = 0; i < 4; ++i) { float p = __expf(sc[j][i] - mx); sc[j][i] = p; sum += p; }
    sum = wave_sum(sum);
    const float inv = 1.f / sum;
#pragma unroll
    for (int j = 0; j < 4; ++j)
#pragma unroll
        for (int i = 0; i < 4; ++i) sp[h][j * 256 + lane + 64 * i] = sc[j][i] * inv;
    __syncthreads();
    float o0 = 0.f, o1 = 0.f;
#pragma unroll
    for (int j = 0; j < 4; ++j) {
        if (!val[j]) continue;
        const int nk = (j < 3) ? 256 : (t & 255) + 1;
        const bf16* vb = va + (size_t)(b * T + sel[j] * 256) * 1024 + h * 128;
        for (int i = 0; i < nk; ++i) { float p = sp[h][j * 256 + i]; o0 += p * bf2f(vb[(size_t)i * 1024 + lane]); o1 += p * bf2f(vb[(size_t)i * 1024 + lane + 64]); }
    }
    mix[(size_t)m * D + h * 128 + lane] = f2bf(o0); mix[(size_t)m * D + h * 128 + lane + 64] = f2bf(o1);
}
__global__ void __launch_bounds__(512) k_ret(const bf16* qr, const bf16* kr, const bf16* vr, const bf16* gr, bf16* mix) {
    __shared__ float sq[8][256];
    __shared__ float sp[8][1024];
    const int w = threadIdx.x >> 6, lane = threadIdx.x & 63;
    const int m = blockIdx.x * 2 + (w >> 2), h = w & 3, b = m / T, t = m % T;
    for (int j = 0; j < 4; ++j) sq[w][lane + 64 * j] = bf2f(qr[(size_t)m * 1024 + h * 256 + lane + 64 * j]);
    __syncthreads();
    const float gamma = 1.f - exp2f(-5.f - (float)h), lg2 = log2f(gamma);
    float o[4] = {0.f, 0.f, 0.f, 0.f};
    for (int s0 = 0; s0 <= t; s0 += 1024) {
        const int send = min(s0 + 1023, t);
        if ((float)(t - send) * lg2 < -100.f) continue;
#pragma unroll 1
        for (int i = 0; i < 16; ++i) {
            int s = s0 + lane + 64 * i; float p = 0.f;
            if (s <= t) {
                const uint4* kk4 = (const uint4*)(kr + (size_t)(b * T + s) * 1024 + h * 256);
                float a = 0.f;
#pragma unroll 4
                for (int c = 0; c < 32; ++c) { uint4 kk = kk4[c]; const float* qq = &sq[w][c * 8];
                    a += qq[0] * __uint_as_float(kk.x << 16) + qq[1] * __uint_as_float(kk.x & 0xffff0000u) + qq[2] * __uint_as_float(kk.y << 16) + qq[3] * __uint_as_float(kk.y & 0xffff0000u)
                       + qq[4] * __uint_as_float(kk.z << 16) + qq[5] * __uint_as_float(kk.z & 0xffff0000u) + qq[6] * __uint_as_float(kk.w << 16) + qq[7] * __uint_as_float(kk.w & 0xffff0000u); }
                p = a * exp2f((float)(t - s) * lg2);
            }
            sp[w][lane + 64 * i] = p;
        }
        __builtin_amdgcn_wave_barrier();
        const int nk = send - s0 + 1;
        const bf16* vb = vr + (size_t)(b * T + s0) * 1024 + h * 256;
        for (int i = 0; i < nk; ++i) { float p = sp[w][i];
#pragma unroll
            for (int j = 0; j < 4; ++j) o[j] += p * bf2f(vb[(size_t)i * 1024 + lane + 64 * j]); }
        __builtin_amdgcn_wave_barrier();
    }
    float mu = wave_sum(o[0] + o[1] + o[2] + o[3]) * (1.f / 256.f);
    float vs = 0.f;
#pragma unroll
    for (int j = 0; j < 4; ++j) { o[j] -= mu; vs += o[j] * o[j]; }
    float rs = rsqrtf(wave_sum(vs) * (1.f / 256.f) + NORM_EPS);
#pragma unroll
    for (int j = 0; j < 4; ++j) { float g = bf2f(gr[(size_t)m * 1024 + h * 256 + lane + 64 * j]); mix[(size_t)m * D + 1024 + h * 256 + lane + 64 * j] = f2bf(o[j] * rs * silu_f(g)); }
}
__global__ void __launch_bounds__(512) k_outproj(const bf16* mix, const float* w_out, const float* x, const float* mod, float* x1) {
    __shared__ __attribute__((aligned(16))) float sm[NG_SM];
    const int m0 = (blockIdx.x / (D / 128)) * 64, n0 = (blockIdx.x % (D / 128)) * 128;
    const float* gate = mod + (m0 / T) * 6 * D + 2 * D;
    ngemm_tile(sm, D,
        [&](int r, int k) { return bf2f(mix[(size_t)(m0 + r) * D + k]); },
        [&](int k, int c) { return w_out[(size_t)k * D + n0 + c]; },
        [&](int r0, int c0, const float (&acc)[4][4]) {
#pragma unroll
            for (int i = 0; i < 4; ++i) { size_t off = (size_t)(m0 + r0 + i) * D + n0 + c0; float4 xv = *(const float4*)(x + off), g4 = *(const float4*)(gate + n0 + c0);
                *(float4*)(x1 + off) = make_float4(xv.x + g4.x * acc[i][0], xv.y + g4.y * acc[i][1], xv.z + g4.z * acc[i][2], xv.w + g4.w * acc[i][3]); }
        });
}
__global__ void __launch_bounds__(512) k_logits(const float* x1, const float* rstd, const float* g, const float* mod, const float* w_router, float* logits) {
    __shared__ __attribute__((aligned(16))) float sm[NG_SM];
    const int m0 = blockIdx.x * 64, b = m0 / T;
    const float* sh = mod + b * 6 * D + 3 * D; const float* scv = mod + b * 6 * D + 4 * D;
    ngemm_tile(sm, D,
        [&](int r, int k) { return x1[(size_t)(m0 + r) * D + k] * rstd[m0 + r] * g[k] * (1.f + scv[k]) + sh[k]; },
        [&](int k, int c) { return c < 64 ? w_router[(size_t)k * 64 + c] : 0.f; },
        [&](int r0, int c0, const float (&acc)[4][4]) {
            if (c0 < 64) {
#pragma unroll
                for (int i = 0; i < 4; ++i) *(float4*)(logits + (size_t)(m0 + r0 + i) * 64 + c0) = make_float4(acc[i][0], acc[i][1], acc[i][2], acc[i][3]); }
        });
}
__global__ void k_route(const float* logits, const float* bias, unsigned* cnt, int* ltok, float* lw) {
    const int wave = threadIdx.x >> 6, lane = threadIdx.x & 63;
    const int m = blockIdx.x * (blockDim.x >> 6) + wave; if (m >= M) return;
    const float lg = logits[(size_t)m * 64 + lane];
    const float score = 1.f / (1.f + __expf(-lg));
    const float biased = score + bias[lane];
    float m1 = biased;
    m1 = fmaxf(m1, __shfl_xor(m1, 1)); m1 = fmaxf(m1, __shfl_xor(m1, 2)); m1 = fmaxf(m1, __shfl_xor(m1, 4));
    unsigned long long eq = __ballot(biased == m1);
    unsigned gb = (unsigned)(eq >> (lane & ~7)) & 0xffu;
    int first = __ffs(gb) - 1;
    float v2 = ((lane & 7) == first) ? -3e38f : biased;
    v2 = fmaxf(v2, __shfl_xor(v2, 1)); v2 = fmaxf(v2, __shfl_xor(v2, 2)); v2 = fmaxf(v2, __shfl_xor(v2, 4));
    const float gs = m1 + v2; const int g = lane >> 3;
    int grank = 0;
#pragma unroll
    for (int j = 0; j < 8; ++j) { float o = __shfl(gs, j * 8); grank += (o > gs || (o == gs && j < g)) ? 1 : 0; }
    const float masked = grank < 4 ? biased : NEGF;
    int rank = 0;
#pragma unroll
    for (int j = 0; j < 64; ++j) { float o = __shfl(masked, j); rank += (o > masked || (o == masked && j < lane)) ? 1 : 0; }
    const bool selx = rank < 8;
    const float ssum = wave_sum(selx ? score : 0.f);
    if (selx) {
        unsigned pos = atomicAdd(&cnt[lane], 1u);
        ltok[lane * M + pos] = m * 16 + rank; lw[lane * M + pos] = score / ssum * 2.5f;
    }
    if (lane == 0) { ltok[64 * M + m] = m * 16 + 8; lw[64 * M + m] = 1.f; }
}
__device__ __forceinline__ int expert_count(const unsigned* cnt, int e) { return e < 64 ? (int)cnt[e] : M; }
__device__ __forceinline__ int find_expert(const unsigned* cnt, int R0, int& local, int& count) {
    int start = 0;
    for (int e = 0; e < 65; ++e) { int c = expert_count(cnt, e); int pc = (c + 255) / 256 * 256; if (R0 < start + pc) { local = R0 - start; count = c; return e; } start += pc; }
    return -1;
}
__global__ void __launch_bounds__(512) k_gateup(const bf16* xn, const unsigned* cnt, const int* ltok, const float* wg, const float* wu, const float* wsg, const float* wsu, bf16* act) {
    __shared__ __attribute__((aligned(16))) float sm[NG_SM];
    __shared__ int stok[64];
    const int R0 = (blockIdx.x / 8) * 64, j0 = (blockIdx.x % 8) * 64;
    int local, count; const int e = find_expert(cnt, R0, local, count);
    if (e < 0 || local >= count) return;
    if (threadIdx.x < 64) { int r = local + threadIdx.x; stok[threadIdx.x] = r < count ? (ltok[e * M + r] >> 4) : (ltok[e * M + count - 1] >> 4); }
    __syncthreads();
    const float* G = e < 64 ? wg + (size_t)e * D * EH : wsg; const float* U = e < 64 ? wu + (size_t)e * D * EH : wsu;
    ngemm_tile(sm, D,
        [&](int r, int k) { return bf2f(xn[(size_t)stok[r] * D + k]); },
        [&](int k, int c) { return (c & 1) ? U[(size_t)k * EH + j0 + (c >> 1)] : G[(size_t)k * EH + j0 + (c >> 1)]; },
        [&](int r0, int c0, const float (&acc)[4][4]) {
#pragma unroll
            for (int i = 0; i < 4; ++i) { bf16* o = act + (size_t)(R0 + r0 + i) * EH + j0 + (c0 >> 1);
                o[0] = f2bf(silu_f(acc[i][0]) * acc[i][1]); o[1] = f2bf(silu_f(acc[i][2]) * acc[i][3]); }
        });
}
__global__ void __launch_bounds__(512) k_down(const bf16* act, const unsigned* cnt, const int* ltok, const float* lw, const float* wd, const float* wsd, bf16* yslot) {
    __shared__ __attribute__((aligned(16))) float sm[NG_SM];
    __shared__ int stok[64]; __shared__ float sw[64];
    const int R0 = (blockIdx.x / 16) * 64, n0 = (blockIdx.x % 16) * 128;
    int local, count; const int e = find_expert(cnt, R0, local, count);
    if (e < 0 || local >= count) return;
    if (threadIdx.x < 64) { int r = local + threadIdx.x; stok[threadIdx.x] = r < count ? ltok[e * M + r] : -1; sw[threadIdx.x] = r < count ? lw[e * M + r] : 0.f; }
    __syncthreads();
    const float* W = e < 64 ? wd + (size_t)e * EH * D : wsd;
    ngemm_tile(sm, EH,
        [&](int r, int k) { return bf2f(act[(size_t)(R0 + r) * EH + k]); },
        [&](int k, int c) { return W[(size_t)k * D + n0 + c]; },
        [&](int r0, int c0, const float (&acc)[4][4]) {
#pragma unroll
            for (int i = 0; i < 4; ++i) { int tk = stok[r0 + i]; if (tk < 0) continue; float w = sw[r0 + i];
                bf16* o = yslot + ((size_t)(tk >> 4) * 9 + (tk & 15)) * D + n0 + c0;
                ushort4 v; v.x = f2bf(acc[i][0] * w); v.y = f2bf(acc[i][1] * w); v.z = f2bf(acc[i][2] * w); v.w = f2bf(acc[i][3] * w); *(ushort4*)o = v; }
        });
}
__global__ void k_final(const float* x1, const bf16* yslot, const float* mod, const float* gout, float* out) {
    int wave = threadIdx.x >> 6, lane = threadIdx.x & 63;
    int m = blockIdx.x * (blockDim.x >> 6) + wave; if (m >= M) return;
    const float* gate = mod + (m / T) * 6 * D + 5 * D;
    float4 v[8]; float s = 0.f;
#pragma unroll
    for (int j = 0; j < 8; ++j) {
        int col = (lane + 64 * j) * 4;
        float y0 = 0.f, y1 = 0.f, y2 = 0.f, y3 = 0.f;
#pragma unroll
        for (int k = 0; k < 9; ++k) { ushort4 u = *(const ushort4*)(yslot + ((size_t)m * 9 + k) * D + col); y0 += bf2f(u.x); y1 += bf2f(u.y); y2 += bf2f(u.z); y3 += bf2f(u.w); }
        float4 xv = *(const float4*)(x1 + (size_t)m * D + col), g4 = *(const float4*)(gate + col);
        v[j] = make_float4(xv.x + g4.x * y0, xv.y + g4.y * y1, xv.z + g4.z * y2, xv.w + g4.w * y3);
        s += v[j].x * v[j].x + v[j].y * v[j].y + v[j].z * v[j].z + v[j].w * v[j].w;
    }
    s = wave_sum(s);
    float rstd = rsqrtf(s * (1.f / D) + NORM_EPS);
#pragma unroll
    for (int j = 0; j < 8; ++j) { int col = (lane + 64 * j) * 4; float4 gg = *(const float4*)(gout + col);
        *(float4*)(out + (size_t)m * D + col) = make_float4(v[j].x * rstd * gg.x, v[j].y * rstd * gg.y, v[j].z * rstd * gg.z, v[j].w * rstd * gg.w); }
}
}

#define LAS __attribute__((address_space(3)))
#define GAS __attribute__((address_space(1)))
namespace pg8 {
typedef unsigned short bf16_t;
typedef short bf16x8 __attribute__((ext_vector_type(8)));
typedef float f32x4 __attribute__((ext_vector_type(4)));
typedef unsigned u32x4 __attribute__((ext_vector_type(4)));
constexpr int BM = 256, BK = 64, HALF = 128, HTB = HALF * BK * 2, STAGE_BYTES = 8 * HTB, NXCD = 8, WGM = 8;

__host__ __device__ __forceinline__ int lds_byte(int r, int c) { const int st = (r >> 4) * 2 + (c >> 5), rr = r & 15, cc = c & 31, ob = rr * 64 + cc * 2; return st * 1024 + (ob ^ (((ob >> 9) & 1) << 5)); }
__host__ __device__ __forceinline__ void stage_rc(int b, int& R, int& C) { const int st = b / 1024, sb = b % 1024, swz = sb ^ (((sb >> 9) & 1) << 5); R = (st >> 1) * 16 + swz / 64; C = (st & 1) * 32 + (swz % 64) / 2; }
__host__ __device__ __forceinline__ int perm32(int rho) { const int n = rho >> 4, i = rho & 15; return 8 * (i >> 2) + 4 * n + (i & 3); }

struct Unit { int pm, pn, pb, e, r0, cnt; };
struct Gemm { const bf16_t* A; const bf16_t* Bt; int K; };

__device__ __forceinline__ void tile_of(int L, int nM, int nN, int& pm, int& pn) {
    const int nwg = nM * nN; int wgid = L;
    { const int q = nwg / NXCD, r = nwg % NXCD, xcd = wgid % NXCD, off = wgid / NXCD; wgid = (xcd < r ? xcd * (q + 1) : r * (q + 1) + (xcd - r) * q) + off; }
    const int nig = WGM * nN, gid = wgid / nig, fm = gid * WGM, gsz = (nM - fm) < WGM ? (nM - fm) : WGM;
    pm = fm + ((wgid % nig) % gsz); pn = (wgid % nig) / gsz;
}
struct StaticOrder {
    int nM, nN, nwg, G, c;
    __device__ __forceinline__ void init(int Mrows, int N, int G_, int c_) { nM = Mrows / BM; nN = N / BM; nwg = nM * nN; G = G_; c = c_; }
    __device__ __forceinline__ bool next(int i, Unit& u) const {
        const int L = i * G + c; if (L >= nwg) return false;
        tile_of(L, nM, nN, u.pm, u.pn); u.pb = u.pn; u.e = 0; u.r0 = 0; u.cnt = 256; return true;
    }
    __device__ __forceinline__ void rows(const Unit&, const int*& lp, int& cnt) const { lp = nullptr; cnt = 256; }
};
struct MoeOrder {
    int nM, nN, nwg, G, c; const LAS int* tile_e; const LAS int* tile_start; const LAS int* ecount; const int* ltok;
    __device__ __forceinline__ bool next(int i, Unit& u) const {
        const int L = i * G + c; if (L >= nwg) return false;
        tile_of(L, nM, nN, u.pm, u.pn);
        const int e = tile_e[u.pm], jl = u.pm - tile_start[e], rem = ecount[e] - jl * 256;
        u.e = e; u.r0 = jl * 256; u.cnt = rem < 256 ? rem : 256; u.pb = e * nN + u.pn; return true;
    }
    __device__ __forceinline__ void rows(const Unit& u, const int*& lp, int& cnt) const { lp = ltok + (size_t)u.e * 8192 + u.r0; cnt = u.cnt; }
};

__device__ __forceinline__ unsigned cvt_pk_bf16(float lo, float hi) { unsigned r; asm volatile("v_cvt_pk_bf16_f32 %0, %1, %2" : "=v"(r) : "v"(lo), "v"(hi)); return r; }

template <class Epi, class Sched, bool GATHER, bool ALIGN_EPI>
__device__ __forceinline__ void gemm_phase(LAS unsigned char* lds, LAS unsigned char* tab, const Gemm g, const Sched& S, const Epi& E, const int wid) {
    const int lane = lane_id(), tid = wid * 64 + lane, wr = wid >> 2, wc = wid & 3, fr = lane & 15, fq = lane >> 4;
    const int K = g.K, nt = K / BK;
    unsigned voffA[2][2], voffB[2];
#pragma unroll
    for (int i = 0; i < 2; ++i) { int R, C; stage_rc(tid * 16 + i * 8192, R, C); const int Rb = Epi::PERM ? ((R & ~31) + perm32(R & 31)) : R;
        voffA[0][i] = (unsigned)(R * K + C) * 2u; voffA[1][i] = (unsigned)((R + HALF) * K + C) * 2u; voffB[i] = (unsigned)(Rb * K + C) * 2u; }
    const size_t kstep = (size_t)(BK * 2);
    const size_t hstep = (size_t)HALF * K * 2;
    const size_t tstep = 2 * hstep;
    const unsigned ldsw = (unsigned)wid * 1024u;
    const int aoff = lds_byte(wr * 64 + fr, fq * 8), boff = lds_byte(wc * 32 + fr, fq * 8);
#define PG8_SA(b, h) (((b) * 2 + (h)) * HTB)
#define PG8_SB(b, h) ((4 + (b) * 2 + (h)) * HTB)
#define PG8_STAGE(bufoff, gbase, voff) do { _Pragma("unroll") for (int _i = 0; _i < 2; ++_i) \
        __builtin_amdgcn_global_load_lds((const unsigned*)((const char*)(gbase) + (voff)[_i]), (LAS unsigned*)(lds + (bufoff) + ldsw + _i * 8192), 16, 0, 0); } while (0)
#define PG8_LDA(dst, b, h) do { _Pragma("unroll") for (int m = 0; m < 4; ++m) _Pragma("unroll") for (int k = 0; k < 2; ++k) dst[m][k] = *(const LAS bf16x8*)(lds + PG8_SA(b, h) + aoff + m * 2048 + k * 1024); } while (0)
#define PG8_LDB(dst, b, h) do { _Pragma("unroll") for (int n = 0; n < 2; ++n) _Pragma("unroll") for (int k = 0; k < 2; ++k) dst[n][k] = *(const LAS bf16x8*)(lds + PG8_SB(b, h) + boff + n * 2048 + k * 1024); } while (0)
#define PG8_MMA(ai, bj, At, Bt) do { __builtin_amdgcn_s_setprio(1); _Pragma("unroll") for (int m = 0; m < 4; ++m) _Pragma("unroll") for (int n = 0; n < 2; ++n) _Pragma("unroll") for (int k = 0; k < 2; ++k) \
        acc[ai][bj][m][n] = __builtin_amdgcn_mfma_f32_16x16x32_bf16(Bt[n][k], At[m][k], acc[ai][bj][m][n], 0, 0, 0); __builtin_amdgcn_s_setprio(0); } while (0)
#define PG8_WAIT_V(n) asm volatile("s_waitcnt vmcnt(" #n ")" ::: "memory")
#define PG8_WAIT_L(n) asm volatile("s_waitcnt lgkmcnt(" #n ")" ::: "memory")
#define PG8_BAR __builtin_amdgcn_s_barrier()
#define PG8_SCHED __builtin_amdgcn_sched_barrier(0)
    Unit cur, nxt; int ui = 0;
    if (!S.next(0, cur)) return;
    if constexpr (GATHER) {
        const int* lp; int cnt; S.rows(cur, lp, cnt);
#pragma unroll
        for (int h = 0; h < 2; ++h)
#pragma unroll
            for (int i = 0; i < 2; ++i) { int R, C; stage_rc(tid * 16 + i * 8192, R, C); const int r = h * HALF + R; const int tk = r < cnt ? (lp[r] >> 4) : 0; voffA[h][i] = (unsigned)(tk * K + C) * 2u; }
    }
    f32x4 acc[2][2][4][2];
#pragma unroll
    for (int a = 0; a < 2; ++a)
#pragma unroll
        for (int b = 0; b < 2; ++b)
#pragma unroll
            for (int m = 0; m < 4; ++m)
#pragma unroll
                for (int n = 0; n < 2; ++n) acc[a][b][m][n] = (f32x4){0.f, 0.f, 0.f, 0.f};
    bf16x8 At[4][2], B0[2][2], B1[2][2];
    const char* cA = GATHER ? (const char*)g.A : (const char*)g.A + (size_t)cur.pm * tstep; const char* cB = (const char*)g.Bt + (size_t)cur.pb * tstep;
    PG8_STAGE(PG8_SB(0, 0), cB, voffB); PG8_STAGE(PG8_SB(0, 1), cB + hstep, voffB); PG8_STAGE(PG8_SA(0, 0), cA, voffA[0]); PG8_STAGE(PG8_SA(0, 1), cA, voffA[1]);
    if (wr == 1) PG8_BAR;
    PG8_WAIT_V(2); PG8_BAR;
    PG8_STAGE(PG8_SB(1, 0), cB + kstep, voffB); PG8_STAGE(PG8_SA(1, 0), cA + kstep, voffA[0]); PG8_STAGE(PG8_SB(1, 1), cB + hstep + kstep, voffB);
    PG8_WAIT_V(6); PG8_BAR;
    for (;;) {
        const bool has_next = S.next(ui + 1, nxt);
        int ncnt = 256;
        if constexpr (GATHER) { if (has_next) { const int* nlp; S.rows(nxt, nlp, ncnt);
            if (wid == 0) __builtin_amdgcn_global_load_lds((const unsigned*)(nlp + lane * 4), (LAS unsigned*)tab, 16, 0, 0); } }
        const char* nA = has_next ? (GATHER ? (const char*)g.A : (const char*)g.A + (size_t)nxt.pm * tstep) : cA; const char* nB = has_next ? (const char*)g.Bt + (size_t)nxt.pb * tstep : cB;
        for (int t = 0; t < nt; t += 2) {
            const bool last = (t == nt - 2);
            const char* a1 = cA + (size_t)(t + 1) * kstep;
            const char* a2 = last ? nA : cA + (size_t)(t + 2) * kstep; const char* b2 = last ? nB : cB + (size_t)(t + 2) * kstep;
            const char* a3 = a2 + kstep; const char* b3 = b2 + kstep;
            PG8_LDB(B0, 0, 0); PG8_LDB(B1, 0, 1); PG8_SCHED; PG8_LDA(At, 0, 0); PG8_STAGE(PG8_SA(1, 1), a1, voffA[1]);
            if constexpr (GATHER) { if (last && has_next) {
#pragma unroll
                for (int h = 0; h < 2; ++h)
#pragma unroll
                    for (int i = 0; i < 2; ++i) { int R, C; stage_rc(tid * 16 + i * 8192, R, C); const int r = h * HALF + R; const int v = ((const LAS int*)tab)[r]; const int tk = r < ncnt ? (v >> 4) : 0; voffA[h][i] = (unsigned)(tk * K + C) * 2u; } } }
            PG8_WAIT_V(8); PG8_WAIT_L(0); PG8_BAR; PG8_MMA(0, 0, At, B0); PG8_MMA(0, 1, At, B1); PG8_BAR; PG8_SCHED;
            PG8_LDA(At, 0, 1); PG8_STAGE(PG8_SB(0, 0), b2, voffB); PG8_STAGE(PG8_SB(0, 1), b2 + hstep, voffB); PG8_STAGE(PG8_SA(0, 0), a2, voffA[0]);
            PG8_WAIT_V(8); PG8_WAIT_L(0); PG8_BAR; PG8_MMA(1, 0, At, B0); PG8_MMA(1, 1, At, B1); PG8_BAR; PG8_SCHED;
            PG8_LDB(B0, 1, 0); PG8_LDB(B1, 1, 1); PG8_SCHED; PG8_LDA(At, 1, 0); PG8_STAGE(PG8_SA(0, 1), a2, voffA[1]);
            PG8_WAIT_V(8); PG8_WAIT_L(0); PG8_BAR; PG8_MMA(0, 0, At, B0); PG8_MMA(0, 1, At, B1); PG8_BAR; PG8_SCHED;
            PG8_LDA(At, 1, 1); PG8_STAGE(PG8_SB(1, 0), b3, voffB); PG8_STAGE(PG8_SB(1, 1), b3 + hstep, voffB); PG8_STAGE(PG8_SA(1, 0), a3, voffA[0]);
            PG8_WAIT_V(8); PG8_WAIT_L(0); PG8_BAR; PG8_MMA(1, 0, At, B0); PG8_MMA(1, 1, At, B1); PG8_BAR; PG8_SCHED;
        }
        if constexpr (ALIGN_EPI) { if (wr == 0) PG8_BAR; }
        E(acc, cur, wr, wc, fr, fq);
        if (!has_next) break;
#pragma unroll
        for (int a = 0; a < 2; ++a)
#pragma unroll
            for (int b = 0; b < 2; ++b)
#pragma unroll
                for (int m = 0; m < 4; ++m)
#pragma unroll
                    for (int n = 0; n < 2; ++n) acc[a][b][m][n] = (f32x4){0.f, 0.f, 0.f, 0.f};
        cur = nxt; cA = nA; cB = nB; ++ui;
        if constexpr (ALIGN_EPI) { if (wr == 1) PG8_BAR; }
    }
    PG8_WAIT_V(0);
    if constexpr (!ALIGN_EPI) { if (wr == 0) PG8_BAR; }
    PG8_BAR;
#undef PG8_SA
#undef PG8_SB
#undef PG8_STAGE
#undef PG8_LDA
#undef PG8_LDB
#undef PG8_MMA
#undef PG8_WAIT_V
#undef PG8_WAIT_L
#undef PG8_BAR
#undef PG8_SCHED
}
}
namespace pg8 {
struct EpiProj {
    static constexpr bool PERM = true;
    bf16_t* O; const float2* ropem; const float2* roper; float* kmean;
    __device__ __forceinline__ void operator()(const f32x4 (&acc)[2][2][4][2], const Unit& u, int wr, int wc, int fr, int fq) const {
        const int t = u.pn >> 2, coltile = (u.pn & 3) * BM;
        bf16_t* base = O + (size_t)t * M * 1024;
        const int row0 = u.pm * BM + wr * 64 + fr, col0 = coltile + wc * 32 + 8 * fq;
        const bool moba_rot = (t < 2) && (wc == 0);
        const bool ret_rot = (t == 3) || (t == 4);
        const float osc = (t == 4) ? 0.0625f : 1.f;
        float ks[2][8];
#pragma unroll
        for (int bj = 0; bj < 2; ++bj)
#pragma unroll
            for (int j = 0; j < 8; ++j) ks[bj][j] = 0.f;
#pragma unroll
        for (int ai = 0; ai < 2; ++ai)
#pragma unroll
            for (int m = 0; m < 4; ++m) {
                const int row = row0 + ai * HALF + m * 16;
                float v[2][8];
#pragma unroll
                for (int bj = 0; bj < 2; ++bj)
#pragma unroll
                    for (int j = 0; j < 8; ++j) v[bj][j] = acc[ai][bj][m][j >> 2][j & 3];
                if (moba_rot) {
                    const f32x4* cs4 = (const f32x4*)(ropem + (size_t)row * 16 + 8 * (fq & 1));
                    f32x4 cs[4];
#pragma unroll
                    for (int q = 0; q < 4; ++q) cs[q] = cs4[q];
#pragma unroll
                    for (int bj = 0; bj < 2; ++bj)
#pragma unroll
                        for (int j = 0; j < 8; ++j) { const float c = cs[j >> 1][(j & 1) * 2], s = cs[j >> 1][(j & 1) * 2 + 1]; const float xp = __shfl_xor(v[bj][j], 32);
                            v[bj][j] = (fq < 2) ? v[bj][j] * c - xp * s : v[bj][j] * c + xp * s; }
                } else if (ret_rot) {
                    const f32x4* cs4 = (const f32x4*)(roper + (size_t)row * 128 + wc * 32 + 8 * fq);
                    f32x4 cs[4];
#pragma unroll
                    for (int q = 0; q < 4; ++q) cs[q] = cs4[q];
#pragma unroll
                    for (int j = 0; j < 8; ++j) { const float c = cs[j >> 1][(j & 1) * 2], s = cs[j >> 1][(j & 1) * 2 + 1]; const float x1 = v[0][j], x2 = v[1][j];
                        v[0][j] = (x1 * c - x2 * s) * osc; v[1][j] = (x2 * c + x1 * s) * osc; }
                }
#pragma unroll
                for (int bj = 0; bj < 2; ++bj) {
                    u32x4 w; w.x = cvt_pk_bf16(v[bj][0], v[bj][1]); w.y = cvt_pk_bf16(v[bj][2], v[bj][3]); w.z = cvt_pk_bf16(v[bj][4], v[bj][5]); w.w = cvt_pk_bf16(v[bj][6], v[bj][7]);
                    *(u32x4*)(base + (size_t)row * 1024 + col0 + bj * HALF) = w;
#pragma unroll
                    for (int j = 0; j < 8; ++j) ks[bj][j] += v[bj][j];
                }
            }
        if (t == 1) {
#pragma unroll
            for (int bj = 0; bj < 2; ++bj)
#pragma unroll
                for (int j = 0; j < 8; ++j) { float s = ks[bj][j]; s += __shfl_xor(s, 1); s += __shfl_xor(s, 2); s += __shfl_xor(s, 4); s += __shfl_xor(s, 8);
                    if (fr == 0) atomicAdd(kmean + (size_t)u.pm * 1024 + col0 + bj * HALF + j, s * (1.f / 256.f)); }
        }
    }
};
struct EpiOut {
    static constexpr bool PERM = false;
    const float* x; const float* mod; float* x1;
    __device__ __forceinline__ void operator()(const f32x4 (&acc)[2][2][4][2], const Unit& u, int wr, int wc, int fr, int fq) const {
        const int row0 = u.pm * BM + wr * 64 + fr, col0 = u.pn * BM + wc * 32 + 4 * fq;
        const float* gate = mod + (u.pm / 16) * 6 * D + 2 * D;
#pragma unroll
        for (int bj = 0; bj < 2; ++bj)
#pragma unroll
            for (int n = 0; n < 2; ++n) { const int col = col0 + bj * HALF + n * 16; const f32x4 g4 = *(const f32x4*)(gate + col);
#pragma unroll
                for (int ai = 0; ai < 2; ++ai)
#pragma unroll
                    for (int m = 0; m < 4; ++m) { const size_t off = (size_t)(row0 + ai * HALF + m * 16) * D + col; const f32x4 xv = *(const f32x4*)(x + off);
                        *(f32x4*)(x1 + off) = xv + g4 * acc[ai][bj][m][n]; } }
    }
};
struct EpiAct {
    static constexpr bool PERM = true;
    bf16_t* act;
    __device__ __forceinline__ void operator()(const f32x4 (&acc)[2][2][4][2], const Unit& u, int wr, int wc, int fr, int fq) const {
        const int row0 = u.pm * BM + wr * 64 + fr, col0 = u.pn * HALF + wc * 32 + 8 * fq;
#pragma unroll
        for (int ai = 0; ai < 2; ++ai)
#pragma unroll
            for (int m = 0; m < 4; ++m) { float o[8];
#pragma unroll
                for (int j = 0; j < 8; ++j) { const float gt = acc[ai][0][m][j >> 2][j & 3], up = acc[ai][1][m][j >> 2][j & 3]; o[j] = gt / (1.f + __expf(-gt)) * up; }
                u32x4 w; w.x = cvt_pk_bf16(o[0], o[1]); w.y = cvt_pk_bf16(o[2], o[3]); w.z = cvt_pk_bf16(o[4], o[5]); w.w = cvt_pk_bf16(o[6], o[7]);
                *(u32x4*)(act + (size_t)(row0 + ai * HALF + m * 16) * EH + col0) = w; }
    }
};
struct EpiDown {
    static constexpr bool PERM = true;
    bf16_t* yslot; const int* ltok; const float* lw;
    __device__ __forceinline__ void operator()(const f32x4 (&acc)[2][2][4][2], const Unit& u, int wr, int wc, int fr, int fq) const {
        const int col0 = u.pn * BM + wc * 32 + 8 * fq;
        const int* lt = ltok + (size_t)u.e * 8192 + u.r0; const float* lwp = lw + (size_t)u.e * 8192 + u.r0;
#pragma unroll
        for (int ai = 0; ai < 2; ++ai)
#pragma unroll
            for (int m = 0; m < 4; ++m) { const int r = ai * HALF + wr * 64 + m * 16 + fr;
                if (r < u.cnt) { const int tk = lt[r]; const float w = lwp[r]; bf16_t* orow = yslot + ((size_t)(tk >> 4) * 9 + (tk & 15)) * D + col0;
#pragma unroll
                    for (int bj = 0; bj < 2; ++bj) { const f32x4 v0 = acc[ai][bj][m][0] * w, v1 = acc[ai][bj][m][1] * w;
                        u32x4 o; o.x = cvt_pk_bf16(v0[0], v0[1]); o.y = cvt_pk_bf16(v0[2], v0[3]); o.z = cvt_pk_bf16(v1[0], v1[1]); o.w = cvt_pk_bf16(v1[2], v1[3]);
                        *(u32x4*)(orow + bj * HALF) = o; } } }
    }
};
}
namespace att {
typedef short bf16x8 __attribute__((ext_vector_type(8)));
typedef short s16x4 __attribute__((ext_vector_type(4)));
typedef float f32x16 __attribute__((ext_vector_type(16)));
typedef float f32x4 __attribute__((ext_vector_type(4)));
typedef unsigned u32x4 __attribute__((ext_vector_type(4)));
constexpr int DH = 128, QP = 1024, OP = 2048;
constexpr float SCALE = 0.08838834764831845f, THR = 8.f;
constexpr int NW = 8, QBLK = 32, KVBLK = 64, QB = NW * QBLK;
constexpr int SHM_V = KVBLK * DH * 2, SHM_K = KVBLK * DH * 2;
constexpr int LDS_BYTES = 2 * SHM_V + 2 * SHM_K + NW * 64 * 4;
#define KSWZ(row, colB) ((row) * 256 + ((colB) ^ (((row) & 7) << 4)))
#define SBAR() __builtin_amdgcn_sched_barrier(0)
__device__ __forceinline__ int v_st(int k, int c) { const int kk = (k & ~0xC) | ((k & 4) << 1) | ((k & 8) >> 1); return ((kk >> 3) * 4 + (c >> 5)) * 512 + ((kk & 7) * 32 + (c & 31)) * 2; }
__device__ __forceinline__ int v_rd_base(int lane) { return ((lane & 3) << 3) | (((lane >> 2) & 3) << 6) | (((lane >> 4) & 1) << 5) | (((lane >> 5) & 1) << 8); }
constexpr int v_rd_off(int d0, int ks, int half) { return d0 * 512 + ks * 4096 + half * 2048; }
__device__ __forceinline__ int crow(int r, int hi) { return (r & 3) + 8 * (r >> 2) + 4 * hi; }
__device__ __forceinline__ unsigned cvtpk(float lo, float hi) { unsigned r; asm volatile("v_cvt_pk_bf16_f32 %0, %1, %2" : "=v"(r) : "v"(lo), "v"(hi)); return r; }
__device__ __forceinline__ bf16x8 load8(const bf16* p) { return *reinterpret_cast<const bf16x8*>(p); }
__device__ __forceinline__ void mask_tile(f32x16& p0, f32x16& p1, int dq) {
    const float NEG = -__builtin_inff();
#pragma unroll
    for (int r = 0; r < 16; ++r) { const int c = (r & 3) + 8 * (r >> 2);
        if (dq - c < 0) p0[r] = NEG;
        if (dq - c - 32 < 0) p1[r] = NEG; }
}
__device__ __forceinline__ void partialSM(f32x16& p0, f32x16& p1, float& m_reg, float& mn, float& alpha) {
    float pmax = p0[0];
#pragma unroll
    for (int r = 1; r < 16; ++r) pmax = fmaxf(pmax, p0[r]);
#pragma unroll
    for (int r = 0; r < 16; ++r) pmax = fmaxf(pmax, p1[r]);
    { auto rr = __builtin_amdgcn_permlane32_swap(__float_as_uint(pmax), __float_as_uint(pmax), false, false);
      pmax = fmaxf(__uint_as_float(rr[0]), __uint_as_float(rr[1])); }
    constexpr float C2 = 1.4426950408889634f * SCALE;
    if (__builtin_expect(__all((pmax - m_reg) * SCALE <= THR), 1)) { mn = m_reg; alpha = 1.f; }
    else { mn = fmaxf(m_reg, pmax); alpha = __builtin_amdgcn_exp2f((m_reg - mn) * C2); m_reg = mn; }
    const float mnL = -mn * C2;
#pragma unroll
    for (int r = 0; r < 16; ++r) p0[r] = fmaf(p0[r], C2, mnL);
#pragma unroll
    for (int r = 0; r < 16; ++r) p1[r] = fmaf(p1[r], C2, mnL);
#pragma unroll
    for (int r = 0; r < 16; ++r) p0[r] = __builtin_amdgcn_exp2f(p0[r]);
}
__device__ __forceinline__ void finishSM(f32x16& p0, f32x16& p1, float alpha, float& l_reg, bf16x8& pa0, bf16x8& pa1, bf16x8& pa2, bf16x8& pa3) {
#pragma unroll
    for (int r = 0; r < 16; ++r) p1[r] = __builtin_amdgcn_exp2f(p1[r]);
    float ps = 0;
#pragma unroll
    for (int r = 0; r < 16; ++r) ps += p0[r];
#pragma unroll
    for (int r = 0; r < 16; ++r) ps += p1[r];
    { auto rr = __builtin_amdgcn_permlane32_swap(__float_as_uint(ps), __float_as_uint(ps), false, false);
      ps = __uint_as_float(rr[0]) + __uint_as_float(rr[1]); }
    l_reg = l_reg * alpha + ps;
#define PK4(P, B_, OUT) do { unsigned a0 = cvtpk(P[B_+0], P[B_+1]), a1 = cvtpk(P[B_+2], P[B_+3]);                          \
        unsigned b0 = cvtpk(P[B_+4], P[B_+5]), b1 = cvtpk(P[B_+6], P[B_+7]);                                             \
        auto r0 = __builtin_amdgcn_permlane32_swap(a0, b0, false, false); auto r1 = __builtin_amdgcn_permlane32_swap(a1, b1, false, false); \
        u32x4 w = {r0[0], r1[0], r0[1], r1[1]}; OUT = *reinterpret_cast<bf16x8*>(&w); } while (0)
    PK4(p0, 0, pa0); PK4(p0, 8, pa1); PK4(p1, 0, pa2); PK4(p1, 8, pa3);
#undef PK4
}
template <int KB>
__device__ __forceinline__ void qkt(f32x16& p0, f32x16& p1, const char* K_lds, int r32, int hi, const bf16x8* qr) {
    p0 = f32x16{}; p1 = f32x16{};
    const char* kb[4];
#pragma unroll
    for (int dd = 0; dd < 4; ++dd) kb[dd] = K_lds + KB * SHM_K + KSWZ(r32, (dd * 16 + hi * 8) * 2);
#pragma unroll
    for (int d0 = 0; d0 < 8; ++d0) { const char* a = kb[d0 & 3] + (d0 >> 2) * 128;
        bf16x8 b0 = *reinterpret_cast<const bf16x8*>(a);
        bf16x8 b1 = *reinterpret_cast<const bf16x8*>(a + 32 * 256);
        p0 = __builtin_amdgcn_mfma_f32_32x32x16_bf16(b0, qr[d0], p0, 0, 0, 0);
        p1 = __builtin_amdgcn_mfma_f32_32x32x16_bf16(b1, qr[d0], p1, 0, 0, 0); }
}
template <int VB>
__device__ __forceinline__ void pv_tile(f32x16* o, int vb0, bf16x8 pa0, bf16x8 pa1, bf16x8 pa2, bf16x8 pa3) {
#define TRRD(dst, off) asm volatile("ds_read_b64_tr_b16 %0, %1 offset:%2" : "=&v"(dst) : "v"(vb0), "i"(off) : "memory")
#define PV_D0(d0) do { s16x4 l0, l1, l2, l3, h0, h1, h2, h3; constexpr int b_ = VB * SHM_V + v_rd_off(d0, 0, 0); \
        TRRD(l0, b_); TRRD(h0, b_ + 2048); TRRD(l1, b_ + 4096); TRRD(h1, b_ + 6144); TRRD(l2, b_ + 8192); TRRD(h2, b_ + 10240); TRRD(l3, b_ + 12288); TRRD(h3, b_ + 14336); \
        asm volatile("s_waitcnt lgkmcnt(0)" ::: "memory"); SBAR(); \
        o[d0] = __builtin_amdgcn_mfma_f32_32x32x16_bf16(pa0, (bf16x8){l0[0], l0[1], l0[2], l0[3], h0[0], h0[1], h0[2], h0[3]}, o[d0], 0, 0, 0);   \
        o[d0] = __builtin_amdgcn_mfma_f32_32x32x16_bf16(pa1, (bf16x8){l1[0], l1[1], l1[2], l1[3], h1[0], h1[1], h1[2], h1[3]}, o[d0], 0, 0, 0);   \
        o[d0] = __builtin_amdgcn_mfma_f32_32x32x16_bf16(pa2, (bf16x8){l2[0], l2[1], l2[2], l2[3], h2[0], h2[1], h2[2], h2[3]}, o[d0], 0, 0, 0);   \
        o[d0] = __builtin_amdgcn_mfma_f32_32x32x16_bf16(pa3, (bf16x8){l3[0], l3[1], l3[2], l3[3], h3[0], h3[1], h3[2], h3[3]}, o[d0], 0, 0, 0); } while (0)
    PV_D0(0); PV_D0(1); PV_D0(2); PV_D0(3);
#undef PV_D0
#undef TRRD
}
struct BlockRef { const unsigned char* ws; int item; };
__device__ __forceinline__ int it_bh(int item) { return (item & 7) * 2 + ((item >> 3) & 1); }
__device__ __forceinline__ int it_qb(int item) { return 15 - (item >> 4); }
__device__ __forceinline__ const bf16* it_Q(const BlockRef& r) { const int bh = it_bh(r.item), b = bh >> 3, h = bh & 7; return (const bf16*)(r.ws + WS_PROJ) + (size_t)(b * T + it_qb(r.item) * 256) * 1024 + h * 128; }
__device__ __forceinline__ const bf16* it_K(const BlockRef& r) { const int bh = it_bh(r.item), b = bh >> 3, h = bh & 7; return (const bf16*)(r.ws + WS_PROJ) + (size_t)M * 1024 + (size_t)(b * T) * 1024 + h * 128; }
__device__ __forceinline__ const bf16* it_V(const BlockRef& r) { return it_K(r) + (size_t)M * 1024; }
__device__ __forceinline__ bf16* it_O(const BlockRef& r) { const int bh = it_bh(r.item), b = bh >> 3, h = bh & 7; return (bf16*)(r.ws + WS_MIX) + (size_t)(b * T + it_qb(r.item) * 256) * D + h * 128; }
__device__ __forceinline__ const float* it_KM(const BlockRef& r) { const int bh = it_bh(r.item), b = bh >> 3, h = bh & 7; return (const float*)(r.ws + WS_KMEAN) + (size_t)(b * 16) * 1024 + h * 128; }
struct Seam { bf16x8 qr[8]; bf16x8 st_v0, st_v1, st_k0, st_k1; };
#define ROW(p, k0, rr) ((p) + (size_t)((k0) + (rr)) * QP + sc)
#define VMW() asm volatile("s_waitcnt vmcnt(0)" ::: "memory")
#define VMWN(n) asm volatile("s_waitcnt vmcnt(%0)" :: "i"(n) : "memory")
#define SLOAD_H(Kp, Vp, k0) do { S.st_v0 = load8(ROW(Vp, k0, sr)); S.st_v1 = load8(ROW(Vp, k0, 32 + sr));              \
                         S.st_k0 = load8(ROW(Kp, k0, sr)); S.st_k1 = load8(ROW(Kp, k0, 32 + sr)); } while (0)
#define SWRITE_HK(bf) do { *(bf16x8*)(K_lds + (bf) * SHM_K + kws) = S.st_k0; *(bf16x8*)(K_lds + (bf) * SHM_K + kws + 32 * 256) = S.st_k1; } while (0)
#define SWRITE_HV(bf) do { *(bf16x8*)(V_lds + (bf) * SHM_V + vst0) = S.st_v0; *(bf16x8*)(V_lds + (bf) * SHM_V + vst1) = S.st_v1; } while (0)
#define SWRITE_H(bf) do { SWRITE_HV(bf); SWRITE_HK(bf); } while (0)
__device__ __forceinline__ void moba_prime(const BlockRef& cur, char* lds, Seam& S, const int wid) {
    const int lane = lane_id(), tid = wid * 64 + lane, r32 = lane & 31, hi = lane >> 5;
    const int sr = tid >> 4, sc = (tid & 15) * 8, kws = KSWZ(sr, sc * 2); char* K_lds = lds + 2 * SHM_V;
#pragma unroll
    for (int d0 = 0; d0 < 8; ++d0) S.qr[d0] = load8(it_Q(cur) + (size_t)(wid * QBLK + r32) * QP + d0 * 16 + hi * 8);
    SLOAD_H(it_K(cur), it_V(cur), 0); VMW(); SWRITE_HK(0);
    __syncthreads();
}
__device__ __forceinline__ void moba_block(const BlockRef& cur, const BlockRef& nxt, char* lds, Seam& S, const int wid) {
    const int lane = lane_id(), tid = wid * 64 + lane, r32 = lane & 31, hi = lane >> 5;
    const int qb = it_qb(cur.item), P0 = qb * 256;
    const int NT = (P0 + QB) / KVBLK;
    const int qlo = P0 + wid * QBLK, qm = qlo + r32 - 4 * hi;
    char* V_lds = lds; char* K_lds = lds + 2 * SHM_V;
    float* ws = (float*)(lds + 2 * SHM_V + 2 * SHM_K) + wid * 64; float* li_l = ws, * al_l = ws + 32;
    unsigned selmask = 0u;
    if (qb > 0) {
        float v0 = -__builtin_inff(), v1 = v0, v2 = v0; int i0 = -1, i1 = -1, i2 = -1;
#pragma unroll 1
        for (int n = 0; n < qb; ++n) {
            const float* km = it_KM(cur) + (size_t)n * 1024 + hi * 8;
            float g = 0.f;
#pragma unroll
            for (int d0 = 0; d0 < 8; ++d0) { const f32x4 ka = *(const f32x4*)(km + d0 * 16), kb4 = *(const f32x4*)(km + d0 * 16 + 4);
#pragma unroll
                for (int j = 0; j < 4; ++j) { g += __uint_as_float(((unsigned)(unsigned short)S.qr[d0][j]) << 16) * ka[j]; g += __uint_as_float(((unsigned)(unsigned short)S.qr[d0][4 + j]) << 16) * kb4[j]; } }
            g += __shfl_xor(g, 32);
            const bool b2 = g > v2, b1 = g > v1, b0 = g > v0;
            const float nv2 = b1 ? v1 : (b2 ? g : v2); const int ni2 = b1 ? i1 : (b2 ? n : i2);
            const float nv1 = b0 ? v0 : (b1 ? g : v1); const int ni1 = b0 ? i0 : (b1 ? n : i1);
            v2 = nv2; i2 = ni2; v1 = nv1; i1 = ni1; if (b0) { v0 = g; i0 = n; }
        }
        if (i0 >= 0) selmask |= 1u << i0; if (i1 >= 0) selmask |= 1u << i1; if (i2 >= 0) selmask |= 1u << i2;
    }
    float m_reg = -1e30f, l_reg = 0; f32x16 o[4] = {};
    const int sr = tid >> 4, sc = (tid & 15) * 8, vst0 = v_st(sr, sc), vst1 = v_st(32 + sr, sc), kws = KSWZ(sr, sc * 2);
    const int vb0 = (int)(uintptr_t)V_lds + v_rd_base(lane);
    const bf16* Kh = it_K(cur); const bf16* Vh = Kh + (size_t)M * 1024;
#define RESC(a) do { if (__any((a) < 1.f)) { if (hi == 0) al_l[r32] = (a); asm volatile("s_waitcnt lgkmcnt(0)" ::: "memory");              \
                     for (int d_ = 0; d_ < 4; ++d_) for (int r = 0; r < 16; ++r) o[d_][r] *= al_l[crow(r, hi)]; } } while (0)
#define KBASE(t) ((t) * KVBLK)
#define MASKT(P0_, P1_, t) do { const int kb_ = KBASE(t); const int nb_ = kb_ >> 8;                                              \
        if (nb_ < qb) { if (!((selmask >> nb_) & 1u)) { const float NEG_ = -__builtin_inff();                                   \
            _Pragma("unroll") for (int r = 0; r < 16; ++r) { P0_[r] = NEG_; P1_[r] = NEG_; } } }                                  \
        else if (kb_ + KVBLK - 1 > qlo) mask_tile(P0_, P1_, qm - kb_); } while (0)
    constexpr int NQL = 8;
#define SEAM_K0() do { VMWN(NQL); SWRITE_HK(0); SBAR(); } while (0)
    f32x16 pA0, pA1, pB0, pB1; float mnA, mnB, alA, alB; bf16x8 pa0, pa1, pa2, pa3;
    SWRITE_HV(0); SBAR();
    if (NT > 1) { SLOAD_H(Kh, Vh, KBASE(1)); }
    SBAR(); qkt<0>(pA0, pA1, K_lds, r32, hi, S.qr);
    MASKT(pA0, pA1, 0); partialSM(pA0, pA1, m_reg, mnA, alA);
    if (NT > 1) { VMW(); SWRITE_H(1); }
    __syncthreads();
#define HALF_STEP(PX0, PX1, mnX, alX, PY0, PY1, alY, t, KB, VB, SB) do {                                                      \
        SBAR(); qkt<KB>(PX0, PX1, K_lds, r32, hi, S.qr);                                                                      \
        finishSM(PY0, PY1, alY, l_reg, pa0, pa1, pa2, pa3); SBAR();                                                           \
        if ((t) + 1 < NT) { SLOAD_H(Kh, Vh, KBASE((t) + 1)); SBAR(); }                                                        \
        pv_tile<VB>(o, vb0, pa0, pa1, pa2, pa3); MASKT(PX0, PX1, (t)); partialSM(PX0, PX1, m_reg, mnX, alX);                  \
        __syncthreads();                                                                                                      \
        if ((t) + 1 < NT) { VMW(); SWRITE_H(SB); }                                                                            \
        RESC(alX); __syncthreads(); } while (0)
    for (int t = 1; t + 1 < NT; t += 2) {
        HALF_STEP(pB0, pB1, mnB, alB, pA0, pA1, alA, t, 1, 0, 0);
        HALF_STEP(pA0, pA1, mnA, alA, pB0, pB1, alB, t + 1, 0, 1, 1);
    }
    const bool even = (NT & 1) == 0;
    if (even) { SBAR(); qkt<1>(pB0, pB1, K_lds, r32, hi, S.qr); SBAR(); }
    SLOAD_H(it_K(nxt), it_V(nxt), 0); SBAR();
#pragma unroll
    for (int d0 = 0; d0 < 8; ++d0) S.qr[d0] = load8(it_Q(nxt) + (size_t)(wid * QBLK + r32) * QP + d0 * 16 + hi * 8);
    SBAR();
    finishSM(pA0, pA1, alA, l_reg, pa0, pa1, pa2, pa3); SBAR();
    pv_tile<0>(o, vb0, pa0, pa1, pa2, pa3);
    if (even) { MASKT(pB0, pB1, NT - 1); partialSM(pB0, pB1, m_reg, mnB, alB); __syncthreads(); RESC(alB);
        finishSM(pB0, pB1, alB, l_reg, pa0, pa1, pa2, pa3); SBAR(); pv_tile<1>(o, vb0, pa0, pa1, pa2, pa3); }
    SBAR(); SEAM_K0();
    if (hi == 0) li_l[r32] = l_reg; asm volatile("s_waitcnt lgkmcnt(0)" ::: "memory");
    float rli[16];
#pragma unroll
    for (int r = 0; r < 16; ++r) rli[r] = __builtin_amdgcn_rcpf(li_l[crow(r, hi)]);
    bf16* Ob = it_O(cur) + (size_t)(wid * QBLK + 4 * hi) * OP + r32;
#pragma unroll
    for (int r = 0; r < 16; ++r) { bf16* p = Ob; asm volatile("" : "+v"(p));
        p += (size_t)((r & 3) + 8 * (r >> 2)) * OP;
#pragma unroll
        for (int d0 = 0; d0 < 4; ++d0) { const float v = o[d0][r] * rli[r];
            const float vn = __shfl_xor(v, 1);
            if ((r32 & 1) == 0) *(unsigned*)(p + d0 * 32) = cvtpk(v, vn); } }
    __syncthreads();
#undef RESC
#undef KBASE
#undef MASKT
#undef SEAM_K0
#undef HALF_STEP
}
#undef ROW
#undef VMW
#undef VMWN
#undef SLOAD_H
#undef SWRITE_HK
#undef SWRITE_HV
#undef SWRITE_H
#undef KSWZ
#undef SBAR
}
constexpr int NWAVES = 8;
constexpr int RING_BYTES = 143360;
constexpr int TAB_OFF = RING_BYTES;
constexpr int TILE_E_OFF = TAB_OFF + 1024;
constexpr int TILE_S_OFF = TILE_E_OFF + 2048;
constexpr int ECNT_OFF = TILE_S_OFF + 512;
constexpr int MISC_OFF = ECNT_OFF + 512;
constexpr int LDS_BYTES = MISC_OFF + 256;
static_assert(LDS_BYTES <= 160 * 1024 && LDS_BYTES > 80 * 1024, "one workgroup per CU");

typedef float f32x4 __attribute__((ext_vector_type(4)));
typedef unsigned v4u __attribute__((ext_vector_type(4)));
typedef unsigned v2u __attribute__((ext_vector_type(2)));
typedef GAS unsigned gu32;
#define RLX_AGENT __ATOMIC_RELAXED, __HIP_MEMORY_SCOPE_AGENT

#define XB_TMO      128
#define XB_XCNT(j)  (256  + 64 * (j))
#define XB_XSUB(j)  (1280 + 64 * (j))
#define XB_XGEN(j)  (2304 + 64 * (j))
#define XB_TOP      3328
#define XB_TOPGEN   3392
#define XCD_BAR_WORDS 3456
#define XB_SPIN_CAP (1u << 20)
__device__ __forceinline__ unsigned xb_ld(unsigned* p)              { return __hip_atomic_load(p, __ATOMIC_RELAXED, __HIP_MEMORY_SCOPE_AGENT); }
__device__ __forceinline__ unsigned xb_add(unsigned* p, unsigned v) { return __hip_atomic_fetch_add(p, v, __ATOMIC_RELAXED, __HIP_MEMORY_SCOPE_AGENT); }
__device__ __forceinline__ unsigned xb_xcc_id() { return (unsigned)__builtin_amdgcn_s_getreg((3 << 11) | 20) & 0xFu; }
#define XB_SPIN(cond, bar) do { unsigned _sp = 0; while (cond) { __builtin_amdgcn_s_sleep(1); \
    if ((++_sp & 255u) == 0u) { if (xb_ld(&(bar)[XB_TMO])) break; if (_sp > XB_SPIN_CAP) { atomicAdd(&(bar)[XB_TMO], 1u); break; } } } } while (0)
struct XcdBarrier { unsigned* bar; unsigned x; volatile LAS unsigned* st; };
__device__ __forceinline__ XcdBarrier xcd_barrier_post(unsigned* bar, volatile LAS unsigned* st, int tid) {
    XcdBarrier b; b.bar = bar; b.x = xb_xcc_id(); b.st = st;
    if (tid == 0) (void)xb_add(&bar[XB_XCNT(b.x)], 1u);
    return b;
}
__device__ __forceinline__ void xcd_barrier_complete(unsigned* bar, unsigned x, unsigned& nloc, unsigned& nx) {
    const unsigned G = gridDim.x * gridDim.y * gridDim.z;
    unsigned sum, cnt, mine, sp = 0u;
    for (;;) {
        sum = 0u; cnt = 0u; mine = 0u;
#pragma unroll
        for (unsigned j = 0; j < 16; ++j) { const unsigned c = xb_ld(&bar[XB_XCNT(j)]); sum += c; cnt += (c > 0u) ? 1u : 0u; mine = (j == x) ? c : mine; }
        if (sum == G) break;
        __builtin_amdgcn_s_sleep(1);
        if ((++sp & 255u) == 0u) { if (xb_ld(&bar[XB_TMO])) break; if (sp > XB_SPIN_CAP) { atomicAdd(&bar[XB_TMO], 1u); break; } }
    }
    nloc = mine > 0u ? mine : 1u; nx = cnt > 0u ? cnt : 1u;
}
__device__ __forceinline__ void xcd_barrier(const XcdBarrier& b, int tid) {
    asm volatile("s_waitcnt vmcnt(0)" ::: "memory");
    __syncthreads();
    if (tid == 0) {
        unsigned* bar = b.bar;
        __builtin_amdgcn_s_waitcnt(0);
        unsigned nloc = b.st[0], nx = b.st[1];
        if (nloc == 0u) { xcd_barrier_complete(bar, b.x, nloc, nx); b.st[0] = nloc; b.st[1] = nx; }
        const unsigned old = xb_add(&bar[XB_XSUB(b.x)], 1u);
        const unsigned gen = old / nloc;
        if (old + 1u == (gen + 1u) * nloc) {
            __builtin_amdgcn_fence(__ATOMIC_RELEASE, "agent");
            asm volatile("s_waitcnt vmcnt(0)" ::: "memory");
            const unsigned og = xb_add(&bar[XB_TOP], 1u);
            const unsigned tg = og / nx;
            if (og + 1u == (tg + 1u) * nx) xb_add(&bar[XB_TOPGEN], 1u);
            else XB_SPIN(xb_ld(&bar[XB_TOPGEN]) == tg, bar);
            __builtin_amdgcn_fence(__ATOMIC_ACQUIRE, "agent");
            xb_add(&bar[XB_XGEN(b.x)], 1u);
            asm volatile("s_waitcnt vmcnt(0)" ::: "memory");
        } else {
            XB_SPIN(xb_ld(&bar[XB_XGEN(b.x)]) == gen, bar);
            __builtin_amdgcn_fence(__ATOMIC_ACQUIRE, "agent");
            asm volatile("s_waitcnt vmcnt(0)" ::: "memory");
        }
    }
    __syncthreads();
}

struct Args { const void* in[18]; float* out; unsigned char* ws; int ph_lo, ph_hi, li, pad; };
struct Frame {
    LAS unsigned char* lds; int wave, G, bid;
    unsigned char* ws;
};

__device__ __forceinline__ void transpose_item(const float* W, int N, bf16* WT, int Kout, size_t rb, int k0, int n0, LAS bf16* scr, int lane) {
    const int kr = lane >> 4, nc = (lane & 15) * 4;
    f32x4 v[16];
#pragma unroll
    for (int i = 0; i < 16; ++i) v[i] = *(const GAS f32x4*)(W + (size_t)(k0 + 4 * i + kr) * N + n0 + nc);
#pragma unroll
    for (int i = 0; i < 16; ++i) { const int k = 4 * i + kr;
        const unsigned p0 = pg8::cvt_pk_bf16(v[i][0], v[i][1]), p1 = pg8::cvt_pk_bf16(v[i][2], v[i][3]);
        scr[(nc + 0) * 68 + k] = (bf16)(p0 & 0xffffu); scr[(nc + 1) * 68 + k] = (bf16)(p0 >> 16);
        scr[(nc + 2) * 68 + k] = (bf16)(p1 & 0xffffu); scr[(nc + 3) * 68 + k] = (bf16)(p1 >> 16); }
    asm volatile("s_waitcnt lgkmcnt(0)" ::: "memory");
    const int c = lane & 7;
#pragma unroll
    for (int j = 0; j < 8; ++j) { const int n = (lane >> 3) + 8 * j;
        const LAS v2u* s = (const LAS v2u*)(scr + n * 68 + 8 * c); const v2u a = s[0], b = s[1];
        v4u o; o.x = a.x; o.y = a.y; o.z = b.x; o.w = b.y;
        *(GAS v4u*)(WT + (rb + n) * (size_t)Kout + k0 + 8 * c) = o; }
    asm volatile("s_waitcnt lgkmcnt(0)" ::: "memory");
}
namespace ret {
typedef short bf16x8 __attribute__((ext_vector_type(8)));
typedef short s16x4 __attribute__((ext_vector_type(4)));
typedef float f32x16 __attribute__((ext_vector_type(16)));
typedef float f32x4 __attribute__((ext_vector_type(4)));
typedef unsigned u32x4 __attribute__((ext_vector_type(4)));
constexpr int VSTR = 528;
constexpr int PSTR = 272;
constexpr int IMG = 128 * VSTR;
__device__ __forceinline__ int crow(int r, int hi) { return (r & 3) + 8 * (r >> 2) + 4 * hi; }
__device__ __forceinline__ s16x4 vtr(const LAS char* p) { return __builtin_bit_cast(s16x4, __builtin_amdgcn_ds_read_tr16_b64_v4i16((LAS s16x4*)p)); }
__device__ __forceinline__ bf16x8 tr_frag(const LAS char* img, int str, int k0, int c0, int lane) {
    const int g = lane >> 4, h = g >> 1, i = lane & 15, q = i >> 2, p = i & 3;
    const LAS char* a = img + (k0 + 8 * h + q) * str + (c0 + 16 * (g & 1) + 4 * p) * 2;
    const s16x4 lo = vtr(a), hi = vtr(a + 4 * str);
    return (bf16x8){lo[0], lo[1], lo[2], lo[3], hi[0], hi[1], hi[2], hi[3]};
}
__device__ __forceinline__ unsigned cvtpk(float lo, float hi) { unsigned r; asm volatile("v_cvt_pk_bf16_f32 %0, %1, %2" : "=v"(r) : "v"(lo), "v"(hi)); return r; }
__device__ __forceinline__ float gamma_log2(int h) { return log2f(1.f - exp2f(-5.f - (float)h)); }
__device__ __forceinline__ void stage_chunk(LAS char* img, const bf16* src, int tid, bool scale, float lg) {
#pragma unroll
    for (int i = 0; i < 8; ++i) { const int row = (tid >> 5) + 16 * i, pc = tid & 31;
        u32x4 v = *(const GAS u32x4*)(src + (size_t)row * 1024 + pc * 8);
        if (scale) { const float z = exp2f(lg * (float)(127 - row));
            u32x4 o;
#pragma unroll
            for (int j = 0; j < 4; ++j) o[j] = cvtpk(__uint_as_float(v[j] << 16) * z, __uint_as_float(v[j] & 0xffff0000u) * z);
            v = o; }
        *(LAS u32x4*)(img + row * VSTR + pc * 16) = v; }
}
__device__ __forceinline__ void ret_state(const unsigned char* ws, LAS unsigned char* lds, int item, int wid) {
    const int lane = lane_id(), tid = wid * 64 + lane, hi = lane >> 5, c = lane & 31;
    const int bh = item >> 5, ch = item & 31, b = bh >> 2, h = bh & 3;
    const bf16* proj = (const bf16*)(ws + WS_PROJ); const size_t PS = (size_t)M * 1024;
    const bf16* kr = proj + 4 * PS + (size_t)(b * T + ch * 128) * 1024 + h * 256; const bf16* vr = proj + 5 * PS + (size_t)(b * T + ch * 128) * 1024 + h * 256;
    LAS char* vimg = (LAS char*)lds; LAS char* kimg = vimg + IMG;
    const float lg = gamma_log2(h);
    stage_chunk(vimg, vr, tid, false, 0.f); stage_chunk(kimg, kr, tid, true, lg);
    __syncthreads();
    f32x16 acc[8];
#pragma unroll
    for (int j = 0; j < 8; ++j) acc[j] = f32x16{};
#pragma unroll 2
    for (int ks = 0; ks < 8; ++ks) {
        const bf16x8 a = tr_frag(vimg, VSTR, ks * 16, wid * 32, lane);
#pragma unroll
        for (int j = 0; j < 8; ++j) { const bf16x8 bb = tr_frag(kimg, VSTR, ks * 16, j * 32, lane); acc[j] = __builtin_amdgcn_mfma_f32_32x32x16_bf16(a, bb, acc[j], 0, 0, 0); }
    }
    float* ut = (float*)(ws + WS_U) + (size_t)item * 65536;
#pragma unroll
    for (int j = 0; j < 8; ++j)
#pragma unroll
        for (int r = 0; r < 16; ++r) ut[(size_t)(wid * 32 + crow(r, hi)) * 256 + j * 32 + c] = acc[j][r];
    __syncthreads();
}
__device__ __forceinline__ void ret_scan(const unsigned char* ws, int gtid, int gthreads) {
    const float* ut = (const float*)(ws + WS_U); bf16* st = (bf16*)(ws + WS_S);
    for (int e = gtid; e < 8 * 16384; e += gthreads) {
        const int bh = e >> 14, off = (e & 16383) * 4; const float dec = exp2f(128.f * gamma_log2(bh & 3));
        f32x4 s = {0.f, 0.f, 0.f, 0.f};
        f32x4 u = *(const GAS f32x4*)(ut + (size_t)(bh * 32) * 65536 + off);
#pragma unroll 4
        for (int ch = 0; ch < 32; ++ch) {
            f32x4 un = u; if (ch + 1 < 32) un = *(const GAS f32x4*)(ut + (size_t)(bh * 32 + ch + 1) * 65536 + off);
            v2u w; w.x = cvtpk(s[0], s[1]); w.y = cvtpk(s[2], s[3]);
            *(GAS v2u*)(st + (size_t)(bh * 32 + ch) * 65536 + off) = w;
            s = s * dec + u; u = un;
        }
    }
}
__device__ __forceinline__ void ret_out(const unsigned char* ws, LAS unsigned char* lds, int item, int wid) {
    const int lane = lane_id(), tid = wid * 64 + lane, hi = lane >> 5, c = lane & 31, r32 = c;
    const int bh = item >> 5, ch = item & 31, b = bh >> 2, h = bh & 3;
    const bf16* proj = (const bf16*)(ws + WS_PROJ); const size_t PS = (size_t)M * 1024; const size_t row0 = (size_t)(b * T + ch * 128);
    const bf16* qr = proj + 3 * PS + row0 * 1024 + h * 256; const bf16* kr = proj + 4 * PS + row0 * 1024 + h * 256;
    const bf16* vr = proj + 5 * PS + row0 * 1024 + h * 256; const bf16* gr = proj + 6 * PS + row0 * 1024 + h * 256;
    const bf16* st = (const bf16*)(ws + WS_S) + (size_t)item * 65536;
    LAS char* vimg = (LAS char*)lds; LAS char* pimg = vimg + IMG; LAS float* stat = (LAS float*)(pimg + 128 * PSTR);
    const float lg = gamma_log2(h);
    const int rb = wid & 3, half = wid >> 2;
    stage_chunk(vimg, vr, tid, false, 0.f);
    bf16x8 qf[16];
#pragma unroll
    for (int ks = 0; ks < 16; ++ks) qf[ks] = *(const GAS bf16x8*)(qr + (size_t)(rb * 32 + r32) * 1024 + ks * 16 + hi * 8);
#pragma unroll
    for (int jj = 0; jj < 2; ++jj) { const int cb = 2 * half + jj;
        f32x16 p = f32x16{};
        if (cb <= rb) {
#pragma unroll
            for (int ks = 0; ks < 16; ++ks) { const bf16x8 kf = *(const GAS bf16x8*)(kr + (size_t)(cb * 32 + r32) * 1024 + ks * 16 + hi * 8);
                p = __builtin_amdgcn_mfma_f32_32x32x16_bf16(qf[ks], kf, p, 0, 0, 0); }
        }
#pragma unroll
        for (int r = 0; r < 16; ++r) { const int tq = rb * 32 + crow(r, hi), tk = cb * 32 + c, df = tq - tk;
            const float v = df >= 0 ? p[r] * exp2f(lg * (float)df) : 0.f;
            *(LAS bf16*)(pimg + tq * PSTR + tk * 2) = f2bf(v); }
    }
    __syncthreads();
    f32x16 accP[4], accS[4];
#pragma unroll
    for (int j = 0; j < 4; ++j) { accP[j] = f32x16{}; accS[j] = f32x16{}; }
    for (int ks = 0; ks < 2 * rb + 2; ++ks) {
        const bf16x8 a = *(const LAS bf16x8*)(pimg + (rb * 32 + r32) * PSTR + (ks * 16 + hi * 8) * 2);
#pragma unroll
        for (int j = 0; j < 4; ++j) { const bf16x8 bb = tr_frag(vimg, VSTR, ks * 16, (half * 4 + j) * 32, lane); accP[j] = __builtin_amdgcn_mfma_f32_32x32x16_bf16(a, bb, accP[j], 0, 0, 0); }
    }
    const bf16* qr2 = qr + (size_t)(rb * 32 + r32) * 1024 + hi * 8; asm volatile("" : "+v"(qr2));
#pragma unroll
    for (int ks = 0; ks < 16; ++ks) {
        const bf16x8 qa = *(const GAS bf16x8*)(qr2 + ks * 16);
#pragma unroll
        for (int j = 0; j < 4; ++j) { const bf16x8 sf = *(const GAS bf16x8*)(st + (size_t)((half * 4 + j) * 32 + r32) * 256 + ks * 16 + hi * 8);
            accS[j] = __builtin_amdgcn_mfma_f32_32x32x16_bf16(qa, sf, accS[j], 0, 0, 0); }
    }
    float s1[16], s2[16];
#pragma unroll
    for (int r = 0; r < 16; ++r) { const float xi = exp2f(lg * (float)(crow(r, hi) + rb * 32 + 1)); float a1 = 0.f, a2 = 0.f;
#pragma unroll
        for (int j = 0; j < 4; ++j) { const float v = accP[j][r] + xi * accS[j][r]; accP[j][r] = v; a1 += v; a2 += v * v; }
        s1[r] = a1; s2[r] = a2; }
#pragma unroll
    for (int r = 0; r < 16; ++r) {
#pragma unroll
        for (int o = 1; o < 32; o <<= 1) { s1[r] += __shfl_xor(s1[r], o); s2[r] += __shfl_xor(s2[r], o); }
        if (c == 0) { stat[(half * 128 + rb * 32 + crow(r, hi)) * 2 + 0] = s1[r]; stat[(half * 128 + rb * 32 + crow(r, hi)) * 2 + 1] = s2[r]; } }
    __syncthreads();
    bf16* mixo = (bf16*)(ws + WS_MIX) + row0 * D + 1024 + h * 256;
#pragma unroll
    for (int r = 0; r < 16; ++r) { const int row = rb * 32 + crow(r, hi);
        const float t1 = stat[row * 2] + stat[(128 + row) * 2], t2 = stat[row * 2 + 1] + stat[(128 + row) * 2 + 1];
        const float mu = t1 * (1.f / 256.f), var = t2 * (1.f / 256.f) - mu * mu, rs = rsqrtf(fmaxf(var, 0.f) + NORM_EPS);
#pragma unroll
        for (int j = 0; j < 4; ++j) { const int col = (half * 4 + j) * 32 + c;
            const float g = bf2f(gr[(size_t)row * 1024 + col]);
            const float v = (accP[j][r] - mu) * rs * (g / (1.f + __expf(-g)));
            const float vn = __shfl_xor(v, 1);
            if ((c & 1) == 0) *(unsigned*)(mixo + (size_t)row * D + col) = cvtpk(v, vn); } }
    __syncthreads();
}
}
__device__ __forceinline__ void p0_prologue(const Frame& F, const Args& a) {
    const int lane = lane_id(), tid = F.wave * 64 + lane; (void)tid;
    const float* w_ada = (const float*)a.in[3]; const float* cvec = (const float*)a.in[1]; const int* pos = (const int*)a.in[2];
    const float* w_in = (const float*)a.in[8]; const float* w_out = (const float*)a.in[9];
    const float* w_gate = (const float*)a.in[12]; const float* w_up = (const float*)a.in[13]; const float* w_down = (const float*)a.in[14];
    const float* ws_gate = (const float*)a.in[15]; const float* ws_up = (const float*)a.in[16]; const float* ws_down = (const float*)a.in[17];
    bf16* WinT = (bf16*)(F.ws + WS_WIN); bf16* WoutT = (bf16*)(F.ws + WS_WOUT); bf16* WguT = (bf16*)(F.ws + WS_WGU); bf16* WdT = (bf16*)(F.ws + WS_WD);
    float2* ropem = (float2*)(F.ws + WS_ROPEM); float2* roper = (float2*)(F.ws + WS_ROPER); float* modp = (float*)(F.ws + WS_MODP);
    LAS bf16* scr = (LAS bf16*)(F.lds + F.wave * 8704);
    LAS double* sinv = (LAS double*)(F.lds + 8 * 8704);
    if (tid < 144) sinv[tid] = tid < 16 ? pow(500000.0, -(double)tid / 16.0) : pow(10000.0, -(double)(tid - 16) / 127.0);
    __syncthreads();
    const int gw = F.bid * NWAVES + F.wave, NGW = F.G * NWAVES;
    constexpr int I_MOD = 16 * 48, I_ROPE = (M * 144) / 64;
    constexpr int I_IN = 32 * 112, I_OUT = 32 * 32, I_GU = 65 * 2 * 32 * 8, I_DN = 65 * 8 * 32;
    constexpr int NITEMS = I_MOD + I_ROPE + I_IN + I_OUT + I_GU + I_DN;
    for (int it = gw; it < NITEMS; it += NGW) {
        int r = it;
        if (r < I_MOD) {
            const int kc = r / 48, n0 = (r % 48) * 256 + lane * 4;
            f32x4 a0 = {0.f, 0.f, 0.f, 0.f}, a1 = {0.f, 0.f, 0.f, 0.f};
#pragma unroll 8
            for (int k = kc * 128; k < kc * 128 + 128; ++k) { const f32x4 w = *(const GAS f32x4*)(w_ada + (size_t)k * (6 * D) + n0);
                const float c0 = cvec[k], c1 = cvec[D + k]; a0 += w * silu_f(c0); a1 += w * silu_f(c1); }
            *(f32x4*)(modp + (size_t)(kc * 2 + 0) * (6 * D) + n0) = a0; *(f32x4*)(modp + (size_t)(kc * 2 + 1) * (6 * D) + n0) = a1;
            continue; }
        r -= I_MOD;
        if (r < I_ROPE) {
            const int idx = r * 64 + lane; float2* dst; int m, f;
            if (idx < M * 16) { m = idx >> 4; f = idx & 15; dst = ropem + idx; } else { const int j = idx - M * 16; m = j >> 7; f = 16 + (j & 127); dst = roper + j; }
            const double rev = (double)pos[m] * sinv[f] * 0.15915494309189535; const float fr = (float)(rev - floor(rev));
            *dst = make_float2(__builtin_amdgcn_cosf(fr), __builtin_amdgcn_sinf(fr));
            continue; }
        r -= I_ROPE;
        if (r < I_IN) { transpose_item(w_in, NPROJ, WinT, D, (size_t)(r % 112) * 64, (r / 112) * 64, (r % 112) * 64, scr, lane); continue; }
        r -= I_IN;
        if (r < I_OUT) { transpose_item(w_out, D, WoutT, D, (size_t)(r % 32) * 64, (r / 32) * 64, (r % 32) * 64, scr, lane); continue; }
        r -= I_OUT;
        if (r < I_GU) {
            const int eu = r / 256, e = eu >> 1, up = eu & 1, q = r % 256, kb = q / 8, nb = q % 8, n0 = nb * 64;
            const float* W = e < 64 ? (up ? w_up : w_gate) + (size_t)e * D * EH : (up ? ws_up : ws_gate);
            const size_t rb = (size_t)e * 1024 + (n0 >> 7) * 256 + up * 128 + (n0 & 127);
            transpose_item(W, EH, WguT, D, rb, kb * 64, n0, scr, lane); continue; }
        r -= I_GU;
        { const int e = r / 256, q = r % 256, kb = q / 32, nb = q % 32;
          const float* W = e < 64 ? w_down + (size_t)e * EH * D : ws_down;
          transpose_item(W, D, WdT, EH, (size_t)e * D + nb * 64, kb * 64, nb * 64, scr, lane); }
    }
}
__device__ __forceinline__ void norm_rows(const Frame& F, const float* x, const float* g, const LAS float* smod  , bf16* xn, float* rstd_out, int m_lo, int m_step, int m_hi) {
    const int lane = lane_id(), tid = F.wave * 64 + lane; (void)tid;
    for (int m = m_lo; m < m_hi; m += m_step) {
        const int b = m / T;
        const GAS f32x4* xr = (const GAS f32x4*)(x + (size_t)m * D);
        f32x4 v[8]; float s = 0.f;
#pragma unroll
        for (int j = 0; j < 8; ++j) { v[j] = xr[lane + 64 * j]; s += v[j][0] * v[j][0] + v[j][1] * v[j][1] + v[j][2] * v[j][2] + v[j][3] * v[j][3]; }
        s = wave_sum(s);
        const float rstd = rsqrtf(s * (1.f / D) + NORM_EPS);
        if (rstd_out && lane == 0) rstd_out[m] = rstd;
#pragma unroll
        for (int j = 0; j < 8; ++j) { const int col = (lane + 64 * j) * 4;
            const f32x4 gg = *(const f32x4*)(g + col), h4 = *(const LAS f32x4*)(smod + (b * 2 + 0) * D + col), s4 = *(const LAS f32x4*)(smod + (b * 2 + 1) * D + col);
            const f32x4 o = v[j] * rstd * gg * (s4 + 1.f) + h4;
            v2u w; w.x = pg8::cvt_pk_bf16(o[0], o[1]); w.y = pg8::cvt_pk_bf16(o[2], o[3]);
            *(v2u*)(xn + (size_t)m * D + col) = w; }
    }
}
__device__ __forceinline__ void p1_norm(const Frame& F, const Args& a) {
    const int lane = lane_id(), tid = F.wave * 64 + lane; (void)tid;
    const float* x = (const float*)a.in[0]; const float* b_ada = (const float*)a.in[4]; const float* g = (const float*)a.in[5];
    const float* modp = (const float*)(F.ws + WS_MODP); float* mod = (float*)(F.ws + WS_MOD); bf16* xn = (bf16*)(F.ws + WS_XN);
    LAS float* smod = (LAS float*)F.lds;
    for (int i = tid; i < 2 * 2 * D; i += NWAVES * 64) { const int b = i / (2 * D), which = (i / D) & 1, col = i % D, n = which * D + col;
        float s = b_ada[n];
#pragma unroll
        for (int kc = 0; kc < 16; ++kc) s += modp[(size_t)(kc * 2 + b) * (6 * D) + n];
        smod[i] = s; }
    if (F.bid < 48) { const int i = F.bid * 512 + tid, b = i / (6 * D), n = i % (6 * D);
        float s = b_ada[n];
#pragma unroll
        for (int kc = 0; kc < 16; ++kc) s += modp[(size_t)(kc * 2 + b) * (6 * D) + n];
        mod[i] = s; }
    __syncthreads();
    norm_rows(F, x, g, smod, xn, nullptr, F.bid * NWAVES + F.wave, F.G * NWAVES, M);
    __syncthreads();
}
__device__ __forceinline__ void p10_final(const Frame& F, const Args& a) {
    const int lane = lane_id(), tid = F.wave * 64 + lane; (void)tid;
    const float* x1 = (const float*)(F.ws + WS_X1); const bf16* yslot = (const bf16*)(F.ws + WS_YSLOT); const float* mod = (const float*)(F.ws + WS_MOD);
    const float* gout = (const float*)a.in[7]; float* out = a.out;
    for (int m = F.bid * NWAVES + F.wave; m < M; m += F.G * NWAVES) {
        const float* gate = mod + (m / T) * 6 * D + 5 * D;
        f32x4 v[8]; float s = 0.f;
#pragma unroll
        for (int j = 0; j < 8; ++j) { const int col = (lane + 64 * j) * 4;
            f32x4 y = {0.f, 0.f, 0.f, 0.f};
#pragma unroll
            for (int k = 0; k < 9; ++k) { const v2u u = *(const GAS v2u*)(yslot + ((size_t)m * 9 + k) * D + col);
                y[0] += __uint_as_float(u.x << 16); y[1] += __uint_as_float(u.x & 0xffff0000u); y[2] += __uint_as_float(u.y << 16); y[3] += __uint_as_float(u.y & 0xffff0000u); }
            const f32x4 xv = *(const GAS f32x4*)(x1 + (size_t)m * D + col), g4 = *(const f32x4*)(gate + col);
            v[j] = xv + g4 * y; s += v[j][0] * v[j][0] + v[j][1] * v[j][1] + v[j][2] * v[j][2] + v[j][3] * v[j][3]; }
        s = wave_sum(s);
        const float rstd = rsqrtf(s * (1.f / D) + NORM_EPS);
#pragma unroll
        for (int j = 0; j < 8; ++j) { const int col = (lane + 64 * j) * 4; const f32x4 gg = *(const f32x4*)(gout + col);
            *(f32x4*)(out + (size_t)m * D + col) = v[j] * rstd * gg; }
    }
}
__device__ __forceinline__ int moe_tables(const Frame& F, const unsigned* cnt) {
    const int lane = lane_id(), tid = F.wave * 64 + lane; (void)tid;
    LAS int* tile_e = (LAS int*)(F.lds + TILE_E_OFF); LAS int* tile_s = (LAS int*)(F.lds + TILE_S_OFF); LAS int* ecnt = (LAS int*)(F.lds + ECNT_OFF);
    if (tid < 65) ecnt[tid] = tid < 64 ? (int)__hip_atomic_load(cnt + tid, RLX_AGENT) : M;
    __syncthreads();
    if (tid == 0) { int s = 0; for (int e = 0; e < 65; ++e) { tile_s[e] = s; s += (ecnt[e] + 255) >> 8; } tile_s[65] = s; }
    __syncthreads();
    const int total = tile_s[65];
    if (tid < 65) { for (int p = tile_s[tid]; p < tile_s[tid + 1]; ++p) tile_e[p] = tid; }
    __syncthreads();
    return total;
}
__device__ __forceinline__ void route_row(float lg, const float* bias, int m, unsigned* cnt, int* ltok, float* lw, int lane) {
    const float score = 1.f / (1.f + __expf(-lg));
    const float biased = score + bias[lane];
    float m1 = biased;
    m1 = fmaxf(m1, __shfl_xor(m1, 1)); m1 = fmaxf(m1, __shfl_xor(m1, 2)); m1 = fmaxf(m1, __shfl_xor(m1, 4));
    const unsigned long long eq = __ballot(biased == m1);
    const unsigned gb = (unsigned)(eq >> (lane & ~7)) & 0xffu;
    const int first = __ffs(gb) - 1;
    float v2 = ((lane & 7) == first) ? -3e38f : biased;
    v2 = fmaxf(v2, __shfl_xor(v2, 1)); v2 = fmaxf(v2, __shfl_xor(v2, 2)); v2 = fmaxf(v2, __shfl_xor(v2, 4));
    const float gs = m1 + v2; const int g = lane >> 3;
    int grank = 0;
#pragma unroll
    for (int j = 0; j < 8; ++j) { const float o = __shfl(gs, j * 8); grank += (o > gs || (o == gs && j < g)) ? 1 : 0; }
    const float masked = grank < 4 ? biased : NEGF;
    int rank = 0;
#pragma unroll
    for (int j = 0; j < 64; ++j) { const float o = __shfl(masked, j); rank += (o > masked || (o == masked && j < lane)) ? 1 : 0; }
    const bool selx = rank < 8;
    const float ssum = wave_sum(selx ? score : 0.f);
    if (selx) { const unsigned p = atomicAdd(&cnt[lane], 1u); ltok[lane * M + p] = m * 16 + rank; lw[lane * M + p] = score / ssum * 2.5f; }
    if (lane == 0) { ltok[64 * M + m] = m * 16 + 8; lw[64 * M + m] = 1.f; }
}
__device__ __forceinline__ void p7_route(const Frame& F, const Args& a) {
    typedef float f32x16 __attribute__((ext_vector_type(16)));
    const int lane = lane_id(), w = F.wave, tid = w * 64 + lane;
    const float* x1 = (const float*)(F.ws + WS_X1); const float* g = (const float*)a.in[6]; const float* mod = (const float*)(F.ws + WS_MOD);
    const float* w_router = (const float*)a.in[10]; const float* rbias = (const float*)a.in[11];
    bf16* xn = (bf16*)(F.ws + WS_XN); unsigned* cnt = (unsigned*)(F.ws + WS_CTL) + CW_CNT; int* ltok = (int*)(F.ws + WS_LTOK); float* lw = (float*)(F.ws + WS_LW);
    LAS float* gs = (LAS float*)F.lds; LAS float* sh = gs + 2048; LAS float* cvec = sh + 2048; LAS float* cpart = cvec + 64; LAS float* ssq = cpart + 512; LAS float* part = ssq + 256;
    for (int tile = F.bid; tile < M / 32; tile += F.G) {
        const int m0 = tile * 32, b = m0 / T;
        for (int i = tid; i < D; i += NWAVES * 64) { gs[i] = g[i] * (1.f + mod[b * 6 * D + 4 * D + i]); sh[i] = mod[b * 6 * D + 3 * D + i]; }
        __syncthreads();
        { const int e = tid & 63, sl = tid >> 6; float s = 0.f;
#pragma unroll 8
          for (int k = sl * 256; k < sl * 256 + 256; ++k) s += sh[k] * w_router[(size_t)k * 64 + e];
          cpart[sl * 64 + e] = s; }
        __syncthreads();
        if (tid < 64) { float s = 0.f;
#pragma unroll
            for (int sl = 0; sl < 8; ++sl) s += cpart[sl * 64 + tid];
            cvec[tid] = s; }
        const int i = lane & 31, kh = lane >> 5;
        f32x16 acc0 = f32x16{}, acc1 = f32x16{}; float ss = 0.f;
        const float* xrow = x1 + (size_t)(m0 + i) * D + w * 256 + 4 * kh;
        const float* wb = w_router + (size_t)(w * 256 + 4 * kh) * 64 + i;
        const LAS float* gq = gs + w * 256 + 4 * kh;
#pragma unroll 4
        for (int q = 0; q < 32; ++q) {
            const f32x4 x = *(const GAS f32x4*)(xrow + 8 * q); const f32x4 gg = *(const LAS f32x4*)(gq + 8 * q);
#pragma unroll
            for (int c = 0; c < 4; ++c) { const float b0 = wb[(size_t)(8 * q + c) * 64] * gg[c], b1 = wb[(size_t)(8 * q + c) * 64 + 32] * gg[c];
                acc0 = __builtin_amdgcn_mfma_f32_32x32x2f32(x[c], b0, acc0, 0, 0, 0); acc1 = __builtin_amdgcn_mfma_f32_32x32x2f32(x[c], b1, acc1, 0, 0, 0); ss += x[c] * x[c]; }
        }
        ss += __shfl_xor(ss, 32);
#pragma unroll
        for (int r = 0; r < 16; ++r) { const int row = (r & 3) + 8 * (r >> 2) + 4 * kh; part[(w * 32 + row) * 64 + i] = acc0[r]; part[(w * 32 + row) * 64 + 32 + i] = acc1[r]; }
        if (kh == 0) ssq[w * 32 + i] = ss;
        __syncthreads();
        for (int rr = 0; rr < 4; ++rr) { const int row = w * 4 + rr, m = m0 + row;
            float acc = 0.f, s2 = 0.f;
#pragma unroll
            for (int ww = 0; ww < 8; ++ww) { acc += part[(ww * 32 + row) * 64 + lane]; s2 += ssq[ww * 32 + row]; }
            const float rstd = rsqrtf(s2 * (1.f / D) + NORM_EPS);
            route_row(rstd * acc + cvec[lane], rbias, m, cnt, ltok, lw, lane);
            const GAS f32x4* xr = (const GAS f32x4*)(x1 + (size_t)m * D);
#pragma unroll
            for (int j = 0; j < 8; ++j) { const int col = (lane + 64 * j) * 4; const f32x4 v = xr[lane + 64 * j];
                const f32x4 o = v * rstd * *(const LAS f32x4*)(gs + col) + *(const LAS f32x4*)(sh + col);
                v2u pk; pk.x = pg8::cvt_pk_bf16(o[0], o[1]); pk.y = pg8::cvt_pk_bf16(o[2], o[3]);
                *(v2u*)(xn + (size_t)m * D + col) = pk; }
        }
        __syncthreads();
    }
}

__device__ __forceinline__ void p3_attention(const Frame& F) {
    char* lds = (char*)F.lds;
    att::Seam S; bool first = true;
    for (int it = F.bid; it < 256; it += F.G) {
        const att::BlockRef cur{F.ws, it}, nxt{F.ws, (it + F.G < 256) ? it + F.G : it};
        if (first) { att::moba_prime(cur, lds, S, F.wave); first = false; }
        att::moba_block(cur, nxt, lds, S, F.wave);
    }
    const int nl = F.G / 2;
    if (F.bid >= F.G - nl) for (int ri = F.bid - (F.G - nl); ri < 256; ri += nl) ret::ret_state(F.ws, F.lds, ri, F.wave);
}

__global__ void __launch_bounds__(NWAVES * 64, 2) mk_fwd(Args args) {
    extern __shared__ __attribute__((aligned(16))) unsigned char lds_raw[];
    Frame F;
    F.lds = (LAS unsigned char*)lds_raw; F.wave = __builtin_amdgcn_readfirstlane(threadIdx.x >> 6);
    F.G = gridDim.x; F.bid = blockIdx.x; F.ws = args.ws;
    volatile LAS unsigned* MISC = (volatile LAS unsigned*)(F.lds + MISC_OFF);
    { const int l0 = lane_id(); if (F.wave == 0) MISC[l0] = 0u; }
    __syncthreads();
    unsigned* ctl = (unsigned*)(F.ws + WS_CTL);
    const int lo = args.ph_lo, hi = args.ph_hi;
    XcdBarrier bar; bar.bar = ctl + CW_BAR + args.li * XCD_BAR_WORDS; bar.x = 0; bar.st = nullptr;
    if (hi - lo > 1) bar = xcd_barrier_post(ctl + CW_BAR + args.li * XCD_BAR_WORDS, MISC + 8, F.wave * 64 + lane_id());
#ifndef PROBE_REP
#define PROBE_REP -1
#endif
#define IN(k) (lo <= (k) && (k) < hi)
#define REP(k) for (int rep_ = 0; rep_ < ((k) == PROBE_REP ? 2 : 1); ++rep_)
#define SEAM(k) do { if (IN(k) && IN((k) + 1)) xcd_barrier(bar, F.wave * 64 + lane_id()); } while (0)
    LAS unsigned char* ring = F.lds; LAS unsigned char* tab = F.lds + TAB_OFF;
    if (IN(0)) REP(0) { p0_prologue(F, args); __syncthreads(); } SEAM(0);
    if (IN(1)) REP(1) { p1_norm(F, args); } SEAM(1);
    if (IN(2)) REP(2) {
        pg8::Gemm g{(const bf16*)(F.ws + WS_XN), (const bf16*)(F.ws + WS_WIN), D}; pg8::StaticOrder S; S.init(M, NPROJ, F.G, F.bid);
        pg8::EpiProj E{(bf16*)(F.ws + WS_PROJ), (const float2*)(F.ws + WS_ROPEM), (const float2*)(F.ws + WS_ROPER), (float*)(F.ws + WS_KMEAN)};
        pg8::gemm_phase<pg8::EpiProj, pg8::StaticOrder, false, true>(ring, tab, g, S, E, F.wave);
    } SEAM(2);
    if (IN(3)) REP(3) { p3_attention(F); } SEAM(3);
    if (IN(4)) REP(4) { ret::ret_scan(F.ws, F.bid * (NWAVES * 64) + F.wave * 64 + lane_id(), F.G * NWAVES * 64); } SEAM(4);
    if (IN(5)) REP(5) { for (int item = F.bid; item < 256; item += F.G) ret::ret_out(F.ws, F.lds, item, F.wave); } SEAM(5);
    if (IN(6)) REP(6) {
        pg8::Gemm g{(const bf16*)(F.ws + WS_MIX), (const bf16*)(F.ws + WS_WOUT), D}; pg8::StaticOrder S; S.init(M, D, F.G, F.bid);
        pg8::EpiOut E{(const float*)args.in[0], (const float*)(F.ws + WS_MOD), (float*)(F.ws + WS_X1)};
        pg8::gemm_phase<pg8::EpiOut, pg8::StaticOrder, false, false>(ring, tab, g, S, E, F.wave);
    } SEAM(6);
    if (IN(7)) { p7_route(F, args); } SEAM(7);
    if (IN(8)) REP(8) {
        const int total = moe_tables(F, ctl + CW_CNT);
        pg8::MoeOrder S; S.nM = total; S.nN = 4; S.nwg = total * 4; S.G = F.G; S.c = F.bid;
        S.tile_e = (const LAS int*)(F.lds + TILE_E_OFF); S.tile_start = (const LAS int*)(F.lds + TILE_S_OFF); S.ecount = (const LAS int*)(F.lds + ECNT_OFF); S.ltok = (const int*)(F.ws + WS_LTOK);
        pg8::Gemm g{(const bf16*)(F.ws + WS_XN), (const bf16*)(F.ws + WS_WGU), D};
        pg8::EpiAct E{(bf16*)(F.ws + WS_ACT)};
        pg8::gemm_phase<pg8::EpiAct, pg8::MoeOrder, true, true>(ring, tab, g, S, E, F.wave);
    } SEAM(8);
    if (IN(9)) REP(9) {
        const int total = moe_tables(F, ctl + CW_CNT);
        pg8::MoeOrder S; S.nM = total; S.nN = 8; S.nwg = total * 8; S.G = F.G; S.c = F.bid;
        S.tile_e = (const LAS int*)(F.lds + TILE_E_OFF); S.tile_start = (const LAS int*)(F.lds + TILE_S_OFF); S.ecount = (const LAS int*)(F.lds + ECNT_OFF); S.ltok = (const int*)(F.ws + WS_LTOK);
        pg8::Gemm g{(const bf16*)(F.ws + WS_ACT), (const bf16*)(F.ws + WS_WD), EH};
        pg8::EpiDown E{(bf16*)(F.ws + WS_YSLOT), (const int*)(F.ws + WS_LTOK), (const float*)(F.ws + WS_LW)};
        pg8::gemm_phase<pg8::EpiDown, pg8::MoeOrder, false, true>(ring, tab, g, S, E, F.wave);
    } SEAM(9);
    if (IN(10)) REP(10) { p10_final(F, args); }
#undef IN
#undef SEAM
}

#ifndef MK_MASK
#define MK_MASK 0x7FF
#endif
extern "C" void kernel_launch(void* const* d_in, const int* in_sizes, int n_in, void* d_out, int out_size, void* d_ws, size_t ws_size, hipStream_t stream) {
    static int grid = 0;
    if (grid == 0) {
        if (n_in != 18 || ws_size < WS_END) { fprintf(stderr, "kernel_launch: bad args n_in %d ws %zu\n", n_in, ws_size); grid = -1; return; }
        int dev = 0, cus = 0, per_cu = 0;
        if (hipGetDevice(&dev) != hipSuccess || hipDeviceGetAttribute(&cus, hipDeviceAttributeMultiprocessorCount, dev) != hipSuccess) { grid = -1; return; }
        if (hipFuncSetAttribute((const void*)mk_fwd, hipFuncAttributeMaxDynamicSharedMemorySize, LDS_BYTES) != hipSuccess) { fprintf(stderr, "kernel_launch: hipFuncSetAttribute failed\n"); grid = -1; return; }
        if (hipOccupancyMaxActiveBlocksPerMultiprocessor(&per_cu, (const void*)mk_fwd, NWAVES * 64, LDS_BYTES) != hipSuccess || per_cu < 1) { fprintf(stderr, "kernel_launch: occupancy query says %d\n", per_cu); per_cu = 1; }
        (void)hipGetLastError();
        grid = cus;
    }
    if (grid < 0) return;
    const float* x = (const float*)d_in[0]; const float* c = (const float*)d_in[1]; const int* pos = (const int*)d_in[2];
    const float* w_ada = (const float*)d_in[3]; const float* b_ada = (const float*)d_in[4];
    const float* norm_mix = (const float*)d_in[5]; const float* norm_ffn = (const float*)d_in[6]; const float* norm_out = (const float*)d_in[7];
    const float* w_in = (const float*)d_in[8]; const float* w_out = (const float*)d_in[9]; const float* w_router = (const float*)d_in[10]; const float* rbias = (const float*)d_in[11];
    const float* w_gate = (const float*)d_in[12]; const float* w_up = (const float*)d_in[13]; const float* w_down = (const float*)d_in[14];
    const float* ws_gate = (const float*)d_in[15]; const float* ws_up = (const float*)d_in[16]; const float* ws_down = (const float*)d_in[17];
    unsigned char* ws = (unsigned char*)d_ws;
    unsigned* ctl = (unsigned*)(ws + WS_CTL); float* mod = (float*)(ws + WS_MOD); float* kmean = (float*)(ws + WS_KMEAN); float* rstd = (float*)(ws + WS_RSTD);
    int* ltok = (int*)(ws + WS_LTOK); float* lw = (float*)(ws + WS_LW); float2* ropem = (float2*)(ws + WS_ROPEM); float2* roper = (float2*)(ws + WS_ROPER);
    float* logits = (float*)(ws + WS_LOGITS); float* x1 = (float*)(ws + WS_X1); bf16* xn = (bf16*)(ws + WS_XN); bf16* act = (bf16*)(ws + WS_ACT);
    bf16* proj = (bf16*)(ws + WS_PROJ); bf16* mix = (bf16*)(ws + WS_MIX); bf16* yslot = (bf16*)(ws + WS_YSLOT); float* projf = (float*)(ws + WS_PROJF);
    const size_t PS = (size_t)M * 1024;
    (void)hipMemsetAsync(ws + WS_CTL, 0, CTL_ZERO_BYTES, stream);
    Args a{};
    for (int i = 0; i < 18; ++i) a.in[i] = d_in[i];
    a.out = (float*)d_out; a.ws = ws;
    const unsigned mask = MK_MASK; int li = 0;
    const int max_rt = (M * 9 + 65 * 256) / 64;
    for (int p = 0; p <= 10;) {
        if ((mask >> p) & 1u) {
            int q = p; while (q <= 10 && ((mask >> q) & 1u)) ++q;
            a.ph_lo = p; a.ph_hi = q; a.li = li++;
            hipLaunchKernelGGL(mk_fwd, dim3(grid), dim3(NWAVES * 64), LDS_BYTES, stream, a);
            p = q; continue;
        }
        switch (p) {
        case 0: nv::k_rope<<<(M * 128 + 255) / 256, 256, 0, stream>>>(pos, ropem, roper); break;
        case 1: nv::k_mod<<<6 * D / 256, 256, 0, stream>>>(c, w_ada, b_ada, mod); nv::k_norm_mod<<<M / 8, 512, 0, stream>>>(x, norm_mix, mod, 0, D, xn, nullptr); break;
        case 2: nv::k_proj<<<(M / 64) * (NPROJ / 128), 512, 0, stream>>>(xn, w_in, projf);
                nv::k_rot<<<(unsigned)(((size_t)M * NPROJ + 255) / 256), 256, 0, stream>>>(projf, ropem, roper, proj);
                nv::k_kmean<<<NB * 16 * 1024 / 256, 256, 0, stream>>>(proj + PS, kmean); break;
        case 3: nv::k_moba<<<M, 512, 0, stream>>>(proj, proj + PS, proj + 2 * PS, kmean, mix); break;
        case 5: nv::k_ret<<<M / 2, 512, 0, stream>>>(proj + 3 * PS, proj + 4 * PS, proj + 5 * PS, proj + 6 * PS, mix); break;
        case 6: nv::k_outproj<<<(M / 64) * (D / 128), 512, 0, stream>>>(mix, w_out, x, mod, x1); break;
        case 7: nv::k_norm_mod<<<M / 8, 512, 0, stream>>>(x1, norm_ffn, mod, 3 * D, 4 * D, xn, rstd);
                nv::k_logits<<<M / 64, 512, 0, stream>>>(x1, rstd, norm_ffn, mod, w_router, logits);
                nv::k_route<<<M / 8, 512, 0, stream>>>(logits, rbias, ctl + CW_CNT, ltok, lw); break;
        case 8: nv::k_gateup<<<max_rt * 8, 512, 0, stream>>>(xn, ctl + CW_CNT, ltok, w_gate, w_up, ws_gate, ws_up, act); break;
        case 9: nv::k_down<<<max_rt * 16, 512, 0, stream>>>(act, ctl + CW_CNT, ltok, lw, w_down, ws_down, yslot); break;
        case 10: nv::k_final<<<M / 8, 512, 0, stream>>>(x1, yslot, mod, norm_out, (float*)d_out); break;
        default: break;
        }
        ++p;
    }
}
```

```cpp
#include <hip/hip_runtime.h>
#include <cstdio>
#include <cstdint>

constexpr int NB = 2, T = 4096, D = 2048, M = NB * T;
constexpr int NPROJ = 7168;
constexpr int NE = 64, EH = 512;
constexpr float NORM_EPS = 1e-6f;
constexpr float NEGF = -1e30f;

constexpr size_t MiB = 1u << 20;
constexpr size_t WS_CTL = 0, CTL_ZERO_BYTES = 1 * MiB;
constexpr size_t WS_KMEAN = 512 * 1024;
constexpr size_t WS_MODP = 1 * MiB;
constexpr size_t WS_MOD = 3 * MiB;
constexpr size_t WS_RSTD = 5 * MiB;
constexpr size_t WS_IDENT = 23 * MiB;
constexpr size_t WS_CVEC = 5 * MiB + 65536;
constexpr size_t WS_LTOK = 6 * MiB;
constexpr size_t WS_LW = 9 * MiB;
constexpr size_t WS_ROPEM = 12 * MiB;
constexpr size_t WS_ROPER = 13 * MiB;
constexpr size_t WS_LOGITS = 21 * MiB;
constexpr size_t WS_WGU = 24 * MiB;
constexpr size_t WS_WD = 284 * MiB;
constexpr size_t WS_X1 = 414 * MiB;
constexpr size_t WS_XN8 = 414 * MiB;
constexpr size_t WS_WIN8 = 430 * MiB;
constexpr size_t WS_XN = 478 * MiB;
constexpr size_t WS_ACT = 510 * MiB;
constexpr size_t WS_WIN = 600 * MiB;
constexpr size_t WS_WOUT = 628 * MiB;
constexpr size_t WS_PROJ = 636 * MiB;
constexpr size_t WS_MIX = 748 * MiB;
constexpr size_t WS_U = 780 * MiB;
constexpr size_t WS_S = 844 * MiB;
constexpr size_t WS_MIXO = 780 * MiB;
constexpr size_t WS_YSLOT = 600 * MiB;
constexpr size_t WS_INV = 21 * MiB;
constexpr size_t WS_WTS = 22 * MiB;
constexpr size_t WS_PROJF = 780 * MiB;
constexpr size_t WS_END = 1024 * MiB;
constexpr int CW_CNT = 32768;
constexpr int CW_BAR = 4096;

typedef unsigned short bf16;
__device__ __forceinline__ float bf2f(bf16 v) { return __uint_as_float(((unsigned)v) << 16); }
__device__ __forceinline__ bf16 f2bf(float f) { unsigned u = __float_as_uint(f); return (bf16)((u + 0x7fffu + ((u >> 16) & 1u)) >> 16); }
__device__ __forceinline__ float wave_sum(float v) {
#pragma unroll
    for (int o = 1; o < 64; o <<= 1) v += __shfl_xor(v, o);
    return v;
}
__device__ __forceinline__ float wave_max(float v) {
#pragma unroll
    for (int o = 1; o < 64; o <<= 1) v = fmaxf(v, __shfl_xor(v, o));
    return v;
}
__device__ __forceinline__ int lane_id() { int r; asm volatile("v_mbcnt_lo_u32_b32 %0, -1, 0\n\tv_mbcnt_hi_u32_b32 %0, -1, %0" : "=v"(r)); return r; }
__device__ __forceinline__ float silu_f(float x) { return x / (1.f + __expf(-x)); }

#define LAS __attribute__((address_space(3)))
#define GAS __attribute__((address_space(1)))
namespace pg8 {
typedef unsigned short bf16_t;
typedef short bf16x8 __attribute__((ext_vector_type(8)));
typedef float f32x4 __attribute__((ext_vector_type(4)));
typedef unsigned u32x4 __attribute__((ext_vector_type(4)));
typedef int i32x4 __attribute__((ext_vector_type(4)));
typedef int i32x8 __attribute__((ext_vector_type(8)));
constexpr int BM = 256, BK = 64, HALF = 128, HTB = HALF * BK * 2, STAGE_BYTES = 8 * HTB, NXCD = 8, WGM = 8;

__host__ __device__ __forceinline__ int lds_byte(int r, int c) { const int st = (r >> 4) * 2 + (c >> 5), rr = r & 15, cc = c & 31, ob = rr * 64 + cc * 2; return st * 1024 + (ob ^ (((ob >> 9) & 1) << 5)); }
__host__ __device__ __forceinline__ void stage_rc(int b, int& R, int& C) { const int st = b / 1024, sb = b % 1024, swz = sb ^ (((sb >> 9) & 1) << 5); R = (st >> 1) * 16 + swz / 64; C = (st & 1) * 32 + (swz % 64) / 2; }
__host__ __device__ __forceinline__ int perm32(int rho) { const int n = rho >> 4, i = rho & 15; return 8 * (i >> 2) + 4 * n + (i & 3); }

struct Unit { int pm, pn, pb, e, r0, cnt; };
struct Gemm { const bf16_t* A; const bf16_t* Bt; int K; };

__device__ __forceinline__ void tile_of(int L, int nM, int nN, int& pm, int& pn) {
    const int nwg = nM * nN; int wgid = L;
    { const int q = nwg / NXCD, r = nwg % NXCD, xcd = wgid % NXCD, off = wgid / NXCD; wgid = (xcd < r ? xcd * (q + 1) : r * (q + 1) + (xcd - r) * q) + off; }
    const int nig = WGM * nN, gid = wgid / nig, fm = gid * WGM, gsz = (nM - fm) < WGM ? (nM - fm) : WGM;
    pm = fm + ((wgid % nig) % gsz); pn = (wgid % nig) / gsz;
}
struct StaticOrder {
    int nM, nN, nwg, G, c, pbase = 0, pc0 = 1 << 30, pskip = 0;
    __device__ __forceinline__ void init(int Mrows, int N, int G_, int c_) { nM = Mrows / BM; nN = N / BM; nwg = nM * nN; G = G_; c = c_; }
    __device__ __forceinline__ bool next(int i, Unit& u) const {
        const int L = i * G + c; if (L >= nwg) return false;
        tile_of(L, nM, nN, u.pm, u.pn); u.pn = pbase + u.pn + (u.pn >= pc0 ? pskip : 0); u.pb = u.pn; u.e = 0; u.r0 = 0; u.cnt = 256; return true;
    }
    __device__ __forceinline__ void rows(const Unit& u, const int*& lp, int& cnt) const { lp = ident + u.pm * 256; cnt = 256; }
    __device__ __forceinline__ bool direct() const { return true; }
    const int* ident;
};
struct MoeOrder {
    int nM, nN, nwg, G, c; const LAS int* tile_e; const LAS int* tile_start; const LAS int* ecount; const int* ltok; const int* ident;
    __device__ __forceinline__ bool next(int i, Unit& u) const {
        const int L = i * G + c; if (L >= nwg) return false;
        tile_of(L, nM, nN, u.pm, u.pn);
        const int e = __builtin_amdgcn_readfirstlane(tile_e[u.pm]), jl = u.pm - __builtin_amdgcn_readfirstlane(tile_start[e]), rem = __builtin_amdgcn_readfirstlane(ecount[e]) - jl * 256;
        u.e = e; u.r0 = jl * 256; u.cnt = rem < 256 ? rem : 256; u.pb = e * nN + u.pn; return true;
    }
    __device__ __forceinline__ void rows(const Unit& u, const int*& lp, int& cnt) const { if (ident) { lp = ident + u.pm * 256; cnt = 256; } else { lp = ltok + (size_t)u.e * 8192 + u.r0; cnt = u.cnt; } }
    __device__ __forceinline__ bool direct() const { return ident != nullptr; }
};

__device__ __forceinline__ unsigned cvt_pk_bf16(float lo, float hi) { unsigned r; asm volatile("v_cvt_pk_bf16_f32 %0, %1, %2" : "=v"(r) : "v"(lo), "v"(hi)); return r; }

template <class Epi, class Sched, bool GATHER, bool ALIGN_EPI, bool F8 = false>
__device__ __forceinline__ void gemm_phase(LAS unsigned char* lds, LAS unsigned char* tab, const Gemm g, const Sched& S, const Epi& E, const int wid) {
    const int lane = lane_id(), tid = wid * 64 + lane, wr = wid >> 2, wc = wid & 3, fr = lane & 15, fq = lane >> 4;
    const int K = F8 ? g.K / 2 : g.K, nt = K / BK;
    unsigned voffA[2][2], voffB[2];
#pragma unroll
    for (int i = 0; i < 2; ++i) { int R, C; stage_rc(tid * 16 + i * 8192, R, C);
        const int Rb = Epi::NMAP ? (64 * (R >> 5) + perm32(R & 31)) : (Epi::PERM ? ((R & ~31) + perm32(R & 31)) : R);
        voffA[0][i] = (unsigned)(R * K + C) * 2u; voffA[1][i] = (unsigned)((R + HALF) * K + C) * 2u; voffB[i] = (unsigned)(Rb * K + C) * 2u; }
    const size_t kstep = (size_t)(BK * 2);
    const size_t hstep = (size_t)HALF * K * 2;
    const size_t tstep = 2 * hstep;
    const size_t hstepB = Epi::NMAP ? (size_t)32 * K * 2 : hstep;
    const unsigned ldsw = (unsigned)wid * 1024u;
    const int aoff = F8 ? lds_byte(wr * 64 + fr, fq * 16) : lds_byte(wr * 64 + fr, fq * 8), boff = F8 ? lds_byte(wc * 32 + fr, fq * 16) : lds_byte(wc * 32 + fr, fq * 8);
#define PG8_SA(b, h) (((b) * 2 + (h)) * HTB)
#define PG8_SB(b, h) ((4 + (b) * 2 + (h)) * HTB)
#define PG8_STAGE(bufoff, gbase, voff) do { _Pragma("unroll") for (int _i = 0; _i < 2; ++_i) \
        __builtin_amdgcn_global_load_lds((const unsigned*)((const char*)(gbase) + (voff)[_i]), (LAS unsigned*)(lds + (bufoff) + ldsw + _i * 8192), 16, 0, 0); } while (0)
#define PG8_LD16(off) (*(const LAS i32x4*)(lds + (off)))
#define PG8_FRAG(off) __builtin_shufflevector(PG8_LD16(off), PG8_LD16((off) + (F8 ? 16 : 1024)), 0, 1, 2, 3, 4, 5, 6, 7)
#define PG8_LDA(dst, b, h) do { _Pragma("unroll") for (int m = 0; m < 4; ++m) dst[m] = PG8_FRAG(PG8_SA(b, h) + aoff + m * 2048); } while (0)
#define PG8_LDB(dst, b, h) do { _Pragma("unroll") for (int n = 0; n < 2; ++n) dst[n] = PG8_FRAG(PG8_SB(b, h) + boff + n * 2048); } while (0)
#define PG8_LO(f) __builtin_bit_cast(bf16x8, __builtin_shufflevector(f, f, 0, 1, 2, 3))
#define PG8_HI(f) __builtin_bit_cast(bf16x8, __builtin_shufflevector(f, f, 4, 5, 6, 7))
#define PG8_MMA(ai, bj, At, Bt) do { __builtin_amdgcn_s_setprio(1); \
        if constexpr (F8) { _Pragma("unroll") for (int m = 0; m < 4; ++m) _Pragma("unroll") for (int n = 0; n < 2; ++n) \
            acc[ai][bj][m][n] = __builtin_amdgcn_mfma_scale_f32_16x16x128_f8f6f4(Bt[n], At[m], acc[ai][bj][m][n], 0, 0, 0, 0x7f7f7f7f, 0, 0x7f7f7f7f); } \
        else { _Pragma("unroll") for (int m = 0; m < 4; ++m) _Pragma("unroll") for (int n = 0; n < 2; ++n) { \
            acc[ai][bj][m][n] = __builtin_amdgcn_mfma_f32_16x16x32_bf16(PG8_LO(Bt[n]), PG8_LO(At[m]), acc[ai][bj][m][n], 0, 0, 0); \
            acc[ai][bj][m][n] = __builtin_amdgcn_mfma_f32_16x16x32_bf16(PG8_HI(Bt[n]), PG8_HI(At[m]), acc[ai][bj][m][n], 0, 0, 0); } } \
        __builtin_amdgcn_s_setprio(0); } while (0)
#define PG8_WAIT_V(n) asm volatile("s_waitcnt vmcnt(" #n ")" ::: "memory")
#define PG8_WAIT_L(n) asm volatile("s_waitcnt lgkmcnt(" #n ")" ::: "memory")
#define PG8_BAR __builtin_amdgcn_s_barrier()
#define PG8_SCHED __builtin_amdgcn_sched_barrier(0)
    Unit cur, nxt; int ui = 0;
    if (!S.next(0, cur)) return;
    if constexpr (GATHER) {
        const int* lp; int cnt; S.rows(cur, lp, cnt);
#pragma unroll
        for (int h = 0; h < 2; ++h)
#pragma unroll
            for (int i = 0; i < 2; ++i) { int R, C; stage_rc(tid * 16 + i * 8192, R, C); const int r = h * HALF + R; const int tk = S.direct() ? cur.pm * 256 + r : (r < cnt ? (lp[r] >> 4) : 0); voffA[h][i] = (unsigned)(tk * K + C) * 2u; }
    }
    f32x4 acc[2][2][4][2];
#pragma unroll
    for (int a = 0; a < 2; ++a)
#pragma unroll
        for (int b = 0; b < 2; ++b)
#pragma unroll
            for (int m = 0; m < 4; ++m)
#pragma unroll
                for (int n = 0; n < 2; ++n) acc[a][b][m][n] = (f32x4){0.f, 0.f, 0.f, 0.f};
    i32x8 At[4], B0[2], B1[2];
    const char* cA = GATHER ? (const char*)g.A : (const char*)g.A + (size_t)cur.pm * tstep; const char* cB = (const char*)g.Bt + (size_t)cur.pb * tstep;
    PG8_STAGE(PG8_SB(0, 0), cB, voffB); PG8_STAGE(PG8_SB(0, 1), cB + hstepB, voffB); PG8_STAGE(PG8_SA(0, 0), cA, voffA[0]); PG8_STAGE(PG8_SA(0, 1), cA, voffA[1]);
    if (wr == 1) PG8_BAR;
    PG8_WAIT_V(2); PG8_BAR;
    PG8_STAGE(PG8_SB(1, 0), cB + kstep, voffB); PG8_STAGE(PG8_SA(1, 0), cA + kstep, voffA[0]); PG8_STAGE(PG8_SB(1, 1), cB + hstepB + kstep, voffB);
    PG8_WAIT_V(6); PG8_BAR;
    for (;;) {
        const bool has_next = S.next(ui + 1, nxt);
        int ncnt = 256;
        if constexpr (GATHER) { if (has_next) { const int* nlp; S.rows(nxt, nlp, ncnt);
            if (wid == 0 && !S.direct()) __builtin_amdgcn_global_load_lds((const unsigned*)(nlp + lane * 4), (LAS unsigned*)tab, 16, 0, 0); } }
        const char* nA = has_next ? (GATHER ? (const char*)g.A : (const char*)g.A + (size_t)nxt.pm * tstep) : cA; const char* nB = has_next ? (const char*)g.Bt + (size_t)nxt.pb * tstep : cB;
#pragma unroll 1
        for (int t = 0; t < nt; t += 2) {
            const bool last = (t == nt - 2);
            const char* a1 = cA + (size_t)(t + 1) * kstep;
            const char* a2 = last ? nA : cA + (size_t)(t + 2) * kstep; const char* b2 = last ? nB : cB + (size_t)(t + 2) * kstep;
            const char* a3 = a2 + kstep; const char* b3 = b2 + kstep;
            PG8_LDB(B0, 0, 0); PG8_LDB(B1, 0, 1); PG8_SCHED; PG8_LDA(At, 0, 0); PG8_STAGE(PG8_SA(1, 1), a1, voffA[1]);
            if constexpr (GATHER) { if (last && has_next) {
#pragma unroll
                for (int h = 0; h < 2; ++h)
#pragma unroll
                    for (int i = 0; i < 2; ++i) { int R, C; stage_rc(tid * 16 + i * 8192, R, C); const int r = h * HALF + R; int tk; if (S.direct()) tk = nxt.pm * 256 + r; else { const int v = ((const LAS int*)tab)[r]; tk = r < ncnt ? (v >> 4) : 0; } voffA[h][i] = (unsigned)(tk * K + C) * 2u; } } }
            PG8_WAIT_V(8); PG8_WAIT_L(0); PG8_BAR; PG8_MMA(0, 0, At, B0); PG8_MMA(0, 1, At, B1); PG8_BAR; PG8_SCHED;
            PG8_LDA(At, 0, 1); PG8_STAGE(PG8_SB(0, 0), b2, voffB); PG8_STAGE(PG8_SB(0, 1), b2 + hstepB, voffB); PG8_STAGE(PG8_SA(0, 0), a2, voffA[0]);
            PG8_WAIT_V(8); PG8_WAIT_L(0); PG8_BAR; PG8_MMA(1, 0, At, B0); PG8_MMA(1, 1, At, B1); PG8_BAR; PG8_SCHED;
            PG8_LDB(B0, 1, 0); PG8_LDB(B1, 1, 1); PG8_SCHED; PG8_LDA(At, 1, 0); PG8_STAGE(PG8_SA(0, 1), a2, voffA[1]);
            PG8_WAIT_V(8); PG8_WAIT_L(0); PG8_BAR; PG8_MMA(0, 0, At, B0); PG8_MMA(0, 1, At, B1); PG8_BAR; PG8_SCHED;
            PG8_LDA(At, 1, 1); PG8_STAGE(PG8_SB(1, 0), b3, voffB); PG8_STAGE(PG8_SB(1, 1), b3 + hstepB, voffB); PG8_STAGE(PG8_SA(1, 0), a3, voffA[0]);
            PG8_WAIT_V(8); PG8_WAIT_L(0); PG8_BAR; PG8_MMA(1, 0, At, B0); PG8_MMA(1, 1, At, B1); PG8_BAR; PG8_SCHED;
        }
        if constexpr (ALIGN_EPI) { if (wr == 0) PG8_BAR; }
        E(acc, cur, wr, wc, fr, fq);
        if (!has_next) break;
#pragma unroll
        for (int a = 0; a < 2; ++a)
#pragma unroll
            for (int b = 0; b < 2; ++b)
#pragma unroll
                for (int m = 0; m < 4; ++m)
#pragma unroll
                    for (int n = 0; n < 2; ++n) acc[a][b][m][n] = (f32x4){0.f, 0.f, 0.f, 0.f};
        cur = nxt; cA = nA; cB = nB; ++ui;
        if constexpr (ALIGN_EPI) { if (wr == 1) PG8_BAR; }
    }
    PG8_WAIT_V(0);
    if constexpr (!ALIGN_EPI) { if (wr == 0) PG8_BAR; }
    PG8_BAR;
#undef PG8_SA
#undef PG8_SB
#undef PG8_STAGE
#undef PG8_LDA
#undef PG8_HI
#undef PG8_LO
#undef PG8_FRAG
#undef PG8_LD16
#undef PG8_LDB
#undef PG8_MMA
#undef PG8_WAIT_V
#undef PG8_WAIT_L
#undef PG8_BAR
#undef PG8_SCHED
}
}
namespace pg8 {
struct EpiProj {
    static constexpr bool PERM = true; static constexpr int NMAP = 0;
    bf16_t* O; const int* pos; float* kmean; float asc;
    __device__ __forceinline__ void operator()(const f32x4 (&acc)[2][2][4][2], const Unit& u, int wr, int wc, int fr, int fq) const {
        const int t = u.pn >> 2, coltile = (u.pn & 3) * BM;
        bf16_t* base = O + (size_t)t * M * 1024;
        const int row0 = u.pm * BM + wr * 64 + fr, col0 = coltile + wc * 32 + 8 * fq;
        const bool moba_rot = (t < 2) && (wc == 0);
        const bool ret_rot = (t == 3) || (t == 4);
        const float osc = (t == 4) ? 0.0625f : 1.f;
        const int fqo = lane_id() >> 4; int wco = wc; asm volatile("" : "+s"(wco));
        float posf[8], invr[8];
        if (moba_rot || ret_rot) {
#pragma unroll
            for (int q = 0; q < 8; ++q) posf[q] = (float)pos[row0 + (q >> 2) * HALF + (q & 3) * 16];
#pragma unroll
            for (int j = 0; j < 8; ++j) invr[j] = moba_rot ? __builtin_amdgcn_exp2f(-(float)(8 * (fqo & 1) + j) * (18.931568569324174f / 16.f)) * 0.15915494309189535f
                                                           : __builtin_amdgcn_exp2f(-(float)(wco * 32 + 8 * fqo + j) * (13.287712379549449f / 127.f)) * 0.15915494309189535f;
        }
        float ks[2][8];
#pragma unroll
        for (int bj = 0; bj < 2; ++bj)
#pragma unroll
            for (int j = 0; j < 8; ++j) ks[bj][j] = 0.f;
#pragma unroll
        for (int ai = 0; ai < 2; ++ai)
#pragma unroll
            for (int m = 0; m < 4; ++m) {
                const int row = row0 + ai * HALF + m * 16;
                float v[2][8];
#pragma unroll
                for (int bj = 0; bj < 2; ++bj)
#pragma unroll
                    for (int j = 0; j < 8; ++j) v[bj][j] = acc[ai][bj][m][j >> 2][j & 3] * asc;
                if (moba_rot || ret_rot) {
                    const float pr = posf[ai * 4 + m];
                    float cs_c[8], cs_s[8];
#pragma unroll
                    for (int j = 0; j < 8; ++j) { const float rev = pr * invr[j]; const float fr_ = rev - __builtin_floorf(rev); cs_c[j] = __builtin_amdgcn_cosf(fr_); cs_s[j] = __builtin_amdgcn_sinf(fr_); }
                    if (moba_rot) {
#pragma unroll
                        for (int bj = 0; bj < 2; ++bj)
#pragma unroll
                            for (int j = 0; j < 8; ++j) { const float xp = __shfl_xor(v[bj][j], 32);
                                v[bj][j] = (fq < 2) ? v[bj][j] * cs_c[j] - xp * cs_s[j] : v[bj][j] * cs_c[j] + xp * cs_s[j]; }
                    } else {
#pragma unroll
                        for (int j = 0; j < 8; ++j) { const float x1 = v[0][j], x2 = v[1][j];
                            v[0][j] = (x1 * cs_c[j] - x2 * cs_s[j]) * osc; v[1][j] = (x2 * cs_c[j] + x1 * cs_s[j]) * osc; }
                    }
                }
#pragma unroll
                for (int bj = 0; bj < 2; ++bj) {
                    u32x4 w; w.x = cvt_pk_bf16(v[bj][0], v[bj][1]); w.y = cvt_pk_bf16(v[bj][2], v[bj][3]); w.z = cvt_pk_bf16(v[bj][4], v[bj][5]); w.w = cvt_pk_bf16(v[bj][6], v[bj][7]);
                    *(u32x4*)(base + (size_t)row * 1024 + col0 + bj * HALF) = w;
#pragma unroll
                    for (int j = 0; j < 8; ++j) ks[bj][j] += v[bj][j];
                }
            }
        if (t == 1) {
#pragma unroll
            for (int bj = 0; bj < 2; ++bj)
#pragma unroll
                for (int j = 0; j < 8; ++j) { float s = ks[bj][j]; s += __shfl_xor(s, 1); s += __shfl_xor(s, 2); s += __shfl_xor(s, 4); s += __shfl_xor(s, 8);
                    if (fr == 0) atomicAdd(kmean + (size_t)u.pm * 1024 + col0 + bj * HALF + j, s * (1.f / 256.f)); }
        }
    }
};
struct EpiOut {
    static constexpr bool PERM = true; static constexpr int NMAP = 1;
    bf16_t* mixo;
    __device__ __forceinline__ void operator()(const f32x4 (&acc)[2][2][4][2], const Unit& u, int wr, int wc, int fr, int fq) const {
        const int row0 = u.pm * BM + wr * 64 + fr, col0 = u.pn * BM + wc * 64 + 8 * fq;
#pragma unroll
        for (int ai = 0; ai < 2; ++ai)
#pragma unroll
            for (int m = 0; m < 4; ++m) { bf16_t* orow = mixo + (size_t)(row0 + ai * HALF + m * 16) * D + col0;
#pragma unroll
                for (int bj = 0; bj < 2; ++bj) { const f32x4 v0 = acc[ai][bj][m][0] * (1.f / 2048.f), v1 = acc[ai][bj][m][1] * (1.f / 2048.f);
                    u32x4 o; o.x = cvt_pk_bf16(v0[0], v0[1]); o.y = cvt_pk_bf16(v0[2], v0[3]); o.z = cvt_pk_bf16(v1[0], v1[1]); o.w = cvt_pk_bf16(v1[2], v1[3]);
                    *(u32x4*)(orow + bj * 32) = o; } }
    }
};
struct EpiAct {
    static constexpr bool PERM = true; static constexpr int NMAP = 0;
    unsigned char* act;
    __device__ __forceinline__ void operator()(const f32x4 (&acc)[2][2][4][2], const Unit& u, int wr, int wc, int fr, int fq) const {
        const int row0 = u.pm * BM + wr * 64 + fr, col0 = u.pn * HALF + wc * 32 + 8 * fq;
#pragma unroll
        for (int ai = 0; ai < 2; ++ai)
#pragma unroll
            for (int m = 0; m < 4; ++m) { float o[8];
#pragma unroll
                for (int j = 0; j < 8; ++j) { const float gt = acc[ai][0][m][j >> 2][j & 3] * (1.f / 2048.f), up = acc[ai][1][m][j >> 2][j & 3] * (1.f / 2048.f);
                    o[j] = __builtin_fminf(__builtin_fmaxf(gt / (1.f + __expf(-gt)) * up * 32.f, -448.f), 448.f); }
                int w0 = __builtin_amdgcn_cvt_pk_fp8_f32(o[0], o[1], 0, false); w0 = __builtin_amdgcn_cvt_pk_fp8_f32(o[2], o[3], w0, true);
                int w1 = __builtin_amdgcn_cvt_pk_fp8_f32(o[4], o[5], 0, false); w1 = __builtin_amdgcn_cvt_pk_fp8_f32(o[6], o[7], w1, true);
                typedef int i32x2 __attribute__((ext_vector_type(2)));
                *(i32x2*)(act + (size_t)(row0 + ai * HALF + m * 16) * EH + col0) = (i32x2){w0, w1}; }
    }
};
struct EpiDown {
    static constexpr bool PERM = true; static constexpr int NMAP = 1;
    unsigned char* yr;
    __device__ __forceinline__ void operator()(const f32x4 (&acc)[2][2][4][2], const Unit& u, int wr, int wc, int fr, int fq) const {
        const int row0 = u.pm * BM + wr * 64 + fr, col0 = u.pn * BM + wc * 64 + 8 * fq;
#pragma unroll
        for (int ai = 0; ai < 2; ++ai)
#pragma unroll
            for (int m = 0; m < 4; ++m) { unsigned char* orow = yr + (size_t)(row0 + ai * HALF + m * 16) * D + col0;
                if (ai * HALF + wr * 64 + m * 16 + fr < u.cnt) {
#pragma unroll
                for (int bj = 0; bj < 2; ++bj) { f32x4 v0 = acc[ai][bj][m][0] * (1.f / 32.f), v1 = acc[ai][bj][m][1] * (1.f / 32.f);
#pragma unroll
                    for (int i = 0; i < 4; ++i) { v0[i] = __builtin_fminf(__builtin_fmaxf(v0[i], -448.f), 448.f); v1[i] = __builtin_fminf(__builtin_fmaxf(v1[i], -448.f), 448.f); }
                    int w0 = __builtin_amdgcn_cvt_pk_fp8_f32(v0[0], v0[1], 0, false); w0 = __builtin_amdgcn_cvt_pk_fp8_f32(v0[2], v0[3], w0, true);
                    int w1 = __builtin_amdgcn_cvt_pk_fp8_f32(v1[0], v1[1], 0, false); w1 = __builtin_amdgcn_cvt_pk_fp8_f32(v1[2], v1[3], w1, true);
                    typedef int i32x2 __attribute__((ext_vector_type(2)));
                    __builtin_nontemporal_store((i32x2){w0, w1}, (i32x2*)(orow + bj * 32)); } } }
    }
};
}
namespace att {
typedef short bf16x8 __attribute__((ext_vector_type(8)));
typedef short s16x4 __attribute__((ext_vector_type(4)));
typedef float f32x16 __attribute__((ext_vector_type(16)));
typedef float f32x4 __attribute__((ext_vector_type(4)));
typedef unsigned u32x4 __attribute__((ext_vector_type(4)));
constexpr int DH = 128, QP = 1024, OP = 2048;
constexpr float SCALE = 0.08838834764831845f, THR = 8.f;
constexpr int NW = 8, QBLK = 32, KVBLK = 64, QB = NW * QBLK;
constexpr int SHM_V = KVBLK * DH * 2, SHM_K = KVBLK * DH * 2;
constexpr int LDS_BYTES = 2 * SHM_V + 2 * SHM_K + NW * 64 * 4;
#define KSWZ(row, colB) ((row) * 256 + ((colB) ^ (((row) & 7) << 4)))
#define SBAR() __builtin_amdgcn_sched_barrier(0)
__device__ __forceinline__ int v_st(int k, int c) { const int kk = (k & ~0xC) | ((k & 4) << 1) | ((k & 8) >> 1); return ((kk >> 3) * 4 + (c >> 5)) * 512 + ((kk & 7) * 32 + (c & 31)) * 2; }
__device__ __forceinline__ int v_rd_base(int lane) { return ((lane & 3) << 3) | (((lane >> 2) & 3) << 6) | (((lane >> 4) & 1) << 5) | (((lane >> 5) & 1) << 8); }
constexpr int v_rd_off(int d0, int ks, int half) { return d0 * 512 + ks * 4096 + half * 2048; }
__device__ __forceinline__ int crow(int r, int hi) { return (r & 3) + 8 * (r >> 2) + 4 * hi; }
__device__ __forceinline__ unsigned cvtpk(float lo, float hi) { unsigned r; asm volatile("v_cvt_pk_bf16_f32 %0, %1, %2" : "=v"(r) : "v"(lo), "v"(hi)); return r; }
__device__ __forceinline__ bf16x8 load8(const bf16* p) { return *reinterpret_cast<const bf16x8*>(p); }
__device__ __forceinline__ void mask_tile(f32x16& p0, f32x16& p1, int dq) {
    const float NEG = -__builtin_inff();
#pragma unroll
    for (int r = 0; r < 16; ++r) { const int c = (r & 3) + 8 * (r >> 2);
        if (dq - c < 0) p0[r] = NEG;
        if (dq - c - 32 < 0) p1[r] = NEG; }
}
__device__ __forceinline__ void partialSM(f32x16& p0, f32x16& p1, float& m_reg, float& mn, float& alpha, const bool dead = false) {
    float pmax = p0[0];
#pragma unroll
    for (int r = 1; r < 16; ++r) pmax = fmaxf(pmax, p0[r]);
#pragma unroll
    for (int r = 0; r < 16; ++r) pmax = fmaxf(pmax, p1[r]);
    { auto rr = __builtin_amdgcn_permlane32_swap(__float_as_uint(pmax), __float_as_uint(pmax), false, false);
      pmax = fmaxf(__uint_as_float(rr[0]), __uint_as_float(rr[1])); }
    if (dead) pmax = -__builtin_inff();
    constexpr float C2 = 1.4426950408889634f * SCALE;
    if (__builtin_expect(__all((pmax - m_reg) * SCALE <= THR), 1)) { mn = m_reg; alpha = 1.f; }
    else { mn = fmaxf(m_reg, pmax); alpha = __builtin_amdgcn_exp2f((m_reg - mn) * C2); m_reg = mn; }
    const float mnL = dead ? -__builtin_inff() : -mn * C2;
#pragma unroll
    for (int r = 0; r < 16; ++r) p0[r] = fmaf(p0[r], C2, mnL);
#pragma unroll
    for (int r = 0; r < 16; ++r) p1[r] = fmaf(p1[r], C2, mnL);
#pragma unroll
    for (int r = 0; r < 16; ++r) p0[r] = __builtin_amdgcn_exp2f(p0[r]);
}
__device__ __forceinline__ void finishSM(f32x16& p0, f32x16& p1, float alpha, float& l_reg, bf16x8& pa0, bf16x8& pa1, bf16x8& pa2, bf16x8& pa3) {
#pragma unroll
    for (int r = 0; r < 16; ++r) p1[r] = __builtin_amdgcn_exp2f(p1[r]);
    float ps = 0;
#pragma unroll
    for (int r = 0; r < 16; ++r) ps += p0[r];
#pragma unroll
    for (int r = 0; r < 16; ++r) ps += p1[r];
    { auto rr = __builtin_amdgcn_permlane32_swap(__float_as_uint(ps), __float_as_uint(ps), false, false);
      ps = __uint_as_float(rr[0]) + __uint_as_float(rr[1]); }
    l_reg = l_reg * alpha + ps;
#define PK4(P, B_, OUT) do { unsigned a0 = cvtpk(P[B_+0], P[B_+1]), a1 = cvtpk(P[B_+2], P[B_+3]);                          \
        unsigned b0 = cvtpk(P[B_+4], P[B_+5]), b1 = cvtpk(P[B_+6], P[B_+7]);                                             \
        auto r0 = __builtin_amdgcn_permlane32_swap(a0, b0, false, false); auto r1 = __builtin_amdgcn_permlane32_swap(a1, b1, false, false); \
        u32x4 w = {r0[0], r1[0], r0[1], r1[1]}; OUT = *reinterpret_cast<bf16x8*>(&w); } while (0)
    PK4(p0, 0, pa0); PK4(p0, 8, pa1); PK4(p1, 0, pa2); PK4(p1, 8, pa3);
#undef PK4
}
template <int KB>
__device__ __forceinline__ void qkt(f32x16& p0, f32x16& p1, const char* K_lds, int r32, int hi, const bf16x8* qr) {
    p0 = f32x16{}; p1 = f32x16{};
    const char* kb[4];
#pragma unroll
    for (int dd = 0; dd < 4; ++dd) kb[dd] = K_lds + KB * SHM_K + KSWZ(r32, (dd * 16 + hi * 8) * 2);
#pragma unroll
    for (int d0 = 0; d0 < 8; ++d0) { const char* a = kb[d0 & 3] + (d0 >> 2) * 128;
        bf16x8 b0 = *reinterpret_cast<const bf16x8*>(a);
        bf16x8 b1 = *reinterpret_cast<const bf16x8*>(a + 32 * 256);
        p0 = __builtin_amdgcn_mfma_f32_32x32x16_bf16(b0, qr[d0], p0, 0, 0, 0);
        p1 = __builtin_amdgcn_mfma_f32_32x32x16_bf16(b1, qr[d0], p1, 0, 0, 0); }
}
template <int VB>
__device__ __forceinline__ void pv_tile(f32x16* o, int vb0, bf16x8 pa0, bf16x8 pa1, bf16x8 pa2, bf16x8 pa3) {
#define TRRD(dst, off) asm volatile("ds_read_b64_tr_b16 %0, %1 offset:%2" : "=&v"(dst) : "v"(vb0), "i"(off) : "memory")
#define PV_D0(d0) do { s16x4 l0, l1, l2, l3, h0, h1, h2, h3; constexpr int b_ = VB * SHM_V + v_rd_off(d0, 0, 0); \
        TRRD(l0, b_); TRRD(h0, b_ + 2048); TRRD(l1, b_ + 4096); TRRD(h1, b_ + 6144); TRRD(l2, b_ + 8192); TRRD(h2, b_ + 10240); TRRD(l3, b_ + 12288); TRRD(h3, b_ + 14336); \
        asm volatile("s_waitcnt lgkmcnt(0)" ::: "memory"); SBAR(); \
        o[d0] = __builtin_amdgcn_mfma_f32_32x32x16_bf16(pa0, (bf16x8){l0[0], l0[1], l0[2], l0[3], h0[0], h0[1], h0[2], h0[3]}, o[d0], 0, 0, 0);   \
        o[d0] = __builtin_amdgcn_mfma_f32_32x32x16_bf16(pa1, (bf16x8){l1[0], l1[1], l1[2], l1[3], h1[0], h1[1], h1[2], h1[3]}, o[d0], 0, 0, 0);   \
        o[d0] = __builtin_amdgcn_mfma_f32_32x32x16_bf16(pa2, (bf16x8){l2[0], l2[1], l2[2], l2[3], h2[0], h2[1], h2[2], h2[3]}, o[d0], 0, 0, 0);   \
        o[d0] = __builtin_amdgcn_mfma_f32_32x32x16_bf16(pa3, (bf16x8){l3[0], l3[1], l3[2], l3[3], h3[0], h3[1], h3[2], h3[3]}, o[d0], 0, 0, 0); } while (0)
    PV_D0(0); PV_D0(1); PV_D0(2); PV_D0(3);
#undef PV_D0
#undef TRRD
}
struct BlockRef { const unsigned char* ws; int item; };
__device__ __forceinline__ int it_bh(int item) { return (item & 7) * 2 + ((item >> 3) & 1); }
__device__ __forceinline__ int it_qb(int item) { return 15 - (item >> 4); }
__device__ __forceinline__ const bf16* it_Q(const BlockRef& r) { const int bh = it_bh(r.item), b = bh >> 3, h = bh & 7; return (const bf16*)(r.ws + WS_PROJ) + (size_t)(b * T + it_qb(r.item) * 256) * 1024 + h * 128; }
__device__ __forceinline__ const bf16* it_K(const BlockRef& r) { const int bh = it_bh(r.item), b = bh >> 3, h = bh & 7; return (const bf16*)(r.ws + WS_PROJ) + (size_t)M * 1024 + (size_t)(b * T) * 1024 + h * 128; }
__device__ __forceinline__ const bf16* it_V(const BlockRef& r) { return it_K(r) + (size_t)M * 1024; }
__device__ __forceinline__ unsigned char* it_O(const BlockRef& r) { const int bh = it_bh(r.item), b = bh >> 3, h = bh & 7; return (unsigned char*)(r.ws + WS_MIX) + (size_t)(b * T + it_qb(r.item) * 256) * D + h * 128; }
__device__ __forceinline__ const float* it_KM(const BlockRef& r) { const int bh = it_bh(r.item), b = bh >> 3, h = bh & 7; return (const float*)(r.ws + WS_KMEAN) + (size_t)(b * 16) * 1024 + h * 128; }
struct Seam { bf16x8 qr[8]; bf16x8 st_v0, st_v1, st_k0, st_k1; };
#define ROW(p, k0, rr) ((p) + (size_t)((k0) + (rr)) * QP + sc)
#define VMW() asm volatile("s_waitcnt vmcnt(0)" ::: "memory")
#define VMWN(n) asm volatile("s_waitcnt vmcnt(%0)" :: "i"(n) : "memory")
#define SLOAD_H(Kp, Vp, k0) do { S.st_v0 = load8(ROW(Vp, k0, sr)); S.st_v1 = load8(ROW(Vp, k0, 32 + sr));              \
                         S.st_k0 = load8(ROW(Kp, k0, sr)); S.st_k1 = load8(ROW(Kp, k0, 32 + sr)); } while (0)
#define SWRITE_HK(bf) do { *(bf16x8*)(K_lds + (bf) * SHM_K + kws) = S.st_k0; *(bf16x8*)(K_lds + (bf) * SHM_K + kws + 32 * 256) = S.st_k1; } while (0)
#define SWRITE_HV(bf) do { *(bf16x8*)(V_lds + (bf) * SHM_V + vst0) = S.st_v0; *(bf16x8*)(V_lds + (bf) * SHM_V + vst1) = S.st_v1; } while (0)
#define SWRITE_H(bf) do { SWRITE_HV(bf); SWRITE_HK(bf); } while (0)
__device__ __forceinline__ void moba_prime(const BlockRef& cur, char* lds, Seam& S, const int wid) {
    const int lane = lane_id(), tid = wid * 64 + lane, r32 = lane & 31, hi = lane >> 5;
    const int sr = tid >> 4, sc = (tid & 15) * 8, kws = KSWZ(sr, sc * 2); char* K_lds = lds + 2 * SHM_V;
#pragma unroll
    for (int d0 = 0; d0 < 8; ++d0) S.qr[d0] = load8(it_Q(cur) + (size_t)(wid * QBLK + r32) * QP + d0 * 16 + hi * 8);
    SLOAD_H(it_K(cur), it_V(cur), 0); VMW(); SWRITE_HK(0);
    __syncthreads();
}
__device__ __forceinline__ void moba_block(const BlockRef& cur, const BlockRef& nxt, char* lds, Seam& S, const int wid) {
    const int lane = lane_id(), tid = wid * 64 + lane, r32 = lane & 31, hi = lane >> 5;
    const int qb = it_qb(cur.item), P0 = qb * 256;
    const int NT = (P0 + QB) / KVBLK;
    const int qlo = P0 + wid * QBLK, qm = qlo + r32 - 4 * hi;
    char* V_lds = lds; char* K_lds = lds + 2 * SHM_V;
    float* ws = (float*)(lds + 2 * SHM_V + 2 * SHM_K) + wid * 64; float* li_l = ws, * al_l = ws + 32;
    unsigned selmask = 0u;
    if (qb > 0) {
        float* kms = (float*)(lds + LDS_BYTES);
        { const float* kmg = it_KM(cur);
#pragma unroll
          for (int u_ = 0; u_ < 4; ++u_) { const int i = tid + 512 * u_; if (i < qb * 128) kms[i] = kmg[(size_t)(i >> 7) * 1024 + (i & 127)]; } }
        __syncthreads();
        float v0 = -__builtin_inff(), v1 = v0, v2 = v0; int i0 = -1, i1 = -1, i2 = -1;
#pragma unroll 1
        for (int n = 0; n < qb; ++n) {
            const float* km = kms + n * 128 + hi * 8;
            float g = 0.f;
#pragma unroll
            for (int d0 = 0; d0 < 8; ++d0) { const f32x4 ka = *(const f32x4*)(km + d0 * 16), kb4 = *(const f32x4*)(km + d0 * 16 + 4);
#pragma unroll
                for (int j = 0; j < 4; ++j) { g += __uint_as_float(((unsigned)(unsigned short)S.qr[d0][j]) << 16) * ka[j]; g += __uint_as_float(((unsigned)(unsigned short)S.qr[d0][4 + j]) << 16) * kb4[j]; } }
            g += __shfl_xor(g, 32);
            const bool b2 = g > v2, b1 = g > v1, b0 = g > v0;
            const float nv2 = b1 ? v1 : (b2 ? g : v2); const int ni2 = b1 ? i1 : (b2 ? n : i2);
            const float nv1 = b0 ? v0 : (b1 ? g : v1); const int ni1 = b0 ? i0 : (b1 ? n : i1);
            v2 = nv2; i2 = ni2; v1 = nv1; i1 = ni1; if (b0) { v0 = g; i0 = n; }
        }
        if (i0 >= 0) selmask |= 1u << i0; if (i1 >= 0) selmask |= 1u << i1; if (i2 >= 0) selmask |= 1u << i2;
        __syncthreads();
    }
    float m_reg = -1e30f, l_reg = 0; f32x16 o[4] = {};
    const int sr = tid >> 4, sc = (tid & 15) * 8, vst0 = v_st(sr, sc), vst1 = v_st(32 + sr, sc), kws = KSWZ(sr, sc * 2);
    const int vb0 = (int)(uintptr_t)V_lds + v_rd_base(lane);
    const bf16* Kh = it_K(cur); const bf16* Vh = Kh + (size_t)M * 1024;
#define RESC(a) do { if (__any((a) < 1.f)) { if (hi == 0) al_l[r32] = (a); asm volatile("s_waitcnt lgkmcnt(0)" ::: "memory");              \
                     for (int d_ = 0; d_ < 4; ++d_) for (int r = 0; r < 16; ++r) o[d_][r] *= al_l[crow(r, hi)]; } } while (0)
#define KBASE(t) ((t) * KVBLK)
#define MASKT(P0_, P1_, t) do { const int kb_ = KBASE(t); const int nb_ = kb_ >> 8; dead_ = false;                          \
        if (nb_ < qb) dead_ = !((selmask >> nb_) & 1u);                                                                    \
        else if (kb_ + KVBLK - 1 > qlo) mask_tile(P0_, P1_, qm - kb_); } while (0)
    bool dead_ = false;
    constexpr int NQL = 8;
#define SEAM_K0() do { VMWN(NQL); SWRITE_HK(0); SBAR(); } while (0)
    f32x16 pA0, pA1, pB0, pB1; float mnA, mnB, alA, alB; bf16x8 pa0, pa1, pa2, pa3;
    SWRITE_HV(0); SBAR();
    if (NT > 1) { SLOAD_H(Kh, Vh, KBASE(1)); }
    SBAR(); qkt<0>(pA0, pA1, K_lds, r32, hi, S.qr);
    MASKT(pA0, pA1, 0); partialSM(pA0, pA1, m_reg, mnA, alA, dead_);
    if (NT > 1) { VMW(); SWRITE_H(1); }
    __syncthreads();
#define HALF_STEP(PX0, PX1, mnX, alX, PY0, PY1, alY, t, KB, VB, SB) do {                                                      \
        SBAR(); qkt<KB>(PX0, PX1, K_lds, r32, hi, S.qr);                                                                      \
        finishSM(PY0, PY1, alY, l_reg, pa0, pa1, pa2, pa3); SBAR();                                                           \
        if ((t) + 1 < NT) { SLOAD_H(Kh, Vh, KBASE((t) + 1)); SBAR(); }                                                        \
        pv_tile<VB>(o, vb0, pa0, pa1, pa2, pa3); MASKT(PX0, PX1, (t)); partialSM(PX0, PX1, m_reg, mnX, alX, dead_);                  \
        __syncthreads();                                                                                                      \
        if ((t) + 1 < NT) { VMW(); SWRITE_H(SB); }                                                                            \
        RESC(alX); __syncthreads(); } while (0)
    for (int t = 1; t + 1 < NT; t += 2) {
        HALF_STEP(pB0, pB1, mnB, alB, pA0, pA1, alA, t, 1, 0, 0);
        HALF_STEP(pA0, pA1, mnA, alA, pB0, pB1, alB, t + 1, 0, 1, 1);
    }
    const bool even = (NT & 1) == 0;
    if (even) { SBAR(); qkt<1>(pB0, pB1, K_lds, r32, hi, S.qr); SBAR(); }
    SLOAD_H(it_K(nxt), it_V(nxt), 0); SBAR();
#pragma unroll
    for (int d0 = 0; d0 < 8; ++d0) S.qr[d0] = load8(it_Q(nxt) + (size_t)(wid * QBLK + r32) * QP + d0 * 16 + hi * 8);
    SBAR();
    finishSM(pA0, pA1, alA, l_reg, pa0, pa1, pa2, pa3); SBAR();
    pv_tile<0>(o, vb0, pa0, pa1, pa2, pa3);
    if (even) { MASKT(pB0, pB1, NT - 1); partialSM(pB0, pB1, m_reg, mnB, alB, dead_); __syncthreads(); RESC(alB);
        finishSM(pB0, pB1, alB, l_reg, pa0, pa1, pa2, pa3); SBAR(); pv_tile<1>(o, vb0, pa0, pa1, pa2, pa3); }
    SBAR(); SEAM_K0();
    if (hi == 0) li_l[r32] = l_reg; asm volatile("s_waitcnt lgkmcnt(0)" ::: "memory");
    float rli[16];
#pragma unroll
    for (int r = 0; r < 16; ++r) rli[r] = __builtin_amdgcn_rcpf(li_l[crow(r, hi)]);
    unsigned char* Ob = it_O(cur) + (size_t)(wid * QBLK + 4 * hi) * OP + r32;
#pragma unroll
    for (int r = 0; r < 16; ++r) { unsigned char* p = Ob; asm volatile("" : "+v"(p));
        p += (size_t)((r & 3) + 8 * (r >> 2)) * OP;
#pragma unroll
        for (int d0 = 0; d0 < 4; ++d0) { const float v = __builtin_fminf(__builtin_fmaxf(o[d0][r] * rli[r] * 16.f, -448.f), 448.f);
            const float vn = __builtin_bit_cast(float, __builtin_amdgcn_mov_dpp(__builtin_bit_cast(int, v), 0xB1, 0xF, 0xF, true));
            const int w01 = __builtin_amdgcn_cvt_pk_fp8_f32(v, vn, 0, false) & 0xffff;
            const int w23 = __builtin_amdgcn_mov_dpp(w01, 0x4E, 0xF, 0xF, true);
            if ((r32 & 3) == 0) *(GAS unsigned*)(p + d0 * 32) = (unsigned)(w01 | (w23 << 16)); } }
    __syncthreads();
#undef RESC
#undef KBASE
#undef MASKT
#undef SEAM_K0
#undef HALF_STEP
}
#undef ROW
#undef VMW
#undef VMWN
#undef SLOAD_H
#undef SWRITE_HK
#undef SWRITE_HV
#undef SWRITE_H
#undef KSWZ
#undef SBAR
}
constexpr int NWAVES = 8;
constexpr int RING_BYTES = 143360;
constexpr int TAB_OFF = RING_BYTES;
constexpr int TILE_E_OFF = TAB_OFF + 1024;
constexpr int TILE_S_OFF = TILE_E_OFF + 2048;
constexpr int ECNT_OFF = TILE_S_OFF + 512;
constexpr int MISC_OFF = ECNT_OFF + 512;
constexpr int LDS_BYTES = MISC_OFF + 256;
static_assert(LDS_BYTES <= 160 * 1024 && LDS_BYTES > 80 * 1024, "one workgroup per CU");

typedef float f32x4 __attribute__((ext_vector_type(4)));
typedef unsigned v4u __attribute__((ext_vector_type(4)));
typedef unsigned v2u __attribute__((ext_vector_type(2)));
typedef GAS unsigned gu32;
#define RLX_AGENT __ATOMIC_RELAXED, __HIP_MEMORY_SCOPE_AGENT

#define XB_TMO      128
#define XB_XCNT(j)  (256  + 64 * (j))
#define XB_XSUB(j)  (1280 + 64 * (j))
#define XB_XGEN(j)  (2304 + 64 * (j))
#define XB_TOP      3328
#define XB_TOPGEN   3392
#define XCD_BAR_WORDS 3456
#define XB_SPIN_CAP (1u << 20)
__device__ __forceinline__ unsigned xb_ld(unsigned* p)              { return __hip_atomic_load(p, __ATOMIC_RELAXED, __HIP_MEMORY_SCOPE_AGENT); }
__device__ __forceinline__ unsigned xb_add(unsigned* p, unsigned v) { return __hip_atomic_fetch_add(p, v, __ATOMIC_RELAXED, __HIP_MEMORY_SCOPE_AGENT); }
__device__ __forceinline__ unsigned xb_xcc_id() { return (unsigned)__builtin_amdgcn_s_getreg((3 << 11) | 20) & 0xFu; }
#define XB_SPIN(cond, bar) do { unsigned _sp = 0; while (cond) { __builtin_amdgcn_s_sleep(1); \
    if ((++_sp & 255u) == 0u) { if (xb_ld(&(bar)[XB_TMO])) break; if (_sp > XB_SPIN_CAP) { atomicAdd(&(bar)[XB_TMO], 1u); break; } } } } while (0)
struct XcdBarrier { unsigned* bar; unsigned x; volatile LAS unsigned* st; };
__device__ __forceinline__ XcdBarrier xcd_barrier_post(unsigned* bar, volatile LAS unsigned* st, int tid) {
    XcdBarrier b; b.bar = bar; b.x = xb_xcc_id(); b.st = st;
    if (tid == 0) (void)xb_add(&bar[XB_XCNT(b.x)], 1u);
    return b;
}
__device__ __forceinline__ void xcd_barrier_complete(unsigned* bar, unsigned x, unsigned& nloc, unsigned& nx) {
    const unsigned G = gridDim.x * gridDim.y * gridDim.z;
    unsigned sum, cnt, mine, sp = 0u;
    for (;;) {
        sum = 0u; cnt = 0u; mine = 0u;
#pragma unroll
        for (unsigned j = 0; j < 16; ++j) { const unsigned c = xb_ld(&bar[XB_XCNT(j)]); sum += c; cnt += (c > 0u) ? 1u : 0u; mine = (j == x) ? c : mine; }
        if (sum == G) break;
        __builtin_amdgcn_s_sleep(1);
        if ((++sp & 255u) == 0u) { if (xb_ld(&bar[XB_TMO])) break; if (sp > XB_SPIN_CAP) { atomicAdd(&bar[XB_TMO], 1u); break; } }
    }
    nloc = mine > 0u ? mine : 1u; nx = cnt > 0u ? cnt : 1u;
}
__device__ __forceinline__ void xcd_barrier(const XcdBarrier& b, int tid) {
    asm volatile("s_waitcnt vmcnt(0)" ::: "memory");
    __syncthreads();
    if (tid == 0) {
        unsigned* bar = b.bar;
        __builtin_amdgcn_s_waitcnt(0);
        unsigned nloc = b.st[0], nx = b.st[1];
        if (nloc == 0u) { xcd_barrier_complete(bar, b.x, nloc, nx); b.st[0] = nloc; b.st[1] = nx; }
        const unsigned old = xb_add(&bar[XB_XSUB(b.x)], 1u);
        const unsigned gen = old / nloc;
        if (old + 1u == (gen + 1u) * nloc) {
            __builtin_amdgcn_fence(__ATOMIC_RELEASE, "agent");
            asm volatile("s_waitcnt vmcnt(0)" ::: "memory");
            const unsigned og = xb_add(&bar[XB_TOP], 1u);
            const unsigned tg = og / nx;
            if (og + 1u == (tg + 1u) * nx) xb_add(&bar[XB_TOPGEN], 1u);
            else XB_SPIN(xb_ld(&bar[XB_TOPGEN]) == tg, bar);
            __builtin_amdgcn_fence(__ATOMIC_ACQUIRE, "agent");
            xb_add(&bar[XB_XGEN(b.x)], 1u);
            asm volatile("s_waitcnt vmcnt(0)" ::: "memory");
        } else {
            XB_SPIN(xb_ld(&bar[XB_XGEN(b.x)]) == gen, bar);
            __builtin_amdgcn_fence(__ATOMIC_ACQUIRE, "agent");
            asm volatile("s_waitcnt vmcnt(0)" ::: "memory");
        }
    }
    __syncthreads();
}

struct Args { const void* in[18]; float* out; unsigned char* ws; int ph_lo, ph_hi, li, pad; };
struct Frame {
    LAS unsigned char* lds; int wave, G, bid;
    unsigned char* ws;
};

__device__ __forceinline__ void transpose_item(const float* W, int N, bf16* WT, int Kout, size_t rb, int k0, int n0, LAS bf16* scr, int lane) {
    const int kr = lane >> 4, nc = (lane & 15) * 4;
    f32x4 v[16];
#pragma unroll
    for (int i = 0; i < 16; ++i) v[i] = *(const GAS f32x4*)(W + (size_t)(k0 + 4 * i + kr) * N + n0 + nc);
#pragma unroll
    for (int i = 0; i < 16; ++i) { const int k = 4 * i + kr;
        const unsigned p0 = pg8::cvt_pk_bf16(v[i][0], v[i][1]), p1 = pg8::cvt_pk_bf16(v[i][2], v[i][3]);
        scr[(nc + 0) * 68 + k] = (bf16)(p0 & 0xffffu); scr[(nc + 1) * 68 + k] = (bf16)(p0 >> 16);
        scr[(nc + 2) * 68 + k] = (bf16)(p1 & 0xffffu); scr[(nc + 3) * 68 + k] = (bf16)(p1 >> 16); }
    asm volatile("s_waitcnt lgkmcnt(0)" ::: "memory");
    const int c = lane & 7;
#pragma unroll
    for (int j = 0; j < 8; ++j) { const int n = (lane >> 3) + 8 * j;
        const LAS v2u* s = (const LAS v2u*)(scr + n * 68 + 8 * c); const v2u a = s[0], b = s[1];
        v4u o; o.x = a.x; o.y = a.y; o.z = b.x; o.w = b.y;
        *(GAS v4u*)(WT + (rb + n) * (size_t)Kout + k0 + 8 * c) = o; }
    asm volatile("s_waitcnt lgkmcnt(0)" ::: "memory");
}

struct TrItem { const float* W; bf16* WT; size_t rb; int N, Kout, k0, n0; };
__device__ __forceinline__ void tr_load(f32x4 (&v)[16], const TrItem& t, int lane) {
    const int kr = lane >> 4, nc = (lane & 15) * 4;
#pragma unroll
    for (int i = 0; i < 16; ++i) v[i] = __builtin_nontemporal_load((const GAS f32x4*)(t.W + (size_t)(t.k0 + 4 * i + kr) * t.N + t.n0 + nc));
}
__device__ __forceinline__ void tr_finish(const f32x4 (&v)[16], const TrItem& t, LAS bf16* scr, int lane) {
    const int kr = lane >> 4, nc = (lane & 15) * 4;
#pragma unroll
    for (int i = 0; i < 16; ++i) { const int k = 4 * i + kr;
        const unsigned p0 = pg8::cvt_pk_bf16(v[i][0], v[i][1]), p1 = pg8::cvt_pk_bf16(v[i][2], v[i][3]);
        scr[(nc + 0) * 68 + k] = (bf16)(p0 & 0xffffu); scr[(nc + 1) * 68 + k] = (bf16)(p0 >> 16);
        scr[(nc + 2) * 68 + k] = (bf16)(p1 & 0xffffu); scr[(nc + 3) * 68 + k] = (bf16)(p1 >> 16); }
    asm volatile("s_waitcnt lgkmcnt(0)" ::: "memory");
    const int c = lane & 7;
#pragma unroll
    for (int j = 0; j < 8; ++j) { const int n = (lane >> 3) + 8 * j;
        const LAS v2u* s = (const LAS v2u*)(scr + n * 68 + 8 * c); const v2u a = s[0], b = s[1];
        v4u o; o.x = a.x; o.y = a.y; o.z = b.x; o.w = b.y;
        *(GAS v4u*)(t.WT + (t.rb + n) * (size_t)t.Kout + t.k0 + 8 * c) = o; }
    asm volatile("s_waitcnt lgkmcnt(0)" ::: "memory");
}

__device__ __forceinline__ void tr_finish8(const f32x4 (&v)[16], const TrItem& t, float scale, LAS unsigned char* scr, int lane) {
    const int kr = lane >> 4, nc = (lane & 15) * 4;
#pragma unroll
    for (int i = 0; i < 16; ++i) { const int k = 4 * i + kr;
        const int p0 = __builtin_amdgcn_cvt_pk_fp8_f32(v[i][0] * scale, v[i][1] * scale, 0, false), p1 = __builtin_amdgcn_cvt_pk_fp8_f32(v[i][2] * scale, v[i][3] * scale, 0, false);
        scr[(nc + 0) * 72 + k] = (unsigned char)(p0 & 0xff); scr[(nc + 1) * 72 + k] = (unsigned char)((p0 >> 8) & 0xff);
        scr[(nc + 2) * 72 + k] = (unsigned char)(p1 & 0xff); scr[(nc + 3) * 72 + k] = (unsigned char)((p1 >> 8) & 0xff); }
    asm volatile("s_waitcnt lgkmcnt(0)" ::: "memory");
    const int c = lane & 7;
#pragma unroll
    for (int j = 0; j < 8; ++j) { const int n = (lane >> 3) + 8 * j;
        const v2u a = *(const LAS v2u*)(scr + n * 72 + 8 * c);
        __builtin_nontemporal_store(a, (GAS v2u*)((unsigned char*)t.WT + (t.rb + n) * (size_t)t.Kout + t.k0 + 8 * c)); }
    asm volatile("s_waitcnt lgkmcnt(0)" ::: "memory");
}

__device__ __forceinline__ void tr_load128(f32x4 (&v)[32], const TrItem& t, int) {
    const int lane = lane_id();
    const int kr = lane >> 4, nc = (lane & 15) * 4;
    const GAS char* base = (const GAS char*)(t.W + (size_t)t.k0 * t.N + t.n0);
    const unsigned loff = (unsigned)(16 * kr * t.N + nc) * 4u;
#pragma unroll
    for (int i = 0; i < 32; ++i) v[i] = __builtin_nontemporal_load((const GAS f32x4*)(base + (size_t)(64 * (i >> 4) + (i & 15)) * (size_t)t.N * 4u + loff));
}
__device__ __forceinline__ void tr_pack128(const f32x4 (&v)[32], float scale, v4u (&d)[4][2]) {
#pragma unroll
    for (int c = 0; c < 4; ++c)
#pragma unroll
        for (int p = 0; p < 2; ++p)
#pragma unroll
            for (int q = 0; q < 4; ++q) { const int i0 = 16 * p + 4 * q;
                int w = __builtin_amdgcn_cvt_pk_fp8_f32(v[i0][c] * scale, v[i0 + 1][c] * scale, 0, false);
                w = __builtin_amdgcn_cvt_pk_fp8_f32(v[i0 + 2][c] * scale, v[i0 + 3][c] * scale, w, true);
                d[c][p][q] = (unsigned)w; }
}
__device__ __forceinline__ void tr_store128(const v4u (&d)[4][2], const TrItem& t, LAS unsigned char* scr, int) {
    const int lane = lane_id();
    const int kr = lane >> 4, nq = lane & 15;
#pragma unroll
    for (int c = 0; c < 4; ++c)
#pragma unroll
        for (int p = 0; p < 2; ++p) *(LAS v4u*)(scr + (4 * nq + c) * 144 + p * 64 + 16 * kr) = d[c][p];
    asm volatile("s_waitcnt lgkmcnt(0)" ::: "memory");
    const int c8 = lane & 7;
#pragma unroll
    for (int j = 0; j < 8; ++j) { const int n = (lane >> 3) + 8 * j;
        const v4u o = *(const LAS v4u*)(scr + n * 144 + 16 * c8);
        __builtin_nontemporal_store(o, (GAS v4u*)((unsigned char*)t.WT + (t.rb + n) * (size_t)t.Kout + t.k0 + 16 * c8)); }
    asm volatile("s_waitcnt lgkmcnt(0)" ::: "memory");
}
namespace ret {
typedef short bf16x8 __attribute__((ext_vector_type(8)));
typedef short s16x4 __attribute__((ext_vector_type(4)));
typedef float f32x16 __attribute__((ext_vector_type(16)));
typedef float f32x4 __attribute__((ext_vector_type(4)));
typedef unsigned u32x4 __attribute__((ext_vector_type(4)));
constexpr int VSTR = 528;
constexpr int PSTR = 272;
constexpr int IMG = 128 * VSTR;
__device__ __forceinline__ int crow(int r, int hi) { return (r & 3) + 8 * (r >> 2) + 4 * hi; }
__device__ __forceinline__ s16x4 vtr(const LAS char* p) { return __builtin_bit_cast(s16x4, __builtin_amdgcn_ds_read_tr16_b64_v4i16((LAS s16x4*)p)); }
__device__ __forceinline__ bf16x8 tr_frag(const LAS char* img, int str, int k0, int c0, int lane) {
    const int g = lane >> 4, h = g >> 1, i = lane & 15, q = i >> 2, p = i & 3;
    const LAS char* a = img + (k0 + 8 * h + q) * str + (c0 + 16 * (g & 1) + 4 * p) * 2;
    const s16x4 lo = vtr(a), hi = vtr(a + 4 * str);
    return (bf16x8){lo[0], lo[1], lo[2], lo[3], hi[0], hi[1], hi[2], hi[3]};
}
__device__ __forceinline__ unsigned cvtpk(float lo, float hi) { unsigned r; asm volatile("v_cvt_pk_bf16_f32 %0, %1, %2" : "=v"(r) : "v"(lo), "v"(hi)); return r; }
__device__ __forceinline__ float gamma_log2(int h) { return log2f(1.f - exp2f(-5.f - (float)h)); }
__device__ __forceinline__ void stage_chunk(LAS char* img, const bf16* src, int tid, bool scale, float lg) {
#pragma unroll
    for (int i = 0; i < 8; ++i) { const int row = (tid >> 5) + 16 * i, pc = tid & 31;
        u32x4 v = *(const GAS u32x4*)(src + (size_t)row * 1024 + pc * 8);
        if (scale) { const float z = exp2f(lg * (float)(127 - row));
            u32x4 o;
#pragma unroll
            for (int j = 0; j < 4; ++j) o[j] = cvtpk(__uint_as_float(v[j] << 16) * z, __uint_as_float(v[j] & 0xffff0000u) * z);
            v = o; }
        *(LAS u32x4*)(img + row * VSTR + pc * 16) = v; }
}
__device__ __forceinline__ void ret_state(const unsigned char* ws, LAS unsigned char* lds, int item, int wid) {
    const int lane = lane_id(), tid = wid * 64 + lane, hi = lane >> 5, c = lane & 31;
    const int bh = item >> 5, ch = item & 31, b = bh >> 2, h = bh & 3;
    const bf16* proj = (const bf16*)(ws + WS_PROJ); const size_t PS = (size_t)M * 1024;
    const bf16* kr = proj + 4 * PS + (size_t)(b * T + ch * 128) * 1024 + h * 256; const bf16* vr = proj + 5 * PS + (size_t)(b * T + ch * 128) * 1024 + h * 256;
    LAS char* vimg = (LAS char*)lds; LAS char* kimg = vimg + IMG;
    const float lg = gamma_log2(h);
    stage_chunk(vimg, vr, tid, false, 0.f); stage_chunk(kimg, kr, tid, true, lg);
    __syncthreads();
    f32x16 acc[8];
#pragma unroll
    for (int j = 0; j < 8; ++j) acc[j] = f32x16{};
#pragma unroll 2
    for (int ks = 0; ks < 8; ++ks) {
        const bf16x8 a = tr_frag(vimg, VSTR, ks * 16, wid * 32, lane);
#pragma unroll
        for (int j = 0; j < 8; ++j) { const bf16x8 bb = tr_frag(kimg, VSTR, ks * 16, j * 32, lane); acc[j] = __builtin_amdgcn_mfma_f32_32x32x16_bf16(a, bb, acc[j], 0, 0, 0); }
    }
    bf16* ut = (bf16*)(ws + WS_U) + (size_t)item * 65536;
#pragma unroll
    for (int j = 0; j < 8; ++j)
#pragma unroll
        for (int r = 0; r < 16; ++r) { const float v = acc[j][r], vn = __builtin_bit_cast(float, __builtin_amdgcn_mov_dpp(__builtin_bit_cast(int, v), 0xB1, 0xF, 0xF, true));
            if ((c & 1) == 0) *(GAS unsigned*)(ut + (size_t)(wid * 32 + crow(r, hi)) * 256 + j * 32 + c) = cvtpk(v, vn); }
    __syncthreads();
}
__device__ __forceinline__ void ret_scan(const unsigned char* ws, int gtid, int gthreads) {
    const bf16* ut = (const bf16*)(ws + WS_U); bf16* st = (bf16*)(ws + WS_S);
    for (int e = gtid; e < 8 * 16384; e += gthreads) {
        const int bh = e >> 14, off = (e & 16383) * 4; const float dec = exp2f(128.f * gamma_log2(bh & 3));
        f32x4 s = {0.f, 0.f, 0.f, 0.f};
        v2u u = __builtin_nontemporal_load((const GAS v2u*)(ut + (size_t)(bh * 32) * 65536 + off));
#pragma unroll 4
        for (int ch = 0; ch < 32; ++ch) {
            v2u un = u; if (ch + 1 < 32) un = __builtin_nontemporal_load((const GAS v2u*)(ut + (size_t)(bh * 32 + ch + 1) * 65536 + off));
            v2u w; w.x = cvtpk(s[0], s[1]); w.y = cvtpk(s[2], s[3]);
            *(GAS v2u*)(st + (size_t)(bh * 32 + ch) * 65536 + off) = w;
            s = s * dec + (f32x4){__uint_as_float(u.x << 16), __uint_as_float(u.x & 0xffff0000u), __uint_as_float(u.y << 16), __uint_as_float(u.y & 0xffff0000u)}; u = un;
        }
    }
}
template <int NROWS>
__device__ __forceinline__ void stage_rows(LAS char* img, const bf16* src, int pitch, int tid) {
    u32x4 v[NROWS / 16];
#pragma unroll
    for (int i = 0; i < NROWS / 16; ++i) v[i] = *(const GAS u32x4*)(src + (size_t)((tid >> 5) + 16 * i) * pitch + (tid & 31) * 8);
#pragma unroll
    for (int i = 0; i < NROWS / 16; ++i) *(LAS u32x4*)(img + ((tid >> 5) + 16 * i) * VSTR + (tid & 31) * 16) = v[i];
}
__device__ __forceinline__ void ret_out(const unsigned char* ws, LAS unsigned char* lds, int item, int wid) {
    const int lane = lane_id(), tid = wid * 64 + lane, hi = lane >> 5, c = lane & 31, r32 = c;
    const int bh = item >> 5, ch = item & 31, b = bh >> 2, h = bh & 3;
    const bf16* proj = (const bf16*)(ws + WS_PROJ); const size_t PS = (size_t)M * 1024; const size_t row0 = (size_t)(b * T + ch * 128);
    const bf16* qr = proj + 3 * PS + row0 * 1024 + h * 256; const bf16* kr = proj + 4 * PS + row0 * 1024 + h * 256;
    const bf16* vr = proj + 5 * PS + row0 * 1024 + h * 256; const bf16* gr = proj + 6 * PS + row0 * 1024 + h * 256;
    const bf16* st = (const bf16*)(ws + WS_S) + (size_t)item * 65536;
    LAS char* img0 = (LAS char*)lds; LAS char* img1 = img0 + IMG; LAS float* stat = (LAS float*)(img0 + 2 * IMG);
    const float lg = gamma_log2(h);
    const int rb = wid & 3, half = wid >> 2;
    stage_rows<128>(img0, kr, 1024, tid); stage_rows<128>(img1, vr, 1024, tid);
    bf16x8 qf[16];
#pragma unroll
    for (int ks = 0; ks < 16; ++ks) qf[ks] = *(const GAS bf16x8*)(qr + (size_t)(rb * 32 + r32) * 1024 + ks * 16 + hi * 8);
    __syncthreads();
    u32x4 sv[16];
#pragma unroll
    for (int i = 0; i < 16; ++i) sv[i] = *(const GAS u32x4*)(st + (size_t)((tid >> 5) + 16 * i) * 256 + (tid & 31) * 8);
    unsigned pw[2][8];
#pragma unroll
    for (int jj = 0; jj < 2; ++jj) { const int cb = 2 * half + jj;
        f32x16 p = f32x16{};
        if (cb <= rb) {
#pragma unroll
            for (int ks = 0; ks < 16; ++ks) { const bf16x8 kf = *(const LAS bf16x8*)(img0 + (cb * 32 + r32) * VSTR + (ks * 16 + hi * 8) * 2);
                p = __builtin_amdgcn_mfma_f32_32x32x16_bf16(qf[ks], kf, p, 0, 0, 0); }
        }
#pragma unroll
        for (int r = 0; r < 16; r += 2) { const int tk = cb * 32 + c, d0 = rb * 32 + crow(r, hi) - tk, d1 = d0 + 1;
            const float v0 = d0 >= 0 ? p[r] * exp2f(lg * (float)d0) : 0.f, v1 = d1 >= 0 ? p[r + 1] * exp2f(lg * (float)d1) : 0.f;
            pw[jj][r >> 1] = cvtpk(v0, v1); }
    }
    __syncthreads();
#pragma unroll
    for (int jj = 0; jj < 2; ++jj) { const int cb = 2 * half + jj;
#pragma unroll
        for (int r = 0; r < 16; r += 2) { const int tq = rb * 32 + crow(r, hi), tk = cb * 32 + c;
            *(LAS bf16*)(img0 + tq * PSTR + tk * 2) = (bf16)(pw[jj][r >> 1] & 0xffffu); *(LAS bf16*)(img0 + (tq + 1) * PSTR + tk * 2) = (bf16)(pw[jj][r >> 1] >> 16); } }
    __syncthreads();
    f32x16 acc[4];
#pragma unroll
    for (int j = 0; j < 4; ++j) acc[j] = f32x16{};
    for (int ks = 0; ks < 2 * rb + 2; ++ks) {
        const bf16x8 a = *(const LAS bf16x8*)(img0 + (rb * 32 + r32) * PSTR + (ks * 16 + hi * 8) * 2);
#pragma unroll
        for (int j = 0; j < 4; ++j) { const bf16x8 bb = tr_frag(img1, VSTR, ks * 16, (half * 4 + j) * 32, lane); acc[j] = __builtin_amdgcn_mfma_f32_32x32x16_bf16(a, bb, acc[j], 0, 0, 0); }
    }
    __syncthreads();
#pragma unroll
    for (int i = 0; i < 16; ++i) *(LAS u32x4*)(img0 + ((tid >> 5) + 16 * i) * VSTR + (tid & 31) * 16) = sv[i];
    { const float xi = exp2f(lg * (float)(rb * 32 + r32 + 1));
#pragma unroll
      for (int ks = 0; ks < 16; ++ks) { u32x4 w = __builtin_bit_cast(u32x4, qf[ks]);
#pragma unroll
          for (int j = 0; j < 4; ++j) w[j] = cvtpk(__uint_as_float(w[j] << 16) * xi, __uint_as_float(w[j] & 0xffff0000u) * xi);
          qf[ks] = __builtin_bit_cast(bf16x8, w); } }
    __syncthreads();
#pragma unroll
    for (int ks = 0; ks < 16; ++ks) {
#pragma unroll
        for (int j = 0; j < 4; ++j) { const bf16x8 sf = *(const LAS bf16x8*)(img0 + ((half * 4 + j) * 32 + r32) * VSTR + (ks * 16 + hi * 8) * 2);
            acc[j] = __builtin_amdgcn_mfma_f32_32x32x16_bf16(qf[ks], sf, acc[j], 0, 0, 0); }
    }
#define RDPPF(v, ctrl) __builtin_bit_cast(float, __builtin_amdgcn_mov_dpp(__builtin_bit_cast(int, (float)(v)), ctrl, 0xF, 0xF, true))
    unsigned short gv[16][4];
#pragma unroll
    for (int r = 0; r < 16; ++r)
#pragma unroll
        for (int j = 0; j < 4; ++j) gv[r][j] = *(const GAS unsigned short*)(gr + (size_t)(rb * 32 + crow(r, hi)) * 1024 + (half * 4 + j) * 32 + c);
    float s1[16], s2[16];
#pragma unroll
    for (int r = 0; r < 16; ++r) { float a1 = 0.f, a2 = 0.f;
#pragma unroll
        for (int j = 0; j < 4; ++j) { const float v = acc[j][r]; a1 += v; a2 += v * v; }
        s1[r] = a1; s2[r] = a2; }
#pragma unroll
    for (int r = 0; r < 16; ++r) {
        s1[r] += RDPPF(s1[r], 0x128); s2[r] += RDPPF(s2[r], 0x128); s1[r] += RDPPF(s1[r], 0x124); s2[r] += RDPPF(s2[r], 0x124);
        s1[r] += RDPPF(s1[r], 0x122); s2[r] += RDPPF(s2[r], 0x122); s1[r] += RDPPF(s1[r], 0x121); s2[r] += RDPPF(s2[r], 0x121);
        s1[r] += __shfl_xor(s1[r], 16); s2[r] += __shfl_xor(s2[r], 16);
        if (c == 0) { stat[(half * 128 + rb * 32 + crow(r, hi)) * 2 + 0] = s1[r]; stat[(half * 128 + rb * 32 + crow(r, hi)) * 2 + 1] = s2[r]; } }
    __syncthreads();
    unsigned char* mixo = (unsigned char*)(ws + WS_MIX) + row0 * D + 1024 + h * 256;
#pragma unroll
    for (int r = 0; r < 16; ++r) { const int row = rb * 32 + crow(r, hi);
        const float t1 = stat[row * 2] + stat[(128 + row) * 2], t2 = stat[row * 2 + 1] + stat[(128 + row) * 2 + 1];
        const float mu = t1 * (1.f / 256.f), var = t2 * (1.f / 256.f) - mu * mu, rs = rsqrtf(fmaxf(var, 0.f) + NORM_EPS);
#pragma unroll
        for (int j = 0; j < 4; ++j) { const int col = (half * 4 + j) * 32 + c;
            const float g = __uint_as_float(((unsigned)gv[r][j]) << 16);
            const float v = (acc[j][r] - mu) * rs * (g * __builtin_amdgcn_rcpf(1.f + __expf(-g)));
            const float vn = RDPPF(v, 0xB1);
            const int w01 = __builtin_amdgcn_cvt_pk_fp8_f32(__builtin_fminf(__builtin_fmaxf(v * 16.f, -448.f), 448.f), __builtin_fminf(__builtin_fmaxf(vn * 16.f, -448.f), 448.f), 0, false) & 0xffff;
            const int w23 = __builtin_amdgcn_mov_dpp(w01, 0x4E, 0xF, 0xF, true);
            if ((c & 3) == 0) *(GAS unsigned*)(mixo + (size_t)row * D + col) = (unsigned)(w01 | (w23 << 16)); } }
#undef RDPPF
    __syncthreads();
}
}
__device__ __forceinline__ void p0_prologue(const Frame& F, const Args& a) {
    const int lane = lane_id(), tid = F.wave * 64 + lane; (void)tid;
    const float* w_ada = (const float*)a.in[3]; const float* cvec = (const float*)a.in[1];
    const float* w_in = (const float*)a.in[8]; const float* w_out = (const float*)a.in[9];
    const float* w_gate = (const float*)a.in[12]; const float* w_up = (const float*)a.in[13]; const float* w_down = (const float*)a.in[14];
    const float* ws_gate = (const float*)a.in[15]; const float* ws_up = (const float*)a.in[16]; const float* ws_down = (const float*)a.in[17];
    bf16* WinT = (bf16*)(F.ws + WS_WIN); bf16* WoutT = (bf16*)(F.ws + WS_WOUT); bf16* WguT = (bf16*)(F.ws + WS_WGU); bf16* WdT = (bf16*)(F.ws + WS_WD);
    float* modp = (float*)(F.ws + WS_MODP);
    LAS bf16* scr = (LAS bf16*)(F.lds + F.wave * 9216);
    for (int i = F.bid * (NWAVES * 64) + tid; i < 90368; i += F.G * NWAVES * 64) ((int*)(F.ws + WS_IDENT))[i] = i * 16;
    constexpr int I_MOD = 16 * 48;
    constexpr int I_IN = 32 * 112, I_OUT = 0;
    if (F.wave < 3) {
        for (int r = F.wave * F.G + F.bid; r < I_MOD; r += 3 * F.G) {
            const int kc = r / 48, n0 = (r % 48) * 256 + lane * 4;
            f32x4 a0 = {0.f, 0.f, 0.f, 0.f}, a1 = {0.f, 0.f, 0.f, 0.f};
#pragma unroll 16
            for (int k = kc * 128; k < kc * 128 + 128; ++k) { const f32x4 w = __builtin_nontemporal_load((const GAS f32x4*)(w_ada + (size_t)k * (6 * D) + n0));
                const float c0 = cvec[k], c1 = cvec[D + k]; a0 += w * silu_f(c0); a1 += w * silu_f(c1); }
            *(f32x4*)(modp + (size_t)(kc * 2 + 0) * (6 * D) + n0) = a0; *(f32x4*)(modp + (size_t)(kc * 2 + 1) * (6 * D) + n0) = a1; }
    } else {
        constexpr int I_BF = 32 * 32, I_F8 = 16 * 80;
        for (int r = F.bid * 5 + (F.wave - 3); r < I_BF + I_F8; r += F.G * 5) {
            if (r < I_BF) { f32x4 vv[16]; TrItem t; const int kb = r / 32, nb = r % 32;
                t.W = w_in; t.WT = WinT; t.rb = (size_t)nb * 64; t.N = NPROJ; t.Kout = D; t.k0 = kb * 64; t.n0 = nb * 64;
                tr_load(vv, t, lane); tr_finish(vv, t, scr, lane); }
            else { f32x4 va[32]; TrItem t; const int r2 = r - I_BF, kb = r2 / 80, nb = 32 + r2 % 80;
                t.W = w_in; t.WT = (bf16*)(F.ws + WS_WIN8); t.rb = (size_t)nb * 64; t.N = NPROJ; t.Kout = D; t.k0 = kb * 128; t.n0 = nb * 64;
                tr_load128(va, t, lane); v4u d[4][2]; tr_pack128(va, 128.f, d); tr_store128(d, t, (LAS unsigned char*)scr, lane); } }
    }
}
constexpr int CV_OUT = 16 * 32, CV_GU = 65 * 2 * 16 * 8, CV_DN = 65 * 4 * 32, CV_CHUNK = 8, CV_NCHUNK = (CV_OUT + CV_GU + CV_DN) / CV_CHUNK;
constexpr int CW_CONVQ = 2048;
__device__ __forceinline__ TrItem conv_desc(const Frame& F, const Args& a, int r) {
    const float* w_gate = (const float*)a.in[12]; const float* w_up = (const float*)a.in[13]; const float* w_down = (const float*)a.in[14];
    const float* ws_gate = (const float*)a.in[15]; const float* ws_up = (const float*)a.in[16]; const float* ws_down = (const float*)a.in[17];
    TrItem t;
    if (r < CV_OUT) { const int kb = r / 32, nb = r % 32;
        t.W = (const float*)a.in[9]; t.WT = (bf16*)(F.ws + WS_WOUT); t.rb = (size_t)nb * 64; t.N = D; t.Kout = D; t.k0 = kb * 128; t.n0 = nb * 64; return t; }
    r -= CV_OUT;
    if (r < CV_GU) {
        const int eu = r / 128, e = eu >> 1, up = eu & 1, q = r % 128, kb = q / 8, nb = q % 8, n0 = nb * 64;
        t.W = e < 64 ? (up ? w_up : w_gate) + (size_t)e * D * EH : (up ? ws_up : ws_gate); t.WT = (bf16*)(F.ws + WS_WGU);
        t.rb = (size_t)e * 1024 + (n0 >> 7) * 256 + up * 128 + (n0 & 127); t.N = EH; t.Kout = D; t.k0 = kb * 128; t.n0 = n0; return t; }
    r -= CV_GU;
    { const int e = r / 128, q = r % 128, kb = q / 32, nb = q % 32;
      t.W = e < 64 ? w_down + (size_t)e * EH * D : ws_down; t.WT = (bf16*)(F.ws + WS_WD);
      t.rb = (size_t)e * D + nb * 64; t.N = D; t.Kout = EH; t.k0 = kb * 128; t.n0 = nb * 64; return t; }
}
constexpr int CW_DONE = 2112;
constexpr int CV_NOUT = CV_OUT / CV_CHUNK, CV_NGU = (CV_OUT + CV_GU) / CV_CHUNK;
__device__ __forceinline__ void conv_drain(const Frame& F, const Args& a, int limit, unsigned* done, unsigned need) {
    const int lane = lane_id(), tid = F.wave * 64 + lane;
    LAS int* slot = (LAS int*)(F.lds + MISC_OFF + 136);
    LAS unsigned char* scr8 = (LAS unsigned char*)(F.lds + F.wave * 9216);
    unsigned* head = (unsigned*)(F.ws + WS_CTL) + CW_CONVQ;
    int prev = 0; unsigned dv = 0u;
    __syncthreads();
    if (tid == 0) { int c = CV_NCHUNK;
        if (done != nullptr) dv = __hip_atomic_load(done, RLX_AGENT);
        if (!(done != nullptr && dv >= need) && (int)__hip_atomic_load(head, RLX_AGENT) < limit) c = (int)atomicAdd(head, 1u);
        slot[0] = c; prev = c; }
    __syncthreads();
    int c = __builtin_amdgcn_readfirstlane(slot[0]);
    if (c < CV_NCHUNK) {
        f32x4 va[32];
        TrItem t = conv_desc(F, a, c * CV_CHUNK + F.wave);
        tr_load128(va, t, lane);
        int par = 1;
        for (;;) {
            if (tid == 0) { int cn = CV_NCHUNK;
                if (!(done != nullptr && dv >= need) && prev + 1 < limit) cn = (int)atomicAdd(head, 1u);
                if (done != nullptr) dv = __hip_atomic_load(done, RLX_AGENT);
                slot[par] = cn; prev = cn; }
            v4u d[4][2];
            tr_pack128(va, c < CV_NGU ? 128.f : 64.f, d);
#pragma unroll
            for (int q = 0; q < 4; ++q) asm volatile("" : "+v"(d[q][0]), "+v"(d[q][1]));
            __syncthreads();
            const int cn = __builtin_amdgcn_readfirstlane(slot[par]); par ^= 1;
            TrItem tn = t;
            if (cn < CV_NCHUNK) { tn = conv_desc(F, a, cn * CV_CHUNK + F.wave); tr_load128(va, tn, lane); }
            tr_store128(d, t, scr8, lane);
            if (cn >= CV_NCHUNK) break;
            c = cn; t = tn;
        }
    }
    __syncthreads();
}
__device__ __forceinline__ void signal_done(const Frame& F, unsigned* done) {
    __syncthreads();
    if (F.wave == 0 && lane_id() == 0) (void)atomicAdd(done, 1u);
}
__device__ __forceinline__ void compute_cvec(const Frame& F, const Args& a, int b) {
    const int lane = lane_id(), tid = F.wave * 64 + lane;
    const float* w_router = (const float*)a.in[10]; const float* mod = (const float*)(F.ws + WS_MOD); float* cvec = (float*)(F.ws + WS_CVEC);
    LAS float* shf = (LAS float*)F.lds; LAS float* cp = shf + D;
    for (int i = tid; i < D; i += NWAVES * 64) shf[i] = mod[b * 6 * D + 3 * D + i];
    __syncthreads();
    { const int e = tid & 63, sl = tid >> 6; float s = 0.f;
#pragma unroll 16
      for (int k = sl * 256; k < sl * 256 + 256; ++k) s += shf[k] * w_router[(size_t)k * 64 + e];
      cp[sl * 64 + e] = s; }
    __syncthreads();
    if (tid < 64) { float s = 0.f;
#pragma unroll
        for (int sl = 0; sl < 8; ++sl) s += cp[sl * 64 + tid];
        cvec[b * 64 + tid] = s; }
    __syncthreads();
}
__device__ __forceinline__ void norm_rows(const Frame& F, const float* x, const float* g, const LAS float* smod  , bf16* xn, float* rstd_out, int m_lo, int m_step, int m_hi, unsigned char* xn8 = nullptr) {
    const int lane = lane_id(), tid = F.wave * 64 + lane; (void)tid;
    for (int m = m_lo; m < m_hi; m += m_step) {
        const int b = m / T;
        const GAS f32x4* xr = (const GAS f32x4*)(x + (size_t)m * D);
        f32x4 v[8]; float s = 0.f;
#pragma unroll
        for (int j = 0; j < 8; ++j) { v[j] = __builtin_nontemporal_load(xr + lane + 64 * j); s += v[j][0] * v[j][0] + v[j][1] * v[j][1] + v[j][2] * v[j][2] + v[j][3] * v[j][3]; }
        s = wave_sum(s);
        const float rstd = rsqrtf(s * (1.f / D) + NORM_EPS);
        if (rstd_out && lane == 0) rstd_out[m] = rstd;
#pragma unroll
        for (int j = 0; j < 8; ++j) { const int col = (lane + 64 * j) * 4;
            const f32x4 gg = *(const f32x4*)(g + col), h4 = *(const LAS f32x4*)(smod + (b * 2 + 0) * D + col), s4 = *(const LAS f32x4*)(smod + (b * 2 + 1) * D + col);
            const f32x4 o = v[j] * rstd * gg * (s4 + 1.f) + h4;
            v2u w; w.x = pg8::cvt_pk_bf16(o[0], o[1]); w.y = pg8::cvt_pk_bf16(o[2], o[3]);
            *(v2u*)(xn + (size_t)m * D + col) = w;
            if (xn8) { const f32x4 q = o * 16.f;
                int pk = __builtin_amdgcn_cvt_pk_fp8_f32(__builtin_fminf(__builtin_fmaxf(q[0], -448.f), 448.f), __builtin_fminf(__builtin_fmaxf(q[1], -448.f), 448.f), 0, false);
                pk = __builtin_amdgcn_cvt_pk_fp8_f32(__builtin_fminf(__builtin_fmaxf(q[2], -448.f), 448.f), __builtin_fminf(__builtin_fmaxf(q[3], -448.f), 448.f), pk, true);
                *(int*)(xn8 + (size_t)m * D + col) = pk; } }
    }
}
__device__ __forceinline__ void p1_norm(const Frame& F, const Args& a) {
    const int lane = lane_id(), tid = F.wave * 64 + lane; (void)tid;
    const float* x = (const float*)a.in[0]; const float* b_ada = (const float*)a.in[4]; const float* g = (const float*)a.in[5];
    const float* modp = (const float*)(F.ws + WS_MODP); float* mod = (float*)(F.ws + WS_MOD); bf16* xn = (bf16*)(F.ws + WS_XN);
    LAS float* smod = (LAS float*)F.lds;
    const int rows_per = (M + F.G - 1) / F.G, m_lo = F.bid * rows_per, m_hi = (m_lo + rows_per < M) ? m_lo + rows_per : M;
    const int b_lo = m_lo / T, b_hi = (m_hi - 1) / T;
    for (int b = b_lo; b <= b_hi && b < NB; ++b)
#pragma unroll
        for (int u_ = 0; u_ < 8; ++u_) { const int i = tid + 512 * u_, which = i / D, col = i % D, n = which * D + col;
            float s = b_ada[n];
#pragma unroll
            for (int kc = 0; kc < 16; ++kc) s += modp[(size_t)(kc * 2 + b) * (6 * D) + n];
            smod[b * 2 * D + i] = s; }
    if (F.bid < 48) { const int i = F.bid * 512 + tid, b = i / (6 * D), n = i % (6 * D);
        float s = b_ada[n];
#pragma unroll
        for (int kc = 0; kc < 16; ++kc) s += modp[(size_t)(kc * 2 + b) * (6 * D) + n];
        mod[i] = s; }
    __syncthreads();
    norm_rows(F, x, g, smod, xn, nullptr, m_lo + F.wave, NWAVES, m_hi, (unsigned char*)(F.ws + WS_XN8));
    __syncthreads();
}
__device__ __forceinline__ void p10_final(const Frame& F, const Args& a, const float probe_scale) {
    typedef float f32x2 __attribute__((ext_vector_type(2)));
    const int lane = lane_id();
    const float* xin = (const float*)a.in[0]; const bf16* mixo = (const bf16*)(F.ws + WS_MIXO); const unsigned char* yr = (const unsigned char*)(F.ws + WS_YSLOT); const float* mod = (const float*)(F.ws + WS_MOD);
    const int* inv = (const int*)(F.ws + WS_INV); const float* wts = (const float*)(F.ws + WS_WTS);
    const LAS int* tile_s = (const LAS int*)(F.lds + TILE_S_OFF);
    const float* gout = (const float*)a.in[7]; float* out = a.out;
    for (int m = F.bid * NWAVES + F.wave; m < M; m += F.G * NWAVES) {
        const float* gate = mod + (m / T) * 6 * D + 5 * D; const float* gatea = mod + (m / T) * 6 * D + 2 * D;
        int rowv = 0; float wv = 0.f;
        if (lane < 8) { const int iv = inv[m * 8 + lane]; rowv = tile_s[iv >> 13] * 256 + (iv & 8191); wv = wts[m * 8 + lane] * (1.f / 64.f); }
        else if (lane == 8) { rowv = tile_s[64] * 256 + m; wv = 1.f / 64.f; }
        f32x4 v[4][2]; float s = 0.f;
#pragma unroll
        for (int j = 0; j < 4; ++j) { const int col = (lane + 64 * j) * 8;
            f32x4 y0 = {0.f, 0.f, 0.f, 0.f}, y1 = {0.f, 0.f, 0.f, 0.f};
#pragma unroll
            for (int k = 0; k < 9; ++k) { const int rk = __builtin_amdgcn_readlane(rowv, k); const float wk = __builtin_bit_cast(float, __builtin_amdgcn_readlane(__builtin_bit_cast(int, wv), k));
                const v2u u = __builtin_nontemporal_load((const GAS v2u*)(yr + (size_t)rk * D + col));
                const f32x2 a0 = __builtin_amdgcn_cvt_pk_f32_fp8((int)u.x, false), a1 = __builtin_amdgcn_cvt_pk_f32_fp8((int)u.x, true);
                const f32x2 b0 = __builtin_amdgcn_cvt_pk_f32_fp8((int)u.y, false), b1 = __builtin_amdgcn_cvt_pk_f32_fp8((int)u.y, true);
                y0[0] += wk * a0[0]; y0[1] += wk * a0[1]; y0[2] += wk * a1[0]; y0[3] += wk * a1[1];
                y1[0] += wk * b0[0]; y1[1] += wk * b0[1]; y1[2] += wk * b1[0]; y1[3] += wk * b1[1]; }
            const v4u mm = __builtin_nontemporal_load((const GAS v4u*)(mixo + (size_t)m * D + col));
            const f32x4 gaa = *(const f32x4*)(gatea + col), gab = *(const f32x4*)(gatea + col + 4);
            const f32x4 xa = __builtin_nontemporal_load((const GAS f32x4*)(xin + (size_t)m * D + col)) + gaa * (f32x4){__uint_as_float(mm.x << 16), __uint_as_float(mm.x & 0xffff0000u), __uint_as_float(mm.y << 16), __uint_as_float(mm.y & 0xffff0000u)};
            const f32x4 xb = __builtin_nontemporal_load((const GAS f32x4*)(xin + (size_t)m * D + col + 4)) + gab * (f32x4){__uint_as_float(mm.z << 16), __uint_as_float(mm.z & 0xffff0000u), __uint_as_float(mm.w << 16), __uint_as_float(mm.w & 0xffff0000u)};
            const f32x4 ga = *(const f32x4*)(gate + col), gb = *(const f32x4*)(gate + col + 4);
            v[j][0] = xa + ga * y0; v[j][1] = xb + gb * y1;
#pragma unroll
            for (int q = 0; q < 2; ++q) s += v[j][q][0] * v[j][q][0] + v[j][q][1] * v[j][q][1] + v[j][q][2] * v[j][q][2] + v[j][q][3] * v[j][q][3]; }
        s = wave_sum(s);
        const float rstd = rsqrtf(s * (1.f / D) + NORM_EPS) * probe_scale;
#pragma unroll
        for (int j = 0; j < 4; ++j) { const int col = (lane + 64 * j) * 8;
            *(f32x4*)(out + (size_t)m * D + col) = v[j][0] * rstd * *(const f32x4*)(gout + col);
            *(f32x4*)(out + (size_t)m * D + col + 4) = v[j][1] * rstd * *(const f32x4*)(gout + col + 4); }
    }
}
__device__ __forceinline__ int moe_tables(const Frame& F, const unsigned* cnt) {
    const int lane = lane_id(), tid = F.wave * 64 + lane; (void)tid;
    LAS int* tile_e = (LAS int*)(F.lds + TILE_E_OFF); LAS int* tile_s = (LAS int*)(F.lds + TILE_S_OFF); LAS int* ecnt = (LAS int*)(F.lds + ECNT_OFF);
    if (tid < 65) ecnt[tid] = tid < 64 ? (int)__hip_atomic_load(cnt + tid * 64, RLX_AGENT) : M;
    __syncthreads();
    if (tid == 0) { int s = 0; for (int e = 0; e < 65; ++e) { tile_s[e] = s; s += (ecnt[e] + 255) >> 8; } tile_s[65] = s; }
    __syncthreads();
    const int total = tile_s[65];
    if (tid < 65) { for (int p = tile_s[tid]; p < tile_s[tid + 1]; ++p) tile_e[p] = tid; }
    __syncthreads();
    return total;
}
__device__ __forceinline__ void route_row(float lg, const float* bias, int row, LAS int* lcnt, LAS int* s_e, LAS int* s_lp, LAS float* s_w, LAS float* bscr, int lane) {
    const float score = 1.f / (1.f + __expf(-lg));
    const float biased = score + bias[lane];
    float m1 = biased;
    m1 = fmaxf(m1, __shfl_xor(m1, 1)); m1 = fmaxf(m1, __shfl_xor(m1, 2)); m1 = fmaxf(m1, __shfl_xor(m1, 4));
    const unsigned long long eq = __ballot(biased == m1);
    const unsigned gb = (unsigned)(eq >> (lane & ~7)) & 0xffu;
    const int first = __ffs(gb) - 1;
    float v2 = ((lane & 7) == first) ? -3e38f : biased;
    v2 = fmaxf(v2, __shfl_xor(v2, 1)); v2 = fmaxf(v2, __shfl_xor(v2, 2)); v2 = fmaxf(v2, __shfl_xor(v2, 4));
    const float gs = m1 + v2; const int g = lane >> 3;
    int grank = 0;
#pragma unroll
    for (int j = 0; j < 8; ++j) { const float o = __shfl(gs, j * 8); grank += (o > gs || (o == gs && j < g)) ? 1 : 0; }
    const float masked = grank < 4 ? biased : NEGF;
    int rank = 0, neq = 0;
    bscr[lane] = masked;
    __builtin_amdgcn_wave_barrier();
#pragma unroll
    for (int q = 0; q < 16; ++q) { const f32x4 o = *(const LAS f32x4*)(bscr + 4 * q);
#pragma unroll
        for (int c = 0; c < 4; ++c) { rank += (o[c] > masked) ? 1 : 0; neq += (o[c] == masked) ? 1 : 0; } }
    __builtin_amdgcn_wave_barrier();
    if (__ballot(neq > 1 && grank < 4) != 0ull) {
        int lo_ = lane; asm volatile("" : "+v"(lo_));
#pragma unroll 1
        for (int j = 0; j < 64; ++j) { const float o = __shfl(masked, j); rank += (o == masked && j < lo_) ? 1 : 0; } }
    const bool selx = rank < 8;
    const float ssum = wave_sum(selx ? score : 0.f);
    if (selx) { const int lp = __hip_atomic_fetch_add(lcnt + lane, 1, __ATOMIC_RELAXED, __HIP_MEMORY_SCOPE_WORKGROUP);
        s_e[row * 8 + rank] = lane; s_lp[row * 8 + rank] = lp; s_w[row * 8 + rank] = score / ssum * 2.5f; }
}
__device__ __forceinline__ void p7_route(const Frame& F, const Args& a) {
    typedef float f32x16 __attribute__((ext_vector_type(16)));
    const int lane = lane_id(), w = F.wave, tid = w * 64 + lane;
    const float* xin = (const float*)a.in[0]; const bf16* mixo = (const bf16*)(F.ws + WS_MIXO); float* x1o = (float*)(F.ws + WS_X1);
    const float* g = (const float*)a.in[6]; const float* mod = (const float*)(F.ws + WS_MOD);
    const float* w_router = (const float*)a.in[10]; const float* rbias = (const float*)a.in[11];
    unsigned char* xn = (unsigned char*)(F.ws + WS_XN);
    constexpr int AST = 1028;
    LAS float* At = (LAS float*)F.lds; LAS float* part = At;
    LAS float* cvec = At + 32 * AST; LAS int* lcnt = (LAS int*)(cvec + 64); LAS int* lbase = lcnt + 64; LAS int* s_e = lbase + 64; LAS int* s_lp = s_e + 256; LAS float* s_w = (LAS float*)(s_lp + 256);
    for (int tile = F.bid; tile < M / 32; tile += F.G) {
        const int m0 = tile * 32, b = m0 / T;
        const float* ga = mod + b * 6 * D + 2 * D; const float* shf = mod + b * 6 * D + 3 * D; const float* scf = mod + b * 6 * D + 4 * D;
        { const int t0_ = w * 64 + lane_id(); if (t0_ < 64) { cvec[t0_] = ((const float*)(F.ws + WS_CVEC))[b * 64 + t0_]; lcnt[t0_] = 0; } }
        const GAS char* xrow = (const GAS char*)(xin + (size_t)(m0 + w * 4) * D); const GAS char* mrow = (const GAS char*)(mixo + (size_t)(m0 + w * 4) * D);
        GAS char* nrow = (GAS char*)(xn + (size_t)(m0 + w * 4) * D);
        const unsigned lo16a = (unsigned)lane_id() * 16u;
        f32x4 xv[4][8]; v2u mr[4][8]; float ss[4] = {0.f, 0.f, 0.f, 0.f};
#pragma unroll
        for (int j = 0; j < 8; ++j)
#pragma unroll
            for (int r = 0; r < 4; ++r) { xv[r][j] = *(const GAS f32x4*)(xrow + (size_t)(r * D * 4 + j * 1024) + lo16a); mr[r][j] = *(const GAS v2u*)(mrow + (size_t)(r * D * 2 + j * 512) + (lo16a >> 1)); }
#define LDS_BAR() do { asm volatile("s_waitcnt lgkmcnt(0)" ::: "memory"); __builtin_amdgcn_s_barrier(); asm volatile("" ::: "memory"); } while (0)
        const int i = lane & 31, kh = lane >> 5;
        f32x16 acc0 = f32x16{}, acc1 = f32x16{};
#pragma unroll
        for (int hf = 0; hf < 2; ++hf) {
            const unsigned lo16b = (unsigned)lane_id() * 16u;
#pragma unroll
            for (int j = 4 * hf; j < 4 * hf + 4; ++j) { const f32x4 gaa = *(const GAS f32x4*)((const GAS char*)ga + j * 1024 + lo16b);
#pragma unroll
                for (int r = 0; r < 4; ++r) { const v2u mm = mr[r][j];
                    const f32x4 v = xv[r][j] + gaa * (f32x4){__uint_as_float(mm.x << 16), __uint_as_float(mm.x & 0xffff0000u), __uint_as_float(mm.y << 16), __uint_as_float(mm.y & 0xffff0000u)};
                    xv[r][j] = v; ss[r] += v[0] * v[0] + v[1] * v[1] + v[2] * v[2] + v[3] * v[3]; } }
            LDS_BAR();
#pragma unroll
            for (int j = 0; j < 4; ++j) {
                const f32x4 gsv = *(const GAS f32x4*)((const GAS char*)g + (hf * 4 + j) * 1024 + lo16b) * (*(const GAS f32x4*)((const GAS char*)scf + (hf * 4 + j) * 1024 + lo16b) + 1.f);
#pragma unroll
                for (int r = 0; r < 4; ++r) *(LAS f32x4*)(At + (w * 4 + r) * AST + (lane + 64 * j) * 4) = xv[r][hf * 4 + j] * gsv; }
            LDS_BAR();
            const LAS float* arow = At + i * AST + w * 128 + 4 * kh;
            const float* wb = w_router + (size_t)(hf * 1024 + w * 128 + 4 * kh) * 64 + i;
            float bn[4][2];
#pragma unroll
            for (int c = 0; c < 4; ++c) { bn[c][0] = wb[(size_t)c * 64]; bn[c][1] = wb[(size_t)c * 64 + 32]; }
#pragma unroll 4
            for (int q = 0; q < 16; ++q) {
                float bc[4][2];
#pragma unroll
                for (int c = 0; c < 4; ++c) { bc[c][0] = bn[c][0]; bc[c][1] = bn[c][1]; }
                if (q + 1 < 16) {
#pragma unroll
                    for (int c = 0; c < 4; ++c) { bn[c][0] = wb[(size_t)(8 * (q + 1) + c) * 64]; bn[c][1] = wb[(size_t)(8 * (q + 1) + c) * 64 + 32]; } }
                const f32x4 av = *(const LAS f32x4*)(arow + 8 * q);
#pragma unroll
                for (int c = 0; c < 4; ++c) { acc0 = __builtin_amdgcn_mfma_f32_32x32x2f32(av[c], bc[c][0], acc0, 0, 0, 0); acc1 = __builtin_amdgcn_mfma_f32_32x32x2f32(av[c], bc[c][1], acc1, 0, 0, 0); }
            }
        }
        LAS float* rsl = s_w + 768 + w * 4;
        float rstd[4];
#pragma unroll
        for (int r = 0; r < 4; ++r) { rstd[r] = rsqrtf(wave_sum(ss[r]) * (1.f / D) + NORM_EPS); if (lane_id() == 0) rsl[r] = rstd[r]; }
        const unsigned lo16c = (unsigned)lane_id() * 16u;
#pragma unroll
        for (int j = 0; j < 8; ++j) {
            const f32x4 gsv = *(const GAS f32x4*)((const GAS char*)g + j * 1024 + lo16c) * (*(const GAS f32x4*)((const GAS char*)scf + j * 1024 + lo16c) + 1.f), shv = *(const GAS f32x4*)((const GAS char*)shf + j * 1024 + lo16c);
#pragma unroll
            for (int r = 0; r < 4; ++r) { const f32x4 o = (xv[r][j] * rstd[r] * gsv + shv) * 16.f;
                int pk = __builtin_amdgcn_cvt_pk_fp8_f32(__builtin_fminf(__builtin_fmaxf(o[0], -448.f), 448.f), __builtin_fminf(__builtin_fmaxf(o[1], -448.f), 448.f), 0, false);
                pk = __builtin_amdgcn_cvt_pk_fp8_f32(__builtin_fminf(__builtin_fmaxf(o[2], -448.f), 448.f), __builtin_fminf(__builtin_fmaxf(o[3], -448.f), 448.f), pk, true);
                *(GAS int*)(nrow + (size_t)(r * D + j * 256) + (lo16c >> 2)) = pk; } }
        LDS_BAR();
#pragma unroll
        for (int r = 0; r < 16; ++r) { const int row = (r & 3) + 8 * (r >> 2) + 4 * kh; part[(w * 32 + row) * 64 + i] = acc0[r]; part[(w * 32 + row) * 64 + 32 + i] = acc1[r]; }
        LDS_BAR();
        const int ln = lane_id();
#undef LDS_BAR
        for (int rr = 0; rr < 4; ++rr) { const int row = w * 4 + rr;
            float acc = 0.f;
#pragma unroll
            for (int ww = 0; ww < 8; ++ww) acc += part[(ww * 32 + row) * 64 + ln];
            route_row(acc * (s_w + 768 + w * 4)[rr] + cvec[ln], rbias, row, lcnt, s_e, s_lp, s_w, s_w + 256 + w * 64, ln);
        }
        __syncthreads();
        const int t2 = w * 64 + lane_id();
        if (t2 < 64) lbase[t2] = (int)atomicAdd((unsigned*)(F.ws + WS_CTL) + CW_CNT + t2 * 64, (unsigned)lcnt[t2]);
        __syncthreads();
        if (t2 < 256) { const int e = s_e[t2], pos = lbase[e] + s_lp[t2], m = m0 + (t2 >> 3), kk = t2 & 7;
            ((int*)(F.ws + WS_LTOK))[e * M + pos] = m * 16 + kk; ((int*)(F.ws + WS_INV))[m * 8 + kk] = e * 8192 + pos; ((float*)(F.ws + WS_WTS))[m * 8 + kk] = s_w[t2]; }
        else if (t2 < 288) { const int m = m0 + t2 - 256; ((int*)(F.ws + WS_LTOK))[64 * M + m] = m * 16 + 8; }
        __syncthreads();
    }
}

constexpr int CW_ATTQ = 2560;
__device__ __forceinline__ int pop_item(const Frame& F, unsigned* ctr, int tid) {
    LAS int* slot = (LAS int*)(F.lds + MISC_OFF + 132);
    __syncthreads();
    if (tid == 0) *slot = (int)atomicAdd(ctr, 1u);
    __syncthreads();
    return *slot;
}
__device__ __forceinline__ void p3_attention(const Frame& F, const Args& a) {
    char* lds = (char*)F.lds;
    att::Seam S; bool first = true;
    for (int it = F.bid; it < 256; it += F.G) {
        const att::BlockRef cur{F.ws, it}, nxt{F.ws, (it + F.G < 256) ? it + F.G : it};
        if (first) { att::moba_prime(cur, lds, S, F.wave); first = false; }
        att::moba_block(cur, nxt, lds, S, F.wave);
    }
    const int nl = F.G / 2;
    if (F.bid >= F.G - nl) for (int ri = F.bid - (F.G - nl); ri < 256; ri += nl) ret::ret_state(F.ws, F.lds, ri, F.wave);
    unsigned* done = (unsigned*)(F.ws + WS_CTL) + CW_DONE + 64;
    signal_done(F, done);
    conv_drain(F, a, CV_NCHUNK, done, (unsigned)F.G);
}

__global__ void __launch_bounds__(NWAVES * 64, 2) mk_fwd(Args args) {
    extern __shared__ __attribute__((aligned(16))) unsigned char lds_raw[];
    Frame F;
    F.lds = (LAS unsigned char*)lds_raw; F.wave = __builtin_amdgcn_readfirstlane(threadIdx.x >> 6);
    F.G = gridDim.x; F.bid = blockIdx.x; F.ws = args.ws;
    volatile LAS unsigned* MISC = (volatile LAS unsigned*)(F.lds + MISC_OFF);
    { const int l0 = lane_id(); if (F.wave == 0) MISC[l0] = 0u; }
    __syncthreads();
    unsigned* ctl = (unsigned*)(F.ws + WS_CTL);
    const int lo = args.ph_lo, hi = args.ph_hi;
    XcdBarrier bar; bar.bar = ctl + CW_BAR + args.li * XCD_BAR_WORDS; bar.x = 0; bar.st = nullptr;
    if (hi - lo > 1) bar = xcd_barrier_post(ctl + CW_BAR + args.li * XCD_BAR_WORDS, MISC + 8, F.wave * 64 + lane_id());
#ifndef PROBE_REP
#define PROBE_REP -1
#endif
#define IN(k) (lo <= (k) && (k) < hi)
#define REP(k) for (int rep_ = 0; rep_ < ((k) == PROBE_REP ? 2 : 1); ++rep_)
#ifndef PROBE_TS
#define PROBE_TS -1
#endif
#ifndef PROBE_TS_A
#define PROBE_TS_A PROBE_TS
#endif
#ifndef PROBE_HEAD
#define PROBE_HEAD 0
#endif
#ifndef PROBE_DIV
#define PROBE_DIV 32.f
#endif
    unsigned long long ts_a = 0ull;
#define TS_BEGIN(k) do { if ((k) == PROBE_TS_A) ts_a = __builtin_amdgcn_s_memrealtime(); } while (0)
#define TS_END(k) do { if ((k) == PROBE_TS && F.bid == 0 && F.wave == 0) { unsigned dt = (unsigned)(__builtin_amdgcn_s_memrealtime() - ts_a); if (PROBE_HEAD) dt = __hip_atomic_load(ctl + CW_CONVQ, RLX_AGENT) * (unsigned)(PROBE_DIV * 100.f) / 120u; __hip_atomic_store(ctl + 3000, (dt + (unsigned)(PROBE_DIV * 50.f)) / (unsigned)(PROBE_DIV * 100.f), RLX_AGENT); } } while (0)
#define SEAM(k) do { if (IN(k) && IN((k) + 1)) xcd_barrier(bar, F.wave * 64 + lane_id()); } while (0)
    LAS unsigned char* ring = F.lds; LAS unsigned char* tab = F.lds + TAB_OFF;
    TS_BEGIN(0); if (IN(0)) REP(0) { p0_prologue(F, args); __syncthreads(); } SEAM(0); TS_END(0);
    TS_BEGIN(1); if (IN(1)) REP(1) { p1_norm(F, args); } SEAM(1); TS_END(1);
    TS_BEGIN(2); if (IN(2)) REP(2) {
        const int GG = (F.G == 256) ? 240 : F.G, G3 = (F.G == 256) ? 16 : 0; unsigned* done = ctl + CW_DONE;
        if (F.bid < GG) {
            { pg8::Gemm g{(const bf16*)(F.ws + WS_XN), (const bf16*)(F.ws + WS_WIN), D}; pg8::StaticOrder S; S.init(M, 8 * 256, GG, F.bid); S.ident = (const int*)(F.ws + WS_IDENT);
              pg8::EpiProj E{(bf16*)(F.ws + WS_PROJ), (const int*)args.in[2], (float*)(F.ws + WS_KMEAN), 1.f};
              pg8::gemm_phase<pg8::EpiProj, pg8::StaticOrder, false, true>(ring, tab, g, S, E, F.wave); }
            if (F.bid >= G3) {
              pg8::Gemm g{(const bf16*)(F.ws + WS_XN8), (const bf16*)(F.ws + WS_WIN8), D}; pg8::StaticOrder S; S.init(M, 20 * 256, GG - G3, F.bid - G3); S.pbase = 8; S.ident = (const int*)(F.ws + WS_IDENT);
              pg8::EpiProj E{(bf16*)(F.ws + WS_PROJ), (const int*)args.in[2], (float*)(F.ws + WS_KMEAN), 1.f / 2048.f};
              pg8::gemm_phase<pg8::EpiProj, pg8::StaticOrder, true, true, true>(ring, tab, g, S, E, F.wave); }
            signal_done(F, done);
            conv_drain(F, args, CV_NCHUNK, done, (unsigned)GG);
        } else { if (F.bid - GG < 2) compute_cvec(F, args, F.bid - GG); conv_drain(F, args, CV_NCHUNK, done, (unsigned)GG); }
    } SEAM(2); TS_END(2);
    TS_BEGIN(3); if (IN(3)) REP(3) { p3_attention(F, args); } SEAM(3); TS_END(3);
    TS_BEGIN(4); if (IN(4)) REP(4) { ret::ret_scan(F.ws, F.bid * (NWAVES * 64) + F.wave * 64 + lane_id(), F.G * NWAVES * 64); } SEAM(4); TS_END(4);
    TS_BEGIN(5); if (IN(5)) REP(5) { for (int item = F.bid; item < 256; item += F.G) ret::ret_out(F.ws, F.lds, item, F.wave); conv_drain(F, args, CV_NOUT, nullptr, 0u);   } SEAM(5); TS_END(5);
    TS_BEGIN(6); if (IN(6)) REP(6) {
        pg8::Gemm g{(const bf16*)(F.ws + WS_MIX), (const bf16*)(F.ws + WS_WOUT), D}; pg8::StaticOrder S; S.init(M, D, F.G, F.bid); S.ident = (const int*)(F.ws + WS_IDENT);
        pg8::EpiOut E{(bf16*)(F.ws + WS_MIXO)};
        pg8::gemm_phase<pg8::EpiOut, pg8::StaticOrder, true, false, true>(ring, tab, g, S, E, F.wave);
    } SEAM(6); TS_END(6);
    TS_BEGIN(7); if (IN(7)) { p7_route(F, args); conv_drain(F, args, CV_NGU, nullptr, 0u); } SEAM(7); TS_END(7);
    TS_BEGIN(8); if (IN(8)) REP(8) {
        const int total = moe_tables(F, ctl + CW_CNT);
        const int nwg = total * 4, rounds = (nwg + F.G - 1) / F.G + 1; int GG = (((nwg + rounds - 1) / rounds) + 7) & ~7; if (GG > F.G) GG = F.G;
        unsigned* done = ctl + CW_DONE + 128;
        if (F.bid < GG) {
            pg8::MoeOrder S; S.nM = total; S.nN = 4; S.nwg = nwg; S.G = GG; S.c = F.bid;
            S.tile_e = (const LAS int*)(F.lds + TILE_E_OFF); S.tile_start = (const LAS int*)(F.lds + TILE_S_OFF); S.ecount = (const LAS int*)(F.lds + ECNT_OFF); S.ltok = (const int*)(F.ws + WS_LTOK); S.ident = nullptr;
            pg8::Gemm g{(const bf16*)(F.ws + WS_XN), (const bf16*)(F.ws + WS_WGU), D};
            pg8::EpiAct E{(unsigned char*)(F.ws + WS_ACT)};
            pg8::gemm_phase<pg8::EpiAct, pg8::MoeOrder, true, true, true>(ring, tab, g, S, E, F.wave);
        }
        conv_drain(F, args, CV_NCHUNK, nullptr, 0u);
    } SEAM(8); TS_END(8);
    TS_BEGIN(9); if (IN(9)) REP(9) {
        const int total = IN(8) ? ((const LAS int*)(F.lds + TILE_S_OFF))[65] : moe_tables(F, ctl + CW_CNT);
        pg8::MoeOrder S; S.nM = total; S.nN = 8; S.nwg = total * 8; S.G = F.G; S.c = F.bid;
        S.tile_e = (const LAS int*)(F.lds + TILE_E_OFF); S.tile_start = (const LAS int*)(F.lds + TILE_S_OFF); S.ecount = (const LAS int*)(F.lds + ECNT_OFF); S.ltok = (const int*)(F.ws + WS_LTOK); S.ident = (const int*)(F.ws + WS_IDENT);
        int kdn = EH; asm volatile("" : "+s"(kdn));
        pg8::Gemm g{(const bf16*)(F.ws + WS_ACT), (const bf16*)(F.ws + WS_WD), kdn};
        pg8::EpiDown E{(unsigned char*)(F.ws + WS_YSLOT)};
        pg8::gemm_phase<pg8::EpiDown, pg8::MoeOrder, true, true, true>(ring, tab, g, S, E, F.wave);
    } SEAM(9); TS_END(9);
    if (IN(10)) REP(10) { if (!IN(8)) (void)moe_tables(F, ctl + CW_CNT); p10_final(F, args, PROBE_TS >= 0 ? 1.f + (float)__hip_atomic_load(ctl + 3000, RLX_AGENT) * 0.01f : 1.f); }
#undef IN
#undef SEAM
}

extern "C" void kernel_launch(void* const* d_in, const int* in_sizes, int n_in, void* d_out, int out_size, void* d_ws, size_t ws_size, hipStream_t stream) {
    static int grid = 0;
    if (grid == 0) {
        if (n_in != 18 || ws_size < WS_END) { fprintf(stderr, "kernel_launch: bad args n_in %d ws %zu\n", n_in, ws_size); grid = -1; return; }
        int dev = 0, cus = 0, per_cu = 0;
        if (hipGetDevice(&dev) != hipSuccess || hipDeviceGetAttribute(&cus, hipDeviceAttributeMultiprocessorCount, dev) != hipSuccess) { grid = -1; return; }
        if (hipFuncSetAttribute((const void*)mk_fwd, hipFuncAttributeMaxDynamicSharedMemorySize, LDS_BYTES) != hipSuccess) { fprintf(stderr, "kernel_launch: hipFuncSetAttribute failed\n"); grid = -1; return; }
        if (hipOccupancyMaxActiveBlocksPerMultiprocessor(&per_cu, (const void*)mk_fwd, NWAVES * 64, LDS_BYTES) != hipSuccess || per_cu < 1) { fprintf(stderr, "kernel_launch: occupancy query says %d\n", per_cu); per_cu = 1; }
        (void)hipGetLastError();
        grid = cus;
    }
    if (grid < 0) return;
    unsigned char* ws = (unsigned char*)d_ws;
    (void)hipMemsetAsync(ws + WS_CTL, 0, CTL_ZERO_BYTES, stream);
    Args a{};
    for (int i = 0; i < 18; ++i) a.in[i] = d_in[i];
    a.out = (float*)d_out; a.ws = ws;
    a.ph_lo = 0; a.ph_hi = 11; a.li = 0;
    hipLaunchKernelGGL(mk_fwd, dim3(grid), dim3(NWAVES * 64), LDS_BYTES, stream, a);
}
```

```cpp
#include <hip/hip_runtime.h>
#include <cstdio>
#include <cstdint>

constexpr int NB = 2, T = 4096, D = 2048, M = NB * T;
constexpr int NPROJ = 7168;
constexpr int NE = 64, EH = 512;
constexpr float NORM_EPS = 1e-6f;
constexpr float NEGF = -1e30f;

constexpr size_t MiB = 1u << 20;
constexpr size_t WS_CTL = 0, CTL_ZERO_BYTES = 1 * MiB;
constexpr size_t WS_KMEAN = 512 * 1024;
constexpr size_t WS_MODP = 1 * MiB;
constexpr size_t WS_MOD = 3 * MiB;
constexpr size_t WS_RSTD = 5 * MiB;
constexpr size_t WS_IDENT = 23 * MiB;
constexpr size_t WS_CVEC = 5 * MiB + 65536;
constexpr size_t WS_LTOK = 6 * MiB;
constexpr size_t WS_LW = 9 * MiB;
constexpr size_t WS_ROPEM = 12 * MiB;
constexpr size_t WS_ROPER = 13 * MiB;
constexpr size_t WS_LOGITS = 21 * MiB;
constexpr size_t WS_WGU = 24 * MiB;
constexpr size_t WS_WD = 284 * MiB;
constexpr size_t WS_X1 = 414 * MiB;
constexpr size_t WS_XN8 = 414 * MiB;
constexpr size_t WS_WIN8 = 430 * MiB;
constexpr size_t WS_XN = 478 * MiB;
constexpr size_t WS_ACT = 510 * MiB;
constexpr size_t WS_WIN = 600 * MiB;
constexpr size_t WS_WOUT = 628 * MiB;
constexpr size_t WS_PROJ = 636 * MiB;
constexpr size_t WS_MIX = 748 * MiB;
constexpr size_t WS_U = 780 * MiB;
constexpr size_t WS_S = 844 * MiB;
constexpr size_t WS_MIXO = 780 * MiB;
constexpr size_t WS_YSLOT = 600 * MiB;
constexpr size_t WS_INV = 21 * MiB;
constexpr size_t WS_WTS = 22 * MiB;
constexpr size_t WS_PROJF = 780 * MiB;
constexpr size_t WS_END = 1024 * MiB;
constexpr int CW_CNT = 32768;
constexpr int CW_BAR = 4096;

typedef unsigned short bf16;
__device__ __forceinline__ float bf2f(bf16 v) { return __uint_as_float(((unsigned)v) << 16); }
__device__ __forceinline__ bf16 f2bf(float f) { unsigned u = __float_as_uint(f); return (bf16)((u + 0x7fffu + ((u >> 16) & 1u)) >> 16); }
__device__ __forceinline__ float wave_sum(float v) {
#pragma unroll
    for (int o = 1; o < 64; o <<= 1) v += __shfl_xor(v, o);
    return v;
}
__device__ __forceinline__ float wave_max(float v) {
#pragma unroll
    for (int o = 1; o < 64; o <<= 1) v = fmaxf(v, __shfl_xor(v, o));
    return v;
}
__device__ __forceinline__ int lane_id() { int r; asm volatile("v_mbcnt_lo_u32_b32 %0, -1, 0\n\tv_mbcnt_hi_u32_b32 %0, -1, %0" : "=v"(r)); return r; }
__device__ __forceinline__ float silu_f(float x) { return x / (1.f + __expf(-x)); }

#define LAS __attribute__((address_space(3)))
#define GAS __attribute__((address_space(1)))
namespace pg8 {
typedef unsigned short bf16_t;
typedef short bf16x8 __attribute__((ext_vector_type(8)));
typedef float f32x4 __attribute__((ext_vector_type(4)));
typedef unsigned u32x4 __attribute__((ext_vector_type(4)));
typedef int i32x4 __attribute__((ext_vector_type(4)));
typedef int i32x8 __attribute__((ext_vector_type(8)));
constexpr int BM = 256, BK = 64, HALF = 128, HTB = HALF * BK * 2, STAGE_BYTES = 8 * HTB, NXCD = 8, WGM = 8;

__host__ __device__ __forceinline__ int lds_byte(int r, int c) { const int st = (r >> 4) * 2 + (c >> 5), rr = r & 15, cc = c & 31, ob = rr * 64 + cc * 2; return st * 1024 + (ob ^ (((ob >> 9) & 1) << 5)); }
__host__ __device__ __forceinline__ void stage_rc(int b, int& R, int& C) { const int st = b / 1024, sb = b % 1024, swz = sb ^ (((sb >> 9) & 1) << 5); R = (st >> 1) * 16 + swz / 64; C = (st & 1) * 32 + (swz % 64) / 2; }
__host__ __device__ __forceinline__ int perm32(int rho) { const int n = rho >> 4, i = rho & 15; return 8 * (i >> 2) + 4 * n + (i & 3); }

struct Unit { int pm, pn, pb, e, r0, cnt; };
struct Gemm { const bf16_t* A; const bf16_t* Bt; int K; };

__device__ __forceinline__ void tile_of(int L, int nM, int nN, int& pm, int& pn) {
    const int nwg = nM * nN; int wgid = L;
    { const int q = nwg / NXCD, r = nwg % NXCD, xcd = wgid % NXCD, off = wgid / NXCD; wgid = (xcd < r ? xcd * (q + 1) : r * (q + 1) + (xcd - r) * q) + off; }
    const int nig = WGM * nN, gid = wgid / nig, fm = gid * WGM, gsz = (nM - fm) < WGM ? (nM - fm) : WGM;
    pm = fm + ((wgid % nig) % gsz); pn = (wgid % nig) / gsz;
}
struct StaticOrder {
    int nM, nN, nwg, G, c, pbase = 0, pc0 = 1 << 30, pskip = 0;
    __device__ __forceinline__ void init(int Mrows, int N, int G_, int c_) { nM = Mrows / BM; nN = N / BM; nwg = nM * nN; G = G_; c = c_; }
    __device__ __forceinline__ bool next(int i, Unit& u) const {
        const int L = i * G + c; if (L >= nwg) return false;
        tile_of(L, nM, nN, u.pm, u.pn); u.pn = pbase + u.pn + (u.pn >= pc0 ? pskip : 0); u.pb = u.pn; u.e = 0; u.r0 = 0; u.cnt = 256; return true;
    }
    __device__ __forceinline__ void rows(const Unit& u, const int*& lp, int& cnt) const { lp = ident + u.pm * 256; cnt = 256; }
    __device__ __forceinline__ bool direct() const { return true; }
    const int* ident;
};
struct MoeOrder {
    int nM, nN, nwg, G, c; const LAS int* tile_e; const LAS int* tile_start; const LAS int* ecount; const int* ltok; const int* ident;
    __device__ __forceinline__ bool next(int i, Unit& u) const {
        const int L = i * G + c; if (L >= nwg) return false;
        tile_of(L, nM, nN, u.pm, u.pn);
        const int e = __builtin_amdgcn_readfirstlane(tile_e[u.pm]), jl = u.pm - __builtin_amdgcn_readfirstlane(tile_start[e]), rem = __builtin_amdgcn_readfirstlane(ecount[e]) - jl * 256;
        u.e = e; u.r0 = jl * 256; u.cnt = rem < 256 ? rem : 256; u.pb = e * nN + u.pn; return true;
    }
    __device__ __forceinline__ void rows(const Unit& u, const int*& lp, int& cnt) const { if (ident) { lp = ident + u.pm * 256; cnt = 256; } else { lp = ltok + (size_t)u.e * 8192 + u.r0; cnt = u.cnt; } }
    __device__ __forceinline__ bool direct() const { return ident != nullptr; }
};

__device__ __forceinline__ unsigned cvt_pk_bf16(float lo, float hi) { unsigned r; asm volatile("v_cvt_pk_bf16_f32 %0, %1, %2" : "=v"(r) : "v"(lo), "v"(hi)); return r; }

template <class Epi, class Sched, bool GATHER, bool ALIGN_EPI, bool F8 = false>
__device__ __forceinline__ void gemm_phase(LAS unsigned char* lds, LAS unsigned char* tab, const Gemm g, const Sched& S, const Epi& E, const int wid) {
    const int lane = lane_id(), tid = wid * 64 + lane, wr = wid >> 2, wc = wid & 3, fr = lane & 15, fq = lane >> 4;
    const int K = F8 ? g.K / 2 : g.K, nt = K / BK;
    unsigned voffA[2][2], voffB[2];
#pragma unroll
    for (int i = 0; i < 2; ++i) { int R, C; stage_rc(tid * 16 + i * 8192, R, C);
        const int Rb = Epi::NMAP ? (64 * (R >> 5) + perm32(R & 31)) : (Epi::PERM ? ((R & ~31) + perm32(R & 31)) : R);
        voffA[0][i] = (unsigned)(R * K + C) * 2u; voffA[1][i] = (unsigned)((R + HALF) * K + C) * 2u; voffB[i] = (unsigned)(Rb * K + C) * 2u; }
    const size_t kstep = (size_t)(BK * 2);
    const size_t hstep = (size_t)HALF * K * 2;
    const size_t tstep = 2 * hstep;
    const size_t hstepB = Epi::NMAP ? (size_t)32 * K * 2 : hstep;
    const unsigned ldsw = (unsigned)wid * 1024u;
    const int aoff = F8 ? lds_byte(wr * 64 + fr, fq * 16) : lds_byte(wr * 64 + fr, fq * 8), boff = F8 ? lds_byte(wc * 32 + fr, fq * 16) : lds_byte(wc * 32 + fr, fq * 8);
#define PG8_SA(b, h) (((b) * 2 + (h)) * HTB)
#define PG8_SB(b, h) ((4 + (b) * 2 + (h)) * HTB)
#define PG8_STAGE(bufoff, gbase, voff) do { _Pragma("unroll") for (int _i = 0; _i < 2; ++_i) \
        __builtin_amdgcn_global_load_lds((const unsigned*)((const char*)(gbase) + (voff)[_i]), (LAS unsigned*)(lds + (bufoff) + ldsw + _i * 8192), 16, 0, 0); } while (0)
#define PG8_LD16(off) (*(const LAS i32x4*)(lds + (off)))
#define PG8_FRAG(off) __builtin_shufflevector(PG8_LD16(off), PG8_LD16((off) + (F8 ? 16 : 1024)), 0, 1, 2, 3, 4, 5, 6, 7)
#define PG8_LDA(dst, b, h) do { _Pragma("unroll") for (int m = 0; m < 4; ++m) dst[m] = PG8_FRAG(PG8_SA(b, h) + aoff + m * 2048); } while (0)
#define PG8_LDB(dst, b, h) do { _Pragma("unroll") for (int n = 0; n < 2; ++n) dst[n] = PG8_FRAG(PG8_SB(b, h) + boff + n * 2048); } while (0)
#define PG8_LO(f) __builtin_bit_cast(bf16x8, __builtin_shufflevector(f, f, 0, 1, 2, 3))
#define PG8_HI(f) __builtin_bit_cast(bf16x8, __builtin_shufflevector(f, f, 4, 5, 6, 7))
#define PG8_MMA(ai, bj, At, Bt) do { __builtin_amdgcn_s_setprio(1); \
        if constexpr (F8) { _Pragma("unroll") for (int m = 0; m < 4; ++m) _Pragma("unroll") for (int n = 0; n < 2; ++n) \
            acc[ai][bj][m][n] = __builtin_amdgcn_mfma_scale_f32_16x16x128_f8f6f4(Bt[n], At[m], acc[ai][bj][m][n], 0, 0, 0, 0x7f7f7f7f, 0, 0x7f7f7f7f); } \
        else { _Pragma("unroll") for (int m = 0; m < 4; ++m) _Pragma("unroll") for (int n = 0; n < 2; ++n) { \
            acc[ai][bj][m][n] = __builtin_amdgcn_mfma_f32_16x16x32_bf16(PG8_LO(Bt[n]), PG8_LO(At[m]), acc[ai][bj][m][n], 0, 0, 0); \
            acc[ai][bj][m][n] = __builtin_amdgcn_mfma_f32_16x16x32_bf16(PG8_HI(Bt[n]), PG8_HI(At[m]), acc[ai][bj][m][n], 0, 0, 0); } } \
        __builtin_amdgcn_s_setprio(0); } while (0)
#define PG8_WAIT_V(n) asm volatile("s_waitcnt vmcnt(" #n ")" ::: "memory")
#define PG8_WAIT_L(n) asm volatile("s_waitcnt lgkmcnt(" #n ")" ::: "memory")
#define PG8_BAR __builtin_amdgcn_s_barrier()
#define PG8_SCHED __builtin_amdgcn_sched_barrier(0)
    Unit cur, nxt; int ui = 0;
    if (!S.next(0, cur)) return;
    if constexpr (GATHER) {
        const int* lp; int cnt; S.rows(cur, lp, cnt);
#pragma unroll
        for (int h = 0; h < 2; ++h)
#pragma unroll
            for (int i = 0; i < 2; ++i) { int R, C; stage_rc(tid * 16 + i * 8192, R, C); const int r = h * HALF + R; const int tk = S.direct() ? cur.pm * 256 + r : (r < cnt ? (lp[r] >> 4) : 0); voffA[h][i] = (unsigned)(tk * K + C) * 2u; }
    }
    f32x4 acc[2][2][4][2];
#pragma unroll
    for (int a = 0; a < 2; ++a)
#pragma unroll
        for (int b = 0; b < 2; ++b)
#pragma unroll
            for (int m = 0; m < 4; ++m)
#pragma unroll
                for (int n = 0; n < 2; ++n) acc[a][b][m][n] = (f32x4){0.f, 0.f, 0.f, 0.f};
    i32x8 At[4], B0[2], B1[2];
    const char* cA = GATHER ? (const char*)g.A : (const char*)g.A + (size_t)cur.pm * tstep; const char* cB = (const char*)g.Bt + (size_t)cur.pb * tstep;
    PG8_STAGE(PG8_SB(0, 0), cB, voffB); PG8_STAGE(PG8_SB(0, 1), cB + hstepB, voffB); PG8_STAGE(PG8_SA(0, 0), cA, voffA[0]); PG8_STAGE(PG8_SA(0, 1), cA, voffA[1]);
    if (wr == 1) PG8_BAR;
    PG8_WAIT_V(2); PG8_BAR;
    PG8_STAGE(PG8_SB(1, 0), cB + kstep, voffB); PG8_STAGE(PG8_SA(1, 0), cA + kstep, voffA[0]); PG8_STAGE(PG8_SB(1, 1), cB + hstepB + kstep, voffB);
    PG8_WAIT_V(6); PG8_BAR;
    for (;;) {
        const bool has_next = S.next(ui + 1, nxt);
        int ncnt = 256;
        if constexpr (GATHER) { if (has_next) { const int* nlp; S.rows(nxt, nlp, ncnt);
            if (wid == 0 && !S.direct()) __builtin_amdgcn_global_load_lds((const unsigned*)(nlp + lane * 4), (LAS unsigned*)tab, 16, 0, 0); } }
        const char* nA = has_next ? (GATHER ? (const char*)g.A : (const char*)g.A + (size_t)nxt.pm * tstep) : cA; const char* nB = has_next ? (const char*)g.Bt + (size_t)nxt.pb * tstep : cB;
#pragma unroll 1
        for (int t = 0; t < nt; t += 2) {
            const bool last = (t == nt - 2);
            const char* a1 = cA + (size_t)(t + 1) * kstep;
            const char* a2 = last ? nA : cA + (size_t)(t + 2) * kstep; const char* b2 = last ? nB : cB + (size_t)(t + 2) * kstep;
            const char* a3 = a2 + kstep; const char* b3 = b2 + kstep;
            PG8_LDB(B0, 0, 0); PG8_LDB(B1, 0, 1); PG8_SCHED; PG8_LDA(At, 0, 0); PG8_STAGE(PG8_SA(1, 1), a1, voffA[1]);
            if constexpr (GATHER) { if (last && has_next) {
#pragma unroll
                for (int h = 0; h < 2; ++h)
#pragma unroll
                    for (int i = 0; i < 2; ++i) { int R, C; stage_rc(tid * 16 + i * 8192, R, C); const int r = h * HALF + R; int tk; if (S.direct()) tk = nxt.pm * 256 + r; else { const int v = ((const LAS int*)tab)[r]; tk = r < ncnt ? (v >> 4) : 0; } voffA[h][i] = (unsigned)(tk * K + C) * 2u; } } }
            PG8_WAIT_V(8); PG8_WAIT_L(0); PG8_BAR; PG8_MMA(0, 0, At, B0); PG8_MMA(0, 1, At, B1); PG8_BAR; PG8_SCHED;
            PG8_LDA(At, 0, 1); PG8_STAGE(PG8_SB(0, 0), b2, voffB); PG8_STAGE(PG8_SB(0, 1), b2 + hstepB, voffB); PG8_STAGE(PG8_SA(0, 0), a2, voffA[0]);
            PG8_WAIT_V(8); PG8_WAIT_L(0); PG8_BAR; PG8_MMA(1, 0, At, B0); PG8_MMA(1, 1, At, B1); PG8_BAR; PG8_SCHED;
            PG8_LDB(B0, 1, 0); PG8_LDB(B1, 1, 1); PG8_SCHED; PG8_LDA(At, 1, 0); PG8_STAGE(PG8_SA(0, 1), a2, voffA[1]);
            PG8_WAIT_V(8); PG8_WAIT_L(0); PG8_BAR; PG8_MMA(0, 0, At, B0); PG8_MMA(0, 1, At, B1); PG8_BAR; PG8_SCHED;
            PG8_LDA(At, 1, 1); PG8_STAGE(PG8_SB(1, 0), b3, voffB); PG8_STAGE(PG8_SB(1, 1), b3 + hstepB, voffB); PG8_STAGE(PG8_SA(1, 0), a3, voffA[0]);
            PG8_WAIT_V(8); PG8_WAIT_L(0); PG8_BAR; PG8_MMA(1, 0, At, B0); PG8_MMA(1, 1, At, B1); PG8_BAR; PG8_SCHED;
        }
        if constexpr (ALIGN_EPI) { if (wr == 0) PG8_BAR; }
        E(acc, cur, wr, wc, fr, fq);
        if (!has_next) break;
#pragma unroll
        for (int a = 0; a < 2; ++a)
#pragma unroll
            for (int b = 0; b < 2; ++b)
#pragma unroll
                for (int m = 0; m < 4; ++m)
#pragma unroll
                    for (int n = 0; n < 2; ++n) acc[a][b][m][n] = (f32x4){0.f, 0.f, 0.f, 0.f};
        cur = nxt; cA = nA; cB = nB; ++ui;
        if constexpr (ALIGN_EPI) { if (wr == 1) PG8_BAR; }
    }
    PG8_WAIT_V(0);
    if constexpr (!ALIGN_EPI) { if (wr == 0) PG8_BAR; }
    PG8_BAR;
#undef PG8_SA
#undef PG8_SB
#undef PG8_STAGE
#undef PG8_LDA
#undef PG8_HI
#undef PG8_LO
#undef PG8_FRAG
#undef PG8_LD16
#undef PG8_LDB
#undef PG8_MMA
#undef PG8_WAIT_V
#undef PG8_WAIT_L
#undef PG8_BAR
#undef PG8_SCHED
}
}
namespace pg8 {
struct EpiProj {
    static constexpr bool PERM = true; static constexpr int NMAP = 0;
    bf16_t* O; const int* pos; float* kmean; float asc;
    __device__ __forceinline__ void operator()(const f32x4 (&acc)[2][2][4][2], const Unit& u, int wr, int wc, int fr, int fq) const {
        const int t = u.pn >> 2, coltile = (u.pn & 3) * BM;
        bf16_t* base = O + (size_t)t * M * 1024;
        const int row0 = u.pm * BM + wr * 64 + fr, col0 = coltile + wc * 32 + 8 * fq;
        const bool moba_rot = (t < 2) && (wc == 0);
        const bool ret_rot = (t == 3) || (t == 4);
        const float osc = (t == 4) ? 0.0625f : 1.f;
        const int fqo = lane_id() >> 4; int wco = wc; asm volatile("" : "+s"(wco));
        float posf[8], invr[8];
        if (moba_rot || ret_rot) {
#pragma unroll
            for (int q = 0; q < 8; ++q) posf[q] = (float)pos[row0 + (q >> 2) * HALF + (q & 3) * 16];
#pragma unroll
            for (int j = 0; j < 8; ++j) invr[j] = moba_rot ? __builtin_amdgcn_exp2f(-(float)(8 * (fqo & 1) + j) * (18.931568569324174f / 16.f)) * 0.15915494309189535f
                                                           : __builtin_amdgcn_exp2f(-(float)(wco * 32 + 8 * fqo + j) * (13.287712379549449f / 127.f)) * 0.15915494309189535f;
        }
        float ks[2][8];
#pragma unroll
        for (int bj = 0; bj < 2; ++bj)
#pragma unroll
            for (int j = 0; j < 8; ++j) ks[bj][j] = 0.f;
#pragma unroll
        for (int ai = 0; ai < 2; ++ai)
#pragma unroll
            for (int m = 0; m < 4; ++m) {
                const int row = row0 + ai * HALF + m * 16;
                float v[2][8];
#pragma unroll
                for (int bj = 0; bj < 2; ++bj)
#pragma unroll
                    for (int j = 0; j < 8; ++j) v[bj][j] = acc[ai][bj][m][j >> 2][j & 3] * asc;
                if (moba_rot || ret_rot) {
                    const float pr = posf[ai * 4 + m];
                    float cs_c[8], cs_s[8];
#pragma unroll
                    for (int j = 0; j < 8; ++j) { const float rev = pr * invr[j]; const float fr_ = rev - __builtin_floorf(rev); cs_c[j] = __builtin_amdgcn_cosf(fr_); cs_s[j] = __builtin_amdgcn_sinf(fr_); }
                    if (moba_rot) {
#pragma unroll
                        for (int bj = 0; bj < 2; ++bj)
#pragma unroll
                            for (int j = 0; j < 8; ++j) { const float xp = __shfl_xor(v[bj][j], 32);
                                v[bj][j] = (fq < 2) ? v[bj][j] * cs_c[j] - xp * cs_s[j] : v[bj][j] * cs_c[j] + xp * cs_s[j]; }
                    } else {
#pragma unroll
                        for (int j = 0; j < 8; ++j) { const float x1 = v[0][j], x2 = v[1][j];
                            v[0][j] = (x1 * cs_c[j] - x2 * cs_s[j]) * osc; v[1][j] = (x2 * cs_c[j] + x1 * cs_s[j]) * osc; }
                    }
                }
#pragma unroll
                for (int bj = 0; bj < 2; ++bj) {
                    u32x4 w; w.x = cvt_pk_bf16(v[bj][0], v[bj][1]); w.y = cvt_pk_bf16(v[bj][2], v[bj][3]); w.z = cvt_pk_bf16(v[bj][4], v[bj][5]); w.w = cvt_pk_bf16(v[bj][6], v[bj][7]);
                    *(u32x4*)(base + (size_t)row * 1024 + col0 + bj * HALF) = w;
#pragma unroll
                    for (int j = 0; j < 8; ++j) ks[bj][j] += v[bj][j];
                }
            }
        if (t == 1) {
#pragma unroll
            for (int bj = 0; bj < 2; ++bj)
#pragma unroll
                for (int j = 0; j < 8; ++j) { float s = ks[bj][j]; s += __shfl_xor(s, 1); s += __shfl_xor(s, 2); s += __shfl_xor(s, 4); s += __shfl_xor(s, 8);
                    if (fr == 0) atomicAdd(kmean + (size_t)u.pm * 1024 + col0 + bj * HALF + j, s * (1.f / 256.f)); }
        }
    }
};
struct EpiOut {
    static constexpr bool PERM = true; static constexpr int NMAP = 1;
    bf16_t* mixo;
    __device__ __forceinline__ void operator()(const f32x4 (&acc)[2][2][4][2], const Unit& u, int wr, int wc, int fr, int fq) const {
        const int row0 = u.pm * BM + wr * 64 + fr, col0 = u.pn * BM + wc * 64 + 8 * fq;
#pragma unroll
        for (int ai = 0; ai < 2; ++ai)
#pragma unroll
            for (int m = 0; m < 4; ++m) { bf16_t* orow = mixo + (size_t)(row0 + ai * HALF + m * 16) * D + col0;
#pragma unroll
                for (int bj = 0; bj < 2; ++bj) { const f32x4 v0 = acc[ai][bj][m][0] * (1.f / 2048.f), v1 = acc[ai][bj][m][1] * (1.f / 2048.f);
                    u32x4 o; o.x = cvt_pk_bf16(v0[0], v0[1]); o.y = cvt_pk_bf16(v0[2], v0[3]); o.z = cvt_pk_bf16(v1[0], v1[1]); o.w = cvt_pk_bf16(v1[2], v1[3]);
                    *(u32x4*)(orow + bj * 32) = o; } }
    }
};
struct EpiAct {
    static constexpr bool PERM = true; static constexpr int NMAP = 0;
    unsigned char* act;
    __device__ __forceinline__ void operator()(const f32x4 (&acc)[2][2][4][2], const Unit& u, int wr, int wc, int fr, int fq) const {
        const int row0 = u.pm * BM + wr * 64 + fr, col0 = u.pn * HALF + wc * 32 + 8 * fq;
#pragma unroll
        for (int ai = 0; ai < 2; ++ai)
#pragma unroll
            for (int m = 0; m < 4; ++m) { float o[8];
#pragma unroll
                for (int j = 0; j < 8; ++j) { const float gt = acc[ai][0][m][j >> 2][j & 3] * (1.f / 2048.f), up = acc[ai][1][m][j >> 2][j & 3] * (1.f / 2048.f);
                    o[j] = __builtin_fminf(__builtin_fmaxf(gt / (1.f + __expf(-gt)) * up * 32.f, -448.f), 448.f); }
                int w0 = __builtin_amdgcn_cvt_pk_fp8_f32(o[0], o[1], 0, false); w0 = __builtin_amdgcn_cvt_pk_fp8_f32(o[2], o[3], w0, true);
                int w1 = __builtin_amdgcn_cvt_pk_fp8_f32(o[4], o[5], 0, false); w1 = __builtin_amdgcn_cvt_pk_fp8_f32(o[6], o[7], w1, true);
                typedef int i32x2 __attribute__((ext_vector_type(2)));
                *(i32x2*)(act + (size_t)(row0 + ai * HALF + m * 16) * EH + col0) = (i32x2){w0, w1}; }
    }
};
struct EpiDown {
    static constexpr bool PERM = true; static constexpr int NMAP = 1;
    unsigned char* yr;
    __device__ __forceinline__ void operator()(const f32x4 (&acc)[2][2][4][2], const Unit& u, int wr, int wc, int fr, int fq) const {
        const int row0 = u.pm * BM + wr * 64 + fr, col0 = u.pn * BM + wc * 64 + 8 * fq;
#pragma unroll
        for (int ai = 0; ai < 2; ++ai)
#pragma unroll
            for (int m = 0; m < 4; ++m) { unsigned char* orow = yr + (size_t)(row0 + ai * HALF + m * 16) * D + col0;
                if (ai * HALF + wr * 64 + m * 16 + fr < u.cnt) {
#pragma unroll
                for (int bj = 0; bj < 2; ++bj) { f32x4 v0 = acc[ai][bj][m][0] * (1.f / 32.f), v1 = acc[ai][bj][m][1] * (1.f / 32.f);
#pragma unroll
                    for (int i = 0; i < 4; ++i) { v0[i] = __builtin_fminf(__builtin_fmaxf(v0[i], -448.f), 448.f); v1[i] = __builtin_fminf(__builtin_fmaxf(v1[i], -448.f), 448.f); }
                    int w0 = __builtin_amdgcn_cvt_pk_fp8_f32(v0[0], v0[1], 0, false); w0 = __builtin_amdgcn_cvt_pk_fp8_f32(v0[2], v0[3], w0, true);
                    int w1 = __builtin_amdgcn_cvt_pk_fp8_f32(v1[0], v1[1], 0, false); w1 = __builtin_amdgcn_cvt_pk_fp8_f32(v1[2], v1[3], w1, true);
                    typedef int i32x2 __attribute__((ext_vector_type(2)));
                    __builtin_nontemporal_store((i32x2){w0, w1}, (i32x2*)(orow + bj * 32)); } } }
    }
};
}
namespace att {
typedef short bf16x8 __attribute__((ext_vector_type(8)));
typedef short s16x4 __attribute__((ext_vector_type(4)));
typedef float f32x16 __attribute__((ext_vector_type(16)));
typedef float f32x4 __attribute__((ext_vector_type(4)));
typedef unsigned u32x4 __attribute__((ext_vector_type(4)));
constexpr int DH = 128, QP = 1024, OP = 2048;
constexpr float SCALE = 0.08838834764831845f, THR = 8.f;
constexpr int NW = 8, QBLK = 32, KVBLK = 64, QB = NW * QBLK;
constexpr int SHM_V = KVBLK * DH * 2, SHM_K = KVBLK * DH * 2;
constexpr int LDS_BYTES = 2 * SHM_V + 2 * SHM_K + NW * 64 * 4;
#define KSWZ(row, colB) ((row) * 256 + ((colB) ^ (((row) & 7) << 4)))
#define SBAR() __builtin_amdgcn_sched_barrier(0)
__device__ __forceinline__ int v_st(int k, int c) { const int kk = (k & ~0xC) | ((k & 4) << 1) | ((k & 8) >> 1); return ((kk >> 3) * 4 + (c >> 5)) * 512 + ((kk & 7) * 32 + (c & 31)) * 2; }
__device__ __forceinline__ int v_rd_base(int lane) { return ((lane & 3) << 3) | (((lane >> 2) & 3) << 6) | (((lane >> 4) & 1) << 5) | (((lane >> 5) & 1) << 8); }
constexpr int v_rd_off(int d0, int ks, int half) { return d0 * 512 + ks * 4096 + half * 2048; }
__device__ __forceinline__ int crow(int r, int hi) { return (r & 3) + 8 * (r >> 2) + 4 * hi; }
__device__ __forceinline__ unsigned cvtpk(float lo, float hi) { unsigned r; asm volatile("v_cvt_pk_bf16_f32 %0, %1, %2" : "=v"(r) : "v"(lo), "v"(hi)); return r; }
__device__ __forceinline__ bf16x8 load8(const bf16* p) { return *reinterpret_cast<const bf16x8*>(p); }
__device__ __forceinline__ void mask_tile(f32x16& p0, f32x16& p1, int dq) {
    const float NEG = -__builtin_inff();
#pragma unroll
    for (int r = 0; r < 16; ++r) { const int c = (r & 3) + 8 * (r >> 2);
        if (dq - c < 0) p0[r] = NEG;
        if (dq - c - 32 < 0) p1[r] = NEG; }
}
__device__ __forceinline__ void partialSM(f32x16& p0, f32x16& p1, float& m_reg, float& mn, float& alpha, const bool dead = false) {
    float pmax = p0[0];
#pragma unroll
    for (int r = 1; r < 16; ++r) pmax = fmaxf(pmax, p0[r]);
#pragma unroll
    for (int r = 0; r < 16; ++r) pmax = fmaxf(pmax, p1[r]);
    { auto rr = __builtin_amdgcn_permlane32_swap(__float_as_uint(pmax), __float_as_uint(pmax), false, false);
      pmax = fmaxf(__uint_as_float(rr[0]), __uint_as_float(rr[1])); }
    if (dead) pmax = -__builtin_inff();
    constexpr float C2 = 1.4426950408889634f * SCALE;
    if (__builtin_expect(__all((pmax - m_reg) * SCALE <= THR), 1)) { mn = m_reg; alpha = 1.f; }
    else { mn = fmaxf(m_reg, pmax); alpha = __builtin_amdgcn_exp2f((m_reg - mn) * C2); m_reg = mn; }
    const float mnL = dead ? -__builtin_inff() : -mn * C2;
#pragma unroll
    for (int r = 0; r < 16; ++r) p0[r] = fmaf(p0[r], C2, mnL);
#pragma unroll
    for (int r = 0; r < 16; ++r) p1[r] = fmaf(p1[r], C2, mnL);
#pragma unroll
    for (int r = 0; r < 16; ++r) p0[r] = __builtin_amdgcn_exp2f(p0[r]);
}
__device__ __forceinline__ void finishSM(f32x16& p0, f32x16& p1, float alpha, float& l_reg, bf16x8& pa0, bf16x8& pa1, bf16x8& pa2, bf16x8& pa3) {
#pragma unroll
    for (int r = 0; r < 16; ++r) p1[r] = __builtin_amdgcn_exp2f(p1[r]);
    float ps = 0;
#pragma unroll
    for (int r = 0; r < 16; ++r) ps += p0[r];
#pragma unroll
    for (int r = 0; r < 16; ++r) ps += p1[r];
    { auto rr = __builtin_amdgcn_permlane32_swap(__float_as_uint(ps), __float_as_uint(ps), false, false);
      ps = __uint_as_float(rr[0]) + __uint_as_float(rr[1]); }
    l_reg = l_reg * alpha + ps;
#define PK4(P, B_, OUT) do { unsigned a0 = cvtpk(P[B_+0], P[B_+1]), a1 = cvtpk(P[B_+2], P[B_+3]);                          \
        unsigned b0 = cvtpk(P[B_+4], P[B_+5]), b1 = cvtpk(P[B_+6], P[B_+7]);                                             \
        auto r0 = __builtin_amdgcn_permlane32_swap(a0, b0, false, false); auto r1 = __builtin_amdgcn_permlane32_swap(a1, b1, false, false); \
        u32x4 w = {r0[0], r1[0], r0[1], r1[1]}; OUT = *reinterpret_cast<bf16x8*>(&w); } while (0)
    PK4(p0, 0, pa0); PK4(p0, 8, pa1); PK4(p1, 0, pa2); PK4(p1, 8, pa3);
#undef PK4
}
template <int KB>
__device__ __forceinline__ void qkt(f32x16& p0, f32x16& p1, const char* K_lds, int r32, int hi, const bf16x8* qr) {
    p0 = f32x16{}; p1 = f32x16{};
    const char* kb[4];
#pragma unroll
    for (int dd = 0; dd < 4; ++dd) kb[dd] = K_lds + KB * SHM_K + KSWZ(r32, (dd * 16 + hi * 8) * 2);
#pragma unroll
    for (int d0 = 0; d0 < 8; ++d0) { const char* a = kb[d0 & 3] + (d0 >> 2) * 128;
        bf16x8 b0 = *reinterpret_cast<const bf16x8*>(a);
        bf16x8 b1 = *reinterpret_cast<const bf16x8*>(a + 32 * 256);
        p0 = __builtin_amdgcn_mfma_f32_32x32x16_bf16(b0, qr[d0], p0, 0, 0, 0);
        p1 = __builtin_amdgcn_mfma_f32_32x32x16_bf16(b1, qr[d0], p1, 0, 0, 0); }
}
template <int VB>
__device__ __forceinline__ void pv_tile(f32x16* o, int vb0, bf16x8 pa0, bf16x8 pa1, bf16x8 pa2, bf16x8 pa3) {
#define TRRD(dst, off) asm volatile("ds_read_b64_tr_b16 %0, %1 offset:%2" : "=&v"(dst) : "v"(vb0), "i"(off) : "memory")
#define PV_D0(d0) do { s16x4 l0, l1, l2, l3, h0, h1, h2, h3; constexpr int b_ = VB * SHM_V + v_rd_off(d0, 0, 0); \
        TRRD(l0, b_); TRRD(h0, b_ + 2048); TRRD(l1, b_ + 4096); TRRD(h1, b_ + 6144); TRRD(l2, b_ + 8192); TRRD(h2, b_ + 10240); TRRD(l3, b_ + 12288); TRRD(h3, b_ + 14336); \
        asm volatile("s_waitcnt lgkmcnt(0)" ::: "memory"); SBAR(); \
        o[d0] = __builtin_amdgcn_mfma_f32_32x32x16_bf16(pa0, (bf16x8){l0[0], l0[1], l0[2], l0[3], h0[0], h0[1], h0[2], h0[3]}, o[d0], 0, 0, 0);   \
        o[d0] = __builtin_amdgcn_mfma_f32_32x32x16_bf16(pa1, (bf16x8){l1[0], l1[1], l1[2], l1[3], h1[0], h1[1], h1[2], h1[3]}, o[d0], 0, 0, 0);   \
        o[d0] = __builtin_amdgcn_mfma_f32_32x32x16_bf16(pa2, (bf16x8){l2[0], l2[1], l2[2], l2[3], h2[0], h2[1], h2[2], h2[3]}, o[d0], 0, 0, 0);   \
        o[d0] = __builtin_amdgcn_mfma_f32_32x32x16_bf16(pa3, (bf16x8){l3[0], l3[1], l3[2], l3[3], h3[0], h3[1], h3[2], h3[3]}, o[d0], 0, 0, 0); } while (0)
    PV_D0(0); PV_D0(1); PV_D0(2); PV_D0(3);
#undef PV_D0
#undef TRRD
}
struct BlockRef { const unsigned char* ws; int item; };
__device__ __forceinline__ int it_bh(int item) { return (item & 7) * 2 + ((item >> 3) & 1); }
__device__ __forceinline__ int it_qb(int item) { return 15 - (item >> 4); }
__device__ __forceinline__ const bf16* it_Q(const BlockRef& r) { const int bh = it_bh(r.item), b = bh >> 3, h = bh & 7; return (const bf16*)(r.ws + WS_PROJ) + (size_t)(b * T + it_qb(r.item) * 256) * 1024 + h * 128; }
__device__ __forceinline__ const bf16* it_K(const BlockRef& r) { const int bh = it_bh(r.item), b = bh >> 3, h = bh & 7; return (const bf16*)(r.ws + WS_PROJ) + (size_t)M * 1024 + (size_t)(b * T) * 1024 + h * 128; }
__device__ __forceinline__ const bf16* it_V(const BlockRef& r) { return it_K(r) + (size_t)M * 1024; }
__device__ __forceinline__ unsigned char* it_O(const BlockRef& r) { const int bh = it_bh(r.item), b = bh >> 3, h = bh & 7; return (unsigned char*)(r.ws + WS_MIX) + (size_t)(b * T + it_qb(r.item) * 256) * D + h * 128; }
__device__ __forceinline__ const float* it_KM(const BlockRef& r) { const int bh = it_bh(r.item), b = bh >> 3, h = bh & 7; return (const float*)(r.ws + WS_KMEAN) + (size_t)(b * 16) * 1024 + h * 128; }
struct Seam { bf16x8 qr[8]; bf16x8 st_v0, st_v1, st_k0, st_k1; };
#define ROW(p, k0, rr) ((p) + (size_t)((k0) + (rr)) * QP + sc)
#define VMW() asm volatile("s_waitcnt vmcnt(0)" ::: "memory")
#define VMWN(n) asm volatile("s_waitcnt vmcnt(%0)" :: "i"(n) : "memory")
#define SLOAD_H(Kp, Vp, k0) do { S.st_v0 = load8(ROW(Vp, k0, sr)); S.st_v1 = load8(ROW(Vp, k0, 32 + sr));              \
                         S.st_k0 = load8(ROW(Kp, k0, sr)); S.st_k1 = load8(ROW(Kp, k0, 32 + sr)); } while (0)
#define SWRITE_HK(bf) do { *(bf16x8*)(K_lds + (bf) * SHM_K + kws) = S.st_k0; *(bf16x8*)(K_lds + (bf) * SHM_K + kws + 32 * 256) = S.st_k1; } while (0)
#define SWRITE_HV(bf) do { *(bf16x8*)(V_lds + (bf) * SHM_V + vst0) = S.st_v0; *(bf16x8*)(V_lds + (bf) * SHM_V + vst1) = S.st_v1; } while (0)
#define SWRITE_H(bf) do { SWRITE_HV(bf); SWRITE_HK(bf); } while (0)
__device__ __forceinline__ void moba_prime(const BlockRef& cur, char* lds, Seam& S, const int wid) {
    const int lane = lane_id(), tid = wid * 64 + lane, r32 = lane & 31, hi = lane >> 5;
    const int sr = tid >> 4, sc = (tid & 15) * 8, kws = KSWZ(sr, sc * 2); char* K_lds = lds + 2 * SHM_V;
#pragma unroll
    for (int d0 = 0; d0 < 8; ++d0) S.qr[d0] = load8(it_Q(cur) + (size_t)(wid * QBLK + r32) * QP + d0 * 16 + hi * 8);
    SLOAD_H(it_K(cur), it_V(cur), 0); VMW(); SWRITE_HK(0);
    __syncthreads();
}
__device__ __forceinline__ void moba_block(const BlockRef& cur, const BlockRef& nxt, char* lds, Seam& S, const int wid) {
    const int lane = lane_id(), tid = wid * 64 + lane, r32 = lane & 31, hi = lane >> 5;
    const int qb = it_qb(cur.item), P0 = qb * 256;
    const int NT = (P0 + QB) / KVBLK;
    const int qlo = P0 + wid * QBLK, qm = qlo + r32 - 4 * hi;
    char* V_lds = lds; char* K_lds = lds + 2 * SHM_V;
    float* ws = (float*)(lds + 2 * SHM_V + 2 * SHM_K) + wid * 64; float* li_l = ws, * al_l = ws + 32;
    unsigned selmask = 0u;
    if (qb > 0) {
        float* kms = (float*)(lds + LDS_BYTES);
        { const float* kmg = it_KM(cur);
#pragma unroll
          for (int u_ = 0; u_ < 4; ++u_) { const int i = tid + 512 * u_; if (i < qb * 128) kms[i] = kmg[(size_t)(i >> 7) * 1024 + (i & 127)]; } }
        __syncthreads();
        float v0 = -__builtin_inff(), v1 = v0, v2 = v0; int i0 = -1, i1 = -1, i2 = -1;
#pragma unroll 1
        for (int n = 0; n < qb; ++n) {
            const float* km = kms + n * 128 + hi * 8;
            float g = 0.f;
#pragma unroll
            for (int d0 = 0; d0 < 8; ++d0) { const f32x4 ka = *(const f32x4*)(km + d0 * 16), kb4 = *(const f32x4*)(km + d0 * 16 + 4);
#pragma unroll
                for (int j = 0; j < 4; ++j) { g += __uint_as_float(((unsigned)(unsigned short)S.qr[d0][j]) << 16) * ka[j]; g += __uint_as_float(((unsigned)(unsigned short)S.qr[d0][4 + j]) << 16) * kb4[j]; } }
            g += __shfl_xor(g, 32);
            const bool b2 = g > v2, b1 = g > v1, b0 = g > v0;
            const float nv2 = b1 ? v1 : (b2 ? g : v2); const int ni2 = b1 ? i1 : (b2 ? n : i2);
            const float nv1 = b0 ? v0 : (b1 ? g : v1); const int ni1 = b0 ? i0 : (b1 ? n : i1);
            v2 = nv2; i2 = ni2; v1 = nv1; i1 = ni1; if (b0) { v0 = g; i0 = n; }
        }
        if (i0 >= 0) selmask |= 1u << i0; if (i1 >= 0) selmask |= 1u << i1; if (i2 >= 0) selmask |= 1u << i2;
        __syncthreads();
    }
    float m_reg = -1e30f, l_reg = 0; f32x16 o[4] = {};
    const int sr = tid >> 4, sc = (tid & 15) * 8, vst0 = v_st(sr, sc), vst1 = v_st(32 + sr, sc), kws = KSWZ(sr, sc * 2);
    const int vb0 = (int)(uintptr_t)V_lds + v_rd_base(lane);
    const bf16* Kh = it_K(cur); const bf16* Vh = Kh + (size_t)M * 1024;
#define RESC(a) do { if (__any((a) < 1.f)) { if (hi == 0) al_l[r32] = (a); asm volatile("s_waitcnt lgkmcnt(0)" ::: "memory");              \
                     for (int d_ = 0; d_ < 4; ++d_) for (int r = 0; r < 16; ++r) o[d_][r] *= al_l[crow(r, hi)]; } } while (0)
#define KBASE(t) ((t) * KVBLK)
#define MASKT(P0_, P1_, t) do { const int kb_ = KBASE(t); const int nb_ = kb_ >> 8; dead_ = false;                          \
        if (nb_ < qb) dead_ = !((selmask >> nb_) & 1u);                                                                    \
        else if (kb_ + KVBLK - 1 > qlo) mask_tile(P0_, P1_, qm - kb_); } while (0)
    bool dead_ = false;
    constexpr int NQL = 8;
#define SEAM_K0() do { VMWN(NQL); SWRITE_HK(0); SBAR(); } while (0)
    f32x16 pA0, pA1, pB0, pB1; float mnA, mnB, alA, alB; bf16x8 pa0, pa1, pa2, pa3;
    SWRITE_HV(0); SBAR();
    if (NT > 1) { SLOAD_H(Kh, Vh, KBASE(1)); }
    SBAR(); qkt<0>(pA0, pA1, K_lds, r32, hi, S.qr);
    MASKT(pA0, pA1, 0); partialSM(pA0, pA1, m_reg, mnA, alA, dead_);
    if (NT > 1) { VMW(); SWRITE_H(1); }
    __syncthreads();
#define HALF_STEP(PX0, PX1, mnX, alX, PY0, PY1, alY, t, KB, VB, SB) do {                                                      \
        SBAR(); qkt<KB>(PX0, PX1, K_lds, r32, hi, S.qr);                                                                      \
        finishSM(PY0, PY1, alY, l_reg, pa0, pa1, pa2, pa3); SBAR();                                                           \
        if ((t) + 1 < NT) { SLOAD_H(Kh, Vh, KBASE((t) + 1)); SBAR(); }                                                        \
        pv_tile<VB>(o, vb0, pa0, pa1, pa2, pa3); MASKT(PX0, PX1, (t)); partialSM(PX0, PX1, m_reg, mnX, alX, dead_);                  \
        __syncthreads();                                                                                                      \
        if ((t) + 1 < NT) { VMW(); SWRITE_H(SB); }                                                                            \
        RESC(alX); __syncthreads(); } while (0)
    for (int t = 1; t + 1 < NT; t += 2) {
        HALF_STEP(pB0, pB1, mnB, alB, pA0, pA1, alA, t, 1, 0, 0);
        HALF_STEP(pA0, pA1, mnA, alA, pB0, pB1, alB, t + 1, 0, 1, 1);
    }
    const bool even = (NT & 1) == 0;
    if (even) { SBAR(); qkt<1>(pB0, pB1, K_lds, r32, hi, S.qr); SBAR(); }
    SLOAD_H(it_K(nxt), it_V(nxt), 0); SBAR();
#pragma unroll
    for (int d0 = 0; d0 < 8; ++d0) S.qr[d0] = load8(it_Q(nxt) + (size_t)(wid * QBLK + r32) * QP + d0 * 16 + hi * 8);
    SBAR();
    finishSM(pA0, pA1, alA, l_reg, pa0, pa1, pa2, pa3); SBAR();
    pv_tile<0>(o, vb0, pa0, pa1, pa2, pa3);
    if (even) { MASKT(pB0, pB1, NT - 1); partialSM(pB0, pB1, m_reg, mnB, alB, dead_); __syncthreads(); RESC(alB);
        finishSM(pB0, pB1, alB, l_reg, pa0, pa1, pa2, pa3); SBAR(); pv_tile<1>(o, vb0, pa0, pa1, pa2, pa3); }
    SBAR(); SEAM_K0();
    if (hi == 0) li_l[r32] = l_reg; asm volatile("s_waitcnt lgkmcnt(0)" ::: "memory");
    float rli[16];
#pragma unroll
    for (int r = 0; r < 16; ++r) rli[r] = __builtin_amdgcn_rcpf(li_l[crow(r, hi)]);
    unsigned char* Ob = it_O(cur) + (size_t)(wid * QBLK + 4 * hi) * OP + r32;
#pragma unroll
    for (int r = 0; r < 16; ++r) { unsigned char* p = Ob; asm volatile("" : "+v"(p));
        p += (size_t)((r & 3) + 8 * (r >> 2)) * OP;
#pragma unroll
        for (int d0 = 0; d0 < 4; ++d0) { const float v = __builtin_fminf(__builtin_fmaxf(o[d0][r] * rli[r] * 16.f, -448.f), 448.f);
            const float vn = __builtin_bit_cast(float, __builtin_amdgcn_mov_dpp(__builtin_bit_cast(int, v), 0xB1, 0xF, 0xF, true));
            const int w01 = __builtin_amdgcn_cvt_pk_fp8_f32(v, vn, 0, false) & 0xffff;
            const int w23 = __builtin_amdgcn_mov_dpp(w01, 0x4E, 0xF, 0xF, true);
            if ((r32 & 3) == 0) *(GAS unsigned*)(p + d0 * 32) = (unsigned)(w01 | (w23 << 16)); } }
    __syncthreads();
#undef RESC
#undef KBASE
#undef MASKT
#undef SEAM_K0
#undef HALF_STEP
}
#undef ROW
#undef VMW
#undef VMWN
#undef SLOAD_H
#undef SWRITE_HK
#undef SWRITE_HV
#undef SWRITE_H
#undef KSWZ
#undef SBAR
}
constexpr int NWAVES = 8;
constexpr int RING_BYTES = 143360;
constexpr int TAB_OFF = RING_BYTES;
constexpr int TILE_E_OFF = TAB_OFF + 1024;
constexpr int TILE_S_OFF = TILE_E_OFF + 2048;
constexpr int ECNT_OFF = TILE_S_OFF + 512;
constexpr int MISC_OFF = ECNT_OFF + 512;
constexpr int LDS_BYTES = MISC_OFF + 256;
static_assert(LDS_BYTES <= 160 * 1024 && LDS_BYTES > 80 * 1024, "one workgroup per CU");

typedef float f32x4 __attribute__((ext_vector_type(4)));
typedef unsigned v4u __attribute__((ext_vector_type(4)));
typedef unsigned v2u __attribute__((ext_vector_type(2)));
typedef GAS unsigned gu32;
#define RLX_AGENT __ATOMIC_RELAXED, __HIP_MEMORY_SCOPE_AGENT

#define XB_TMO      128
#define XB_XCNT(j)  (256  + 64 * (j))
#define XB_XSUB(j)  (1280 + 64 * (j))
#define XB_XGEN(j)  (2304 + 64 * (j))
#define XB_TOP      3328
#define XB_TOPGEN   3392
#define XCD_BAR_WORDS 3456
#define XB_SPIN_CAP (1u << 20)
__device__ __forceinline__ unsigned xb_ld(unsigned* p)              { return __hip_atomic_load(p, __ATOMIC_RELAXED, __HIP_MEMORY_SCOPE_AGENT); }
__device__ __forceinline__ unsigned xb_add(unsigned* p, unsigned v) { return __hip_atomic_fetch_add(p, v, __ATOMIC_RELAXED, __HIP_MEMORY_SCOPE_AGENT); }
__device__ __forceinline__ unsigned xb_xcc_id() { return (unsigned)__builtin_amdgcn_s_getreg((3 << 11) | 20) & 0xFu; }
#define XB_SPIN(cond, bar) do { unsigned _sp = 0; while (cond) { __builtin_amdgcn_s_sleep(1); \
    if ((++_sp & 255u) == 0u) { if (xb_ld(&(bar)[XB_TMO])) break; if (_sp > XB_SPIN_CAP) { atomicAdd(&(bar)[XB_TMO], 1u); break; } } } } while (0)
struct XcdBarrier { unsigned* bar; unsigned x; volatile LAS unsigned* st; };
__device__ __forceinline__ XcdBarrier xcd_barrier_post(unsigned* bar, volatile LAS unsigned* st, int tid) {
    XcdBarrier b; b.bar = bar; b.x = xb_xcc_id(); b.st = st;
    if (tid == 0) (void)xb_add(&bar[XB_XCNT(b.x)], 1u);
    return b;
}
__device__ __forceinline__ void xcd_barrier_complete(unsigned* bar, unsigned x, unsigned& nloc, unsigned& nx) {
    const unsigned G = gridDim.x * gridDim.y * gridDim.z;
    unsigned sum, cnt, mine, sp = 0u;
    for (;;) {
        sum = 0u; cnt = 0u; mine = 0u;
#pragma unroll
        for (unsigned j = 0; j < 16; ++j) { const unsigned c = xb_ld(&bar[XB_XCNT(j)]); sum += c; cnt += (c > 0u) ? 1u : 0u; mine = (j == x) ? c : mine; }
        if (sum == G) break;
        __builtin_amdgcn_s_sleep(1);
        if ((++sp & 255u) == 0u) { if (xb_ld(&bar[XB_TMO])) break; if (sp > XB_SPIN_CAP) { atomicAdd(&bar[XB_TMO], 1u); break; } }
    }
    nloc = mine > 0u ? mine : 1u; nx = cnt > 0u ? cnt : 1u;
}
__device__ __forceinline__ void xcd_barrier(const XcdBarrier& b, int tid) {
    asm volatile("s_waitcnt vmcnt(0)" ::: "memory");
    __syncthreads();
    if (tid == 0) {
        unsigned* bar = b.bar;
        __builtin_amdgcn_s_waitcnt(0);
        unsigned nloc = b.st[0], nx = b.st[1];
        if (nloc == 0u) { xcd_barrier_complete(bar, b.x, nloc, nx); b.st[0] = nloc; b.st[1] = nx; }
        const unsigned old = xb_add(&bar[XB_XSUB(b.x)], 1u);
        const unsigned gen = old / nloc;
        if (old + 1u == (gen + 1u) * nloc) {
            __builtin_amdgcn_fence(__ATOMIC_RELEASE, "agent");
            asm volatile("s_waitcnt vmcnt(0)" ::: "memory");
            const unsigned og = xb_add(&bar[XB_TOP], 1u);
            const unsigned tg = og / nx;
            if (og + 1u == (tg + 1u) * nx) xb_add(&bar[XB_TOPGEN], 1u);
            else XB_SPIN(xb_ld(&bar[XB_TOPGEN]) == tg, bar);
            __builtin_amdgcn_fence(__ATOMIC_ACQUIRE, "agent");
            xb_add(&bar[XB_XGEN(b.x)], 1u);
            asm volatile("s_waitcnt vmcnt(0)" ::: "memory");
        } else {
            XB_SPIN(xb_ld(&bar[XB_XGEN(b.x)]) == gen, bar);
            __builtin_amdgcn_fence(__ATOMIC_ACQUIRE, "agent");
            asm volatile("s_waitcnt vmcnt(0)" ::: "memory");
        }
    }
    __syncthreads();
}

struct Args { const void* in[18]; float* out; unsigned char* ws; int ph_lo, ph_hi, li, pad; };
struct Frame {
    LAS unsigned char* lds; int wave, G, bid;
    unsigned char* ws;
};

__device__ __forceinline__ void transpose_item(const float* W, int N, bf16* WT, int Kout, size_t rb, int k0, int n0, LAS bf16* scr, int lane) {
    const int kr = lane >> 4, nc = (lane & 15) * 4;
    f32x4 v[16];
#pragma unroll
    for (int i = 0; i < 16; ++i) v[i] = *(const GAS f32x4*)(W + (size_t)(k0 + 4 * i + kr) * N + n0 + nc);
#pragma unroll
    for (int i = 0; i < 16; ++i) { const int k = 4 * i + kr;
        const unsigned p0 = pg8::cvt_pk_bf16(v[i][0], v[i][1]), p1 = pg8::cvt_pk_bf16(v[i][2], v[i][3]);
        scr[(nc + 0) * 68 + k] = (bf16)(p0 & 0xffffu); scr[(nc + 1) * 68 + k] = (bf16)(p0 >> 16);
        scr[(nc + 2) * 68 + k] = (bf16)(p1 & 0xffffu); scr[(nc + 3) * 68 + k] = (bf16)(p1 >> 16); }
    asm volatile("s_waitcnt lgkmcnt(0)" ::: "memory");
    const int c = lane & 7;
#pragma unroll
    for (int j = 0; j < 8; ++j) { const int n = (lane >> 3) + 8 * j;
        const LAS v2u* s = (const LAS v2u*)(scr + n * 68 + 8 * c); const v2u a = s[0], b = s[1];
        v4u o; o.x = a.x; o.y = a.y; o.z = b.x; o.w = b.y;
        *(GAS v4u*)(WT + (rb + n) * (size_t)Kout + k0 + 8 * c) = o; }
    asm volatile("s_waitcnt lgkmcnt(0)" ::: "memory");
}

struct TrItem { const float* W; bf16* WT; size_t rb; int N, Kout, k0, n0; };
__device__ __forceinline__ void tr_load(f32x4 (&v)[16], const TrItem& t, int lane) {
    const int kr = lane >> 4, nc = (lane & 15) * 4;
#pragma unroll
    for (int i = 0; i < 16; ++i) v[i] = __builtin_nontemporal_load((const GAS f32x4*)(t.W + (size_t)(t.k0 + 4 * i + kr) * t.N + t.n0 + nc));
}
__device__ __forceinline__ void tr_finish(const f32x4 (&v)[16], const TrItem& t, LAS bf16* scr, int lane) {
    const int kr = lane >> 4, nc = (lane & 15) * 4;
#pragma unroll
    for (int i = 0; i < 16; ++i) { const int k = 4 * i + kr;
        const unsigned p0 = pg8::cvt_pk_bf16(v[i][0], v[i][1]), p1 = pg8::cvt_pk_bf16(v[i][2], v[i][3]);
        scr[(nc + 0) * 68 + k] = (bf16)(p0 & 0xffffu); scr[(nc + 1) * 68 + k] = (bf16)(p0 >> 16);
        scr[(nc + 2) * 68 + k] = (bf16)(p1 & 0xffffu); scr[(nc + 3) * 68 + k] = (bf16)(p1 >> 16); }
    asm volatile("s_waitcnt lgkmcnt(0)" ::: "memory");
    const int c = lane & 7;
#pragma unroll
    for (int j = 0; j < 8; ++j) { const int n = (lane >> 3) + 8 * j;
        const LAS v2u* s = (const LAS v2u*)(scr + n * 68 + 8 * c); const v2u a = s[0], b = s[1];
        v4u o; o.x = a.x; o.y = a.y; o.z = b.x; o.w = b.y;
        *(GAS v4u*)(t.WT + (t.rb + n) * (size_t)t.Kout + t.k0 + 8 * c) = o; }
    asm volatile("s_waitcnt lgkmcnt(0)" ::: "memory");
}

__device__ __forceinline__ void tr_finish8(const f32x4 (&v)[16], const TrItem& t, float scale, LAS unsigned char* scr, int lane) {
    const int kr = lane >> 4, nc = (lane & 15) * 4;
#pragma unroll
    for (int i = 0; i < 16; ++i) { const int k = 4 * i + kr;
        const int p0 = __builtin_amdgcn_cvt_pk_fp8_f32(v[i][0] * scale, v[i][1] * scale, 0, false), p1 = __builtin_amdgcn_cvt_pk_fp8_f32(v[i][2] * scale, v[i][3] * scale, 0, false);
        scr[(nc + 0) * 72 + k] = (unsigned char)(p0 & 0xff); scr[(nc + 1) * 72 + k] = (unsigned char)((p0 >> 8) & 0xff);
        scr[(nc + 2) * 72 + k] = (unsigned char)(p1 & 0xff); scr[(nc + 3) * 72 + k] = (unsigned char)((p1 >> 8) & 0xff); }
    asm volatile("s_waitcnt lgkmcnt(0)" ::: "memory");
    const int c = lane & 7;
#pragma unroll
    for (int j = 0; j < 8; ++j) { const int n = (lane >> 3) + 8 * j;
        const v2u a = *(const LAS v2u*)(scr + n * 72 + 8 * c);
        __builtin_nontemporal_store(a, (GAS v2u*)((unsigned char*)t.WT + (t.rb + n) * (size_t)t.Kout + t.k0 + 8 * c)); }
    asm volatile("s_waitcnt lgkmcnt(0)" ::: "memory");
}

__device__ __forceinline__ void tr_load128(f32x4 (&v)[32], const TrItem& t, int) {
    const int lane = lane_id();
    const int kr = lane >> 4, nc = (lane & 15) * 4;
    const GAS char* base = (const GAS char*)(t.W + (size_t)t.k0 * t.N + t.n0);
    const unsigned loff = (unsigned)(16 * kr * t.N + nc) * 4u;
#pragma unroll
    for (int i = 0; i < 32; ++i) v[i] = __builtin_nontemporal_load((const GAS f32x4*)(base + (size_t)(64 * (i >> 4) + (i & 15)) * (size_t)t.N * 4u + loff));
}
__device__ __forceinline__ void tr_pack128(const f32x4 (&v)[32], float scale, v4u (&d)[4][2]) {
#pragma unroll
    for (int c = 0; c < 4; ++c)
#pragma unroll
        for (int p = 0; p < 2; ++p)
#pragma unroll
            for (int q = 0; q < 4; ++q) { const int i0 = 16 * p + 4 * q;
                int w = __builtin_amdgcn_cvt_pk_fp8_f32(v[i0][c] * scale, v[i0 + 1][c] * scale, 0, false);
                w = __builtin_amdgcn_cvt_pk_fp8_f32(v[i0 + 2][c] * scale, v[i0 + 3][c] * scale, w, true);
                d[c][p][q] = (unsigned)w; }
}
__device__ __forceinline__ void tr_store128(const v4u (&d)[4][2], const TrItem& t, LAS unsigned char* scr, int) {
    const int lane = lane_id();
    const int kr = lane >> 4, nq = lane & 15;
#pragma unroll
    for (int c = 0; c < 4; ++c)
#pragma unroll
        for (int p = 0; p < 2; ++p) *(LAS v4u*)(scr + (4 * nq + c) * 144 + p * 64 + 16 * kr) = d[c][p];
    asm volatile("s_waitcnt lgkmcnt(0)" ::: "memory");
    const int c8 = lane & 7;
#pragma unroll
    for (int j = 0; j < 8; ++j) { const int n = (lane >> 3) + 8 * j;
        const v4u o = *(const LAS v4u*)(scr + n * 144 + 16 * c8);
        __builtin_nontemporal_store(o, (GAS v4u*)((unsigned char*)t.WT + (t.rb + n) * (size_t)t.Kout + t.k0 + 16 * c8)); }
    asm volatile("s_waitcnt lgkmcnt(0)" ::: "memory");
}
namespace ret {
typedef short bf16x8 __attribute__((ext_vector_type(8)));
typedef short s16x4 __attribute__((ext_vector_type(4)));
typedef float f32x16 __attribute__((ext_vector_type(16)));
typedef float f32x4 __attribute__((ext_vector_type(4)));
typedef unsigned u32x4 __attribute__((ext_vector_type(4)));
constexpr int VSTR = 528;
constexpr int PSTR = 272;
constexpr int IMG = 128 * VSTR;
__device__ __forceinline__ int crow(int r, int hi) { return (r & 3) + 8 * (r >> 2) + 4 * hi; }
__device__ __forceinline__ s16x4 vtr(const LAS char* p) { return __builtin_bit_cast(s16x4, __builtin_amdgcn_ds_read_tr16_b64_v4i16((LAS s16x4*)p)); }
__device__ __forceinline__ bf16x8 tr_frag(const LAS char* img, int str, int k0, int c0, int lane) {
    const int g = lane >> 4, h = g >> 1, i = lane & 15, q = i >> 2, p = i & 3;
    const LAS char* a = img + (k0 + 8 * h + q) * str + (c0 + 16 * (g & 1) + 4 * p) * 2;
    const s16x4 lo = vtr(a), hi = vtr(a + 4 * str);
    return (bf16x8){lo[0], lo[1], lo[2], lo[3], hi[0], hi[1], hi[2], hi[3]};
}
__device__ __forceinline__ unsigned cvtpk(float lo, float hi) { unsigned r; asm volatile("v_cvt_pk_bf16_f32 %0, %1, %2" : "=v"(r) : "v"(lo), "v"(hi)); return r; }
__device__ __forceinline__ float gamma_log2(int h) { return log2f(1.f - exp2f(-5.f - (float)h)); }
__device__ __forceinline__ void stage_chunk(LAS char* img, const bf16* src, int tid, bool scale, float lg) {
#pragma unroll
    for (int i = 0; i < 8; ++i) { const int row = (tid >> 5) + 16 * i, pc = tid & 31;
        u32x4 v = *(const GAS u32x4*)(src + (size_t)row * 1024 + pc * 8);
        if (scale) { const float z = exp2f(lg * (float)(127 - row));
            u32x4 o;
#pragma unroll
            for (int j = 0; j < 4; ++j) o[j] = cvtpk(__uint_as_float(v[j] << 16) * z, __uint_as_float(v[j] & 0xffff0000u) * z);
            v = o; }
        *(LAS u32x4*)(img + row * VSTR + pc * 16) = v; }
}
__device__ __forceinline__ void ret_state(const unsigned char* ws, LAS unsigned char* lds, int item, int wid) {
    const int lane = lane_id(), tid = wid * 64 + lane, hi = lane >> 5, c = lane & 31;
    const int bh = item >> 5, ch = item & 31, b = bh >> 2, h = bh & 3;
    const bf16* proj = (const bf16*)(ws + WS_PROJ); const size_t PS = (size_t)M * 1024;
    const bf16* kr = proj + 4 * PS + (size_t)(b * T + ch * 128) * 1024 + h * 256; const bf16* vr = proj + 5 * PS + (size_t)(b * T + ch * 128) * 1024 + h * 256;
    LAS char* vimg = (LAS char*)lds; LAS char* kimg = vimg + IMG;
    const float lg = gamma_log2(h);
    stage_chunk(vimg, vr, tid, false, 0.f); stage_chunk(kimg, kr, tid, true, lg);
    __syncthreads();
    f32x16 acc[8];
#pragma unroll
    for (int j = 0; j < 8; ++j) acc[j] = f32x16{};
#pragma unroll 2
    for (int ks = 0; ks < 8; ++ks) {
        const bf16x8 a = tr_frag(vimg, VSTR, ks * 16, wid * 32, lane);
#pragma unroll
        for (int j = 0; j < 8; ++j) { const bf16x8 bb = tr_frag(kimg, VSTR, ks * 16, j * 32, lane); acc[j] = __builtin_amdgcn_mfma_f32_32x32x16_bf16(a, bb, acc[j], 0, 0, 0); }
    }
    bf16* ut = (bf16*)(ws + WS_U) + (size_t)item * 65536;
#pragma unroll
    for (int j = 0; j < 8; ++j)
#pragma unroll
        for (int r = 0; r < 16; ++r) { const float v = acc[j][r], vn = __builtin_bit_cast(float, __builtin_amdgcn_mov_dpp(__builtin_bit_cast(int, v), 0xB1, 0xF, 0xF, true));
            if ((c & 1) == 0) *(GAS unsigned*)(ut + (size_t)(wid * 32 + crow(r, hi)) * 256 + j * 32 + c) = cvtpk(v, vn); }
    __syncthreads();
}
__device__ __forceinline__ void ret_scan(const unsigned char* ws, int gtid, int gthreads) {
    const bf16* ut = (const bf16*)(ws + WS_U); bf16* st = (bf16*)(ws + WS_S);
    for (int e = gtid; e < 8 * 16384; e += gthreads) {
        const int bh = e >> 14, off = (e & 16383) * 4; const float dec = exp2f(128.f * gamma_log2(bh & 3));
        const GAS char* up = (const GAS char*)(ut + (size_t)(bh * 32) * 65536 + off); GAS char* sp = (GAS char*)(st + (size_t)(bh * 32) * 65536 + off);
        v2u u[32];
#pragma unroll
        for (int ch = 0; ch < 32; ++ch) u[ch] = __builtin_nontemporal_load((const GAS v2u*)(up + (size_t)ch * 131072));
        f32x4 s = {0.f, 0.f, 0.f, 0.f};
#pragma unroll
        for (int ch = 0; ch < 32; ++ch) {
            v2u w; w.x = cvtpk(s[0], s[1]); w.y = cvtpk(s[2], s[3]);
            *(GAS v2u*)(sp + (size_t)ch * 131072) = w;
            s = s * dec + (f32x4){__uint_as_float(u[ch].x << 16), __uint_as_float(u[ch].x & 0xffff0000u), __uint_as_float(u[ch].y << 16), __uint_as_float(u[ch].y & 0xffff0000u)};
        }
    }
}
template <int NROWS>
__device__ __forceinline__ void stage_rows(LAS char* img, const bf16* src, int pitch, int tid) {
    u32x4 v[NROWS / 16];
#pragma unroll
    for (int i = 0; i < NROWS / 16; ++i) v[i] = *(const GAS u32x4*)(src + (size_t)((tid >> 5) + 16 * i) * pitch + (tid & 31) * 8);
#pragma unroll
    for (int i = 0; i < NROWS / 16; ++i) *(LAS u32x4*)(img + ((tid >> 5) + 16 * i) * VSTR + (tid & 31) * 16) = v[i];
}
__device__ __forceinline__ void ret_out(const unsigned char* ws, LAS unsigned char* lds, int item, int wid) {
    const int lane = lane_id(), tid = wid * 64 + lane, hi = lane >> 5, c = lane & 31, r32 = c;
    const int bh = item >> 5, ch = item & 31, b = bh >> 2, h = bh & 3;
    const bf16* proj = (const bf16*)(ws + WS_PROJ); const size_t PS = (size_t)M * 1024; const size_t row0 = (size_t)(b * T + ch * 128);
    const bf16* qr = proj + 3 * PS + row0 * 1024 + h * 256; const bf16* kr = proj + 4 * PS + row0 * 1024 + h * 256;
    const bf16* vr = proj + 5 * PS + row0 * 1024 + h * 256; const bf16* gr = proj + 6 * PS + row0 * 1024 + h * 256;
    const bf16* st = (const bf16*)(ws + WS_S) + (size_t)item * 65536;
    LAS char* img0 = (LAS char*)lds; LAS char* img1 = img0 + IMG; LAS float* stat = (LAS float*)(img0 + 2 * IMG);
    const float lg = gamma_log2(h);
    const int rb = wid & 3, half = wid >> 2;
    stage_rows<128>(img0, kr, 1024, tid); stage_rows<128>(img1, vr, 1024, tid);
    bf16x8 qf[16];
#pragma unroll
    for (int ks = 0; ks < 16; ++ks) qf[ks] = *(const GAS bf16x8*)(qr + (size_t)(rb * 32 + r32) * 1024 + ks * 16 + hi * 8);
    __syncthreads();
    u32x4 sv[16];
#pragma unroll
    for (int i = 0; i < 16; ++i) sv[i] = *(const GAS u32x4*)(st + (size_t)((tid >> 5) + 16 * i) * 256 + (tid & 31) * 8);
    unsigned pw[2][8];
#pragma unroll
    for (int jj = 0; jj < 2; ++jj) { const int cb = 2 * half + jj;
        f32x16 p = f32x16{};
        if (cb <= rb) {
#pragma unroll
            for (int ks = 0; ks < 16; ++ks) { const bf16x8 kf = *(const LAS bf16x8*)(img0 + (cb * 32 + r32) * VSTR + (ks * 16 + hi * 8) * 2);
                p = __builtin_amdgcn_mfma_f32_32x32x16_bf16(qf[ks], kf, p, 0, 0, 0); }
        }
#pragma unroll
        for (int r = 0; r < 16; r += 2) { const int tk = cb * 32 + c, d0 = rb * 32 + crow(r, hi) - tk, d1 = d0 + 1;
            const float v0 = d0 >= 0 ? p[r] * exp2f(lg * (float)d0) : 0.f, v1 = d1 >= 0 ? p[r + 1] * exp2f(lg * (float)d1) : 0.f;
            pw[jj][r >> 1] = cvtpk(v0, v1); }
    }
    __syncthreads();
#pragma unroll
    for (int jj = 0; jj < 2; ++jj) { const int cb = 2 * half + jj;
#pragma unroll
        for (int r = 0; r < 16; r += 2) { const int tq = rb * 32 + crow(r, hi), tk = cb * 32 + c;
            *(LAS bf16*)(img0 + tq * PSTR + tk * 2) = (bf16)(pw[jj][r >> 1] & 0xffffu); *(LAS bf16*)(img0 + (tq + 1) * PSTR + tk * 2) = (bf16)(pw[jj][r >> 1] >> 16); } }
    __syncthreads();
    f32x16 acc[4];
#pragma unroll
    for (int j = 0; j < 4; ++j) acc[j] = f32x16{};
    for (int ks = 0; ks < 2 * rb + 2; ++ks) {
        const bf16x8 a = *(const LAS bf16x8*)(img0 + (rb * 32 + r32) * PSTR + (ks * 16 + hi * 8) * 2);
#pragma unroll
        for (int j = 0; j < 4; ++j) { const bf16x8 bb = tr_frag(img1, VSTR, ks * 16, (half * 4 + j) * 32, lane); acc[j] = __builtin_amdgcn_mfma_f32_32x32x16_bf16(a, bb, acc[j], 0, 0, 0); }
    }
    __syncthreads();
#pragma unroll
    for (int i = 0; i < 16; ++i) *(LAS u32x4*)(img0 + ((tid >> 5) + 16 * i) * VSTR + (tid & 31) * 16) = sv[i];
    { const float xi = exp2f(lg * (float)(rb * 32 + r32 + 1));
#pragma unroll
      for (int ks = 0; ks < 16; ++ks) { u32x4 w = __builtin_bit_cast(u32x4, qf[ks]);
#pragma unroll
          for (int j = 0; j < 4; ++j) w[j] = cvtpk(__uint_as_float(w[j] << 16) * xi, __uint_as_float(w[j] & 0xffff0000u) * xi);
          qf[ks] = __builtin_bit_cast(bf16x8, w); } }
    __syncthreads();
#pragma unroll
    for (int ks = 0; ks < 16; ++ks) {
#pragma unroll
        for (int j = 0; j < 4; ++j) { const bf16x8 sf = *(const LAS bf16x8*)(img0 + ((half * 4 + j) * 32 + r32) * VSTR + (ks * 16 + hi * 8) * 2);
            acc[j] = __builtin_amdgcn_mfma_f32_32x32x16_bf16(qf[ks], sf, acc[j], 0, 0, 0); }
    }
#define RDPPF(v, ctrl) __builtin_bit_cast(float, __builtin_amdgcn_mov_dpp(__builtin_bit_cast(int, (float)(v)), ctrl, 0xF, 0xF, true))
    unsigned short gv[16][4];
#pragma unroll
    for (int r = 0; r < 16; ++r)
#pragma unroll
        for (int j = 0; j < 4; ++j) gv[r][j] = *(const GAS unsigned short*)(gr + (size_t)(rb * 32 + crow(r, hi)) * 1024 + (half * 4 + j) * 32 + c);
    float s1[16], s2[16];
#pragma unroll
    for (int r = 0; r < 16; ++r) { float a1 = 0.f, a2 = 0.f;
#pragma unroll
        for (int j = 0; j < 4; ++j) { const float v = acc[j][r]; a1 += v; a2 += v * v; }
        s1[r] = a1; s2[r] = a2; }
#pragma unroll
    for (int r = 0; r < 16; ++r) {
        s1[r] += RDPPF(s1[r], 0x128); s2[r] += RDPPF(s2[r], 0x128); s1[r] += RDPPF(s1[r], 0x124); s2[r] += RDPPF(s2[r], 0x124);
        s1[r] += RDPPF(s1[r], 0x122); s2[r] += RDPPF(s2[r], 0x122); s1[r] += RDPPF(s1[r], 0x121); s2[r] += RDPPF(s2[r], 0x121);
        s1[r] += __shfl_xor(s1[r], 16); s2[r] += __shfl_xor(s2[r], 16);
        if (c == 0) { stat[(half * 128 + rb * 32 + crow(r, hi)) * 2 + 0] = s1[r]; stat[(half * 128 + rb * 32 + crow(r, hi)) * 2 + 1] = s2[r]; } }
    __syncthreads();
    unsigned char* mixo = (unsigned char*)(ws + WS_MIX) + row0 * D + 1024 + h * 256;
#pragma unroll
    for (int r = 0; r < 16; ++r) { const int row = rb * 32 + crow(r, hi);
        const float t1 = stat[row * 2] + stat[(128 + row) * 2], t2 = stat[row * 2 + 1] + stat[(128 + row) * 2 + 1];
        const float mu = t1 * (1.f / 256.f), var = t2 * (1.f / 256.f) - mu * mu, rs = rsqrtf(fmaxf(var, 0.f) + NORM_EPS);
#pragma unroll
        for (int j = 0; j < 4; ++j) { const int col = (half * 4 + j) * 32 + c;
            const float g = __uint_as_float(((unsigned)gv[r][j]) << 16);
            const float v = (acc[j][r] - mu) * rs * (g * __builtin_amdgcn_rcpf(1.f + __expf(-g)));
            const float vn = RDPPF(v, 0xB1);
            const int w01 = __builtin_amdgcn_cvt_pk_fp8_f32(__builtin_fminf(__builtin_fmaxf(v * 16.f, -448.f), 448.f), __builtin_fminf(__builtin_fmaxf(vn * 16.f, -448.f), 448.f), 0, false) & 0xffff;
            const int w23 = __builtin_amdgcn_mov_dpp(w01, 0x4E, 0xF, 0xF, true);
            if ((c & 3) == 0) *(GAS unsigned*)(mixo + (size_t)row * D + col) = (unsigned)(w01 | (w23 << 16)); } }
#undef RDPPF
    __syncthreads();
}
}
__device__ __forceinline__ void p0_prologue(const Frame& F, const Args& a) {
    const int lane = lane_id(), tid = F.wave * 64 + lane; (void)tid;
    const float* w_ada = (const float*)a.in[3]; const float* cvec = (const float*)a.in[1];
    const float* w_in = (const float*)a.in[8]; const float* w_out = (const float*)a.in[9];
    const float* w_gate = (const float*)a.in[12]; const float* w_up = (const float*)a.in[13]; const float* w_down = (const float*)a.in[14];
    const float* ws_gate = (const float*)a.in[15]; const float* ws_up = (const float*)a.in[16]; const float* ws_down = (const float*)a.in[17];
    bf16* WinT = (bf16*)(F.ws + WS_WIN); bf16* WoutT = (bf16*)(F.ws + WS_WOUT); bf16* WguT = (bf16*)(F.ws + WS_WGU); bf16* WdT = (bf16*)(F.ws + WS_WD);
    float* modp = (float*)(F.ws + WS_MODP);
    LAS bf16* scr = (LAS bf16*)(F.lds + F.wave * 9216);
    for (int i = F.bid * (NWAVES * 64) + tid; i < 90368; i += F.G * NWAVES * 64) ((int*)(F.ws + WS_IDENT))[i] = i * 16;
    constexpr int I_MOD = 16 * 48;
    constexpr int I_IN = 32 * 112, I_OUT = 0;
    if (F.wave < 3) {
        for (int r = F.wave * F.G + F.bid; r < I_MOD; r += 3 * F.G) {
            const int kc = r / 48, n0 = (r % 48) * 256 + lane * 4;
            f32x4 a0 = {0.f, 0.f, 0.f, 0.f}, a1 = {0.f, 0.f, 0.f, 0.f};
#pragma unroll 16
            for (int k = kc * 128; k < kc * 128 + 128; ++k) { const f32x4 w = __builtin_nontemporal_load((const GAS f32x4*)(w_ada + (size_t)k * (6 * D) + n0));
                const float c0 = cvec[k], c1 = cvec[D + k]; a0 += w * silu_f(c0); a1 += w * silu_f(c1); }
            *(f32x4*)(modp + (size_t)(kc * 2 + 0) * (6 * D) + n0) = a0; *(f32x4*)(modp + (size_t)(kc * 2 + 1) * (6 * D) + n0) = a1; }
    } else {
        constexpr int I_BF = 32 * 32, I_F8 = 16 * 80;
        for (int r = F.bid * 5 + (F.wave - 3); r < I_BF + I_F8; r += F.G * 5) {
            if (r < I_BF) { f32x4 vv[16]; TrItem t; const int kb = r / 32, nb = r % 32;
                t.W = w_in; t.WT = WinT; t.rb = (size_t)nb * 64; t.N = NPROJ; t.Kout = D; t.k0 = kb * 64; t.n0 = nb * 64;
                tr_load(vv, t, lane); tr_finish(vv, t, scr, lane); }
            else { f32x4 va[32]; TrItem t; const int r2 = r - I_BF, kb = r2 / 80, nb = 32 + r2 % 80;
                t.W = w_in; t.WT = (bf16*)(F.ws + WS_WIN8); t.rb = (size_t)nb * 64; t.N = NPROJ; t.Kout = D; t.k0 = kb * 128; t.n0 = nb * 64;
                tr_load128(va, t, lane); v4u d[4][2]; tr_pack128(va, 128.f, d); tr_store128(d, t, (LAS unsigned char*)scr, lane); } }
    }
}
constexpr int CV_OUT = 16 * 32, CV_GU = 65 * 2 * 16 * 8, CV_DN = 65 * 4 * 32, CV_CHUNK = 8, CV_NCHUNK = (CV_OUT + CV_GU + CV_DN) / CV_CHUNK;
constexpr int CW_CONVQ = 2048;
__device__ __forceinline__ TrItem conv_desc(const Frame& F, const Args& a, int r) {
    const float* w_gate = (const float*)a.in[12]; const float* w_up = (const float*)a.in[13]; const float* w_down = (const float*)a.in[14];
    const float* ws_gate = (const float*)a.in[15]; const float* ws_up = (const float*)a.in[16]; const float* ws_down = (const float*)a.in[17];
    TrItem t;
    if (r < CV_OUT) { const int kb = r / 32, nb = r % 32;
        t.W = (const float*)a.in[9]; t.WT = (bf16*)(F.ws + WS_WOUT); t.rb = (size_t)nb * 64; t.N = D; t.Kout = D; t.k0 = kb * 128; t.n0 = nb * 64; return t; }
    r -= CV_OUT;
    if (r < CV_GU) {
        const int eu = r / 128, e = eu >> 1, up = eu & 1, q = r % 128, kb = q / 8, nb = q % 8, n0 = nb * 64;
        t.W = e < 64 ? (up ? w_up : w_gate) + (size_t)e * D * EH : (up ? ws_up : ws_gate); t.WT = (bf16*)(F.ws + WS_WGU);
        t.rb = (size_t)e * 1024 + (n0 >> 7) * 256 + up * 128 + (n0 & 127); t.N = EH; t.Kout = D; t.k0 = kb * 128; t.n0 = n0; return t; }
    r -= CV_GU;
    { const int e = r / 128, q = r % 128, kb = q / 32, nb = q % 32;
      t.W = e < 64 ? w_down + (size_t)e * EH * D : ws_down; t.WT = (bf16*)(F.ws + WS_WD);
      t.rb = (size_t)e * D + nb * 64; t.N = D; t.Kout = EH; t.k0 = kb * 128; t.n0 = nb * 64; return t; }
}
constexpr int CW_DONE = 2112;
constexpr int CV_NOUT = CV_OUT / CV_CHUNK, CV_NGU = (CV_OUT + CV_GU) / CV_CHUNK;
__device__ __forceinline__ void conv_drain(const Frame& F, const Args& a, int limit, unsigned* done, unsigned need) {
    const int lane = lane_id(), tid = F.wave * 64 + lane;
    LAS int* slot = (LAS int*)(F.lds + MISC_OFF + 136);
    LAS unsigned char* scr8 = (LAS unsigned char*)(F.lds + F.wave * 9216);
    unsigned* head = (unsigned*)(F.ws + WS_CTL) + CW_CONVQ;
    int prev = 0; unsigned dv = 0u;
    __syncthreads();
    if (tid == 0) { int c = CV_NCHUNK;
        if (done != nullptr) dv = __hip_atomic_load(done, RLX_AGENT);
        if (!(done != nullptr && dv >= need) && (int)__hip_atomic_load(head, RLX_AGENT) < limit) c = (int)atomicAdd(head, 1u);
        slot[0] = c; prev = c; }
    __syncthreads();
    int c = __builtin_amdgcn_readfirstlane(slot[0]);
    if (c < CV_NCHUNK) {
        f32x4 va[32];
        TrItem t = conv_desc(F, a, c * CV_CHUNK + F.wave);
        tr_load128(va, t, lane);
        int par = 1;
        for (;;) {
            if (tid == 0) { int cn = CV_NCHUNK;
                if (!(done != nullptr && dv >= need) && prev + 1 < limit) cn = (int)atomicAdd(head, 1u);
                if (done != nullptr) dv = __hip_atomic_load(done, RLX_AGENT);
                slot[par] = cn; prev = cn; }
            v4u d[4][2];
            tr_pack128(va, c < CV_NGU ? 128.f : 64.f, d);
#pragma unroll
            for (int q = 0; q < 4; ++q) asm volatile("" : "+v"(d[q][0]), "+v"(d[q][1]));
            __syncthreads();
            const int cn = __builtin_amdgcn_readfirstlane(slot[par]); par ^= 1;
            TrItem tn = t;
            if (cn < CV_NCHUNK) { tn = conv_desc(F, a, cn * CV_CHUNK + F.wave); tr_load128(va, tn, lane); }
            tr_store128(d, t, scr8, lane);
            if (cn >= CV_NCHUNK) break;
            c = cn; t = tn;
        }
    }
    __syncthreads();
}
__device__ __forceinline__ void signal_done(const Frame& F, unsigned* done) {
    __syncthreads();
    if (F.wave == 0 && lane_id() == 0) (void)atomicAdd(done, 1u);
}
__device__ __forceinline__ void compute_cvec(const Frame& F, const Args& a, int b) {
    const int lane = lane_id(), tid = F.wave * 64 + lane;
    const float* w_router = (const float*)a.in[10]; const float* mod = (const float*)(F.ws + WS_MOD); float* cvec = (float*)(F.ws + WS_CVEC);
    LAS float* shf = (LAS float*)F.lds; LAS float* cp = shf + D;
    for (int i = tid; i < D; i += NWAVES * 64) shf[i] = mod[b * 6 * D + 3 * D + i];
    __syncthreads();
    { const int e = tid & 63, sl = tid >> 6; float s = 0.f;
#pragma unroll 16
      for (int k = sl * 256; k < sl * 256 + 256; ++k) s += shf[k] * w_router[(size_t)k * 64 + e];
      cp[sl * 64 + e] = s; }
    __syncthreads();
    if (tid < 64) { float s = 0.f;
#pragma unroll
        for (int sl = 0; sl < 8; ++sl) s += cp[sl * 64 + tid];
        cvec[b * 64 + tid] = s; }
    __syncthreads();
}
__device__ __forceinline__ void norm_rows(const Frame& F, const float* x, const float* g, const LAS float* smod  , bf16* xn, float* rstd_out, int m_lo, int m_step, int m_hi, unsigned char* xn8 = nullptr) {
    const int lane = lane_id(), tid = F.wave * 64 + lane; (void)tid;
    for (int m = m_lo; m < m_hi; m += m_step) {
        const int b = m / T;
        const GAS f32x4* xr = (const GAS f32x4*)(x + (size_t)m * D);
        f32x4 v[8]; float s = 0.f;
#pragma unroll
        for (int j = 0; j < 8; ++j) { v[j] = __builtin_nontemporal_load(xr + lane + 64 * j); s += v[j][0] * v[j][0] + v[j][1] * v[j][1] + v[j][2] * v[j][2] + v[j][3] * v[j][3]; }
        s = wave_sum(s);
        const float rstd = rsqrtf(s * (1.f / D) + NORM_EPS);
        if (rstd_out && lane == 0) rstd_out[m] = rstd;
#pragma unroll
        for (int j = 0; j < 8; ++j) { const int col = (lane + 64 * j) * 4;
            const f32x4 gg = *(const f32x4*)(g + col), h4 = *(const LAS f32x4*)(smod + (b * 2 + 0) * D + col), s4 = *(const LAS f32x4*)(smod + (b * 2 + 1) * D + col);
            const f32x4 o = v[j] * rstd * gg * (s4 + 1.f) + h4;
            v2u w; w.x = pg8::cvt_pk_bf16(o[0], o[1]); w.y = pg8::cvt_pk_bf16(o[2], o[3]);
            *(v2u*)(xn + (size_t)m * D + col) = w;
            if (xn8) { const f32x4 q = o * 16.f;
                int pk = __builtin_amdgcn_cvt_pk_fp8_f32(__builtin_fminf(__builtin_fmaxf(q[0], -448.f), 448.f), __builtin_fminf(__builtin_fmaxf(q[1], -448.f), 448.f), 0, false);
                pk = __builtin_amdgcn_cvt_pk_fp8_f32(__builtin_fminf(__builtin_fmaxf(q[2], -448.f), 448.f), __builtin_fminf(__builtin_fmaxf(q[3], -448.f), 448.f), pk, true);
                *(int*)(xn8 + (size_t)m * D + col) = pk; } }
    }
}
__device__ __forceinline__ void p1_norm(const Frame& F, const Args& a) {
    const int lane = lane_id(), tid = F.wave * 64 + lane; (void)tid;
    const float* x = (const float*)a.in[0]; const float* b_ada = (const float*)a.in[4]; const float* g = (const float*)a.in[5];
    const float* modp = (const float*)(F.ws + WS_MODP); float* mod = (float*)(F.ws + WS_MOD); bf16* xn = (bf16*)(F.ws + WS_XN);
    LAS float* smod = (LAS float*)F.lds;
    const int rows_per = (M + F.G - 1) / F.G, m_lo = F.bid * rows_per, m_hi = (m_lo + rows_per < M) ? m_lo + rows_per : M;
    const int b_lo = m_lo / T, b_hi = (m_hi - 1) / T;
    for (int b = b_lo; b <= b_hi && b < NB; ++b)
#pragma unroll
        for (int u_ = 0; u_ < 8; ++u_) { const int i = tid + 512 * u_, which = i / D, col = i % D, n = which * D + col;
            float s = b_ada[n];
#pragma unroll
            for (int kc = 0; kc < 16; ++kc) s += modp[(size_t)(kc * 2 + b) * (6 * D) + n];
            smod[b * 2 * D + i] = s; }
    if (F.bid < 48) { const int i = F.bid * 512 + tid, b = i / (6 * D), n = i % (6 * D);
        float s = b_ada[n];
#pragma unroll
        for (int kc = 0; kc < 16; ++kc) s += modp[(size_t)(kc * 2 + b) * (6 * D) + n];
        mod[i] = s; }
    __syncthreads();
    norm_rows(F, x, g, smod, xn, nullptr, m_lo + F.wave, NWAVES, m_hi, (unsigned char*)(F.ws + WS_XN8));
    __syncthreads();
}
__device__ __forceinline__ void p10_final(const Frame& F, const Args& a, const float probe_scale) {
    typedef float f32x2 __attribute__((ext_vector_type(2)));
    const int lane = lane_id();
    const float* xin = (const float*)a.in[0]; const bf16* mixo = (const bf16*)(F.ws + WS_MIXO); const unsigned char* yr = (const unsigned char*)(F.ws + WS_YSLOT); const float* mod = (const float*)(F.ws + WS_MOD);
    const int* inv = (const int*)(F.ws + WS_INV); const float* wts = (const float*)(F.ws + WS_WTS);
    const LAS int* tile_s = (const LAS int*)(F.lds + TILE_S_OFF);
    const float* gout = (const float*)a.in[7]; float* out = a.out;
    for (int m = F.bid * NWAVES + F.wave; m < M; m += F.G * NWAVES) {
        const float* gate = mod + (m / T) * 6 * D + 5 * D; const float* gatea = mod + (m / T) * 6 * D + 2 * D;
        int rowv = 0; float wv = 0.f;
        if (lane < 8) { const int iv = inv[m * 8 + lane]; rowv = tile_s[iv >> 13] * 256 + (iv & 8191); wv = wts[m * 8 + lane] * (1.f / 64.f); }
        else if (lane == 8) { rowv = tile_s[64] * 256 + m; wv = 1.f / 64.f; }
        f32x4 v[4][2]; float s = 0.f;
#pragma unroll
        for (int j = 0; j < 4; ++j) { const int col = (lane + 64 * j) * 8;
            f32x4 y0 = {0.f, 0.f, 0.f, 0.f}, y1 = {0.f, 0.f, 0.f, 0.f};
#pragma unroll
            for (int k = 0; k < 9; ++k) { const int rk = __builtin_amdgcn_readlane(rowv, k); const float wk = __builtin_bit_cast(float, __builtin_amdgcn_readlane(__builtin_bit_cast(int, wv), k));
                const v2u u = __builtin_nontemporal_load((const GAS v2u*)(yr + (size_t)rk * D + col));
                const f32x2 a0 = __builtin_amdgcn_cvt_pk_f32_fp8((int)u.x, false), a1 = __builtin_amdgcn_cvt_pk_f32_fp8((int)u.x, true);
                const f32x2 b0 = __builtin_amdgcn_cvt_pk_f32_fp8((int)u.y, false), b1 = __builtin_amdgcn_cvt_pk_f32_fp8((int)u.y, true);
                y0[0] += wk * a0[0]; y0[1] += wk * a0[1]; y0[2] += wk * a1[0]; y0[3] += wk * a1[1];
                y1[0] += wk * b0[0]; y1[1] += wk * b0[1]; y1[2] += wk * b1[0]; y1[3] += wk * b1[1]; }
            const v4u mm = __builtin_nontemporal_load((const GAS v4u*)(mixo + (size_t)m * D + col));
            const f32x4 gaa = *(const f32x4*)(gatea + col), gab = *(const f32x4*)(gatea + col + 4);
            const f32x4 xa = __builtin_nontemporal_load((const GAS f32x4*)(xin + (size_t)m * D + col)) + gaa * (f32x4){__uint_as_float(mm.x << 16), __uint_as_float(mm.x & 0xffff0000u), __uint_as_float(mm.y << 16), __uint_as_float(mm.y & 0xffff0000u)};
            const f32x4 xb = __builtin_nontemporal_load((const GAS f32x4*)(xin + (size_t)m * D + col + 4)) + gab * (f32x4){__uint_as_float(mm.z << 16), __uint_as_float(mm.z & 0xffff0000u), __uint_as_float(mm.w << 16), __uint_as_float(mm.w & 0xffff0000u)};
            const f32x4 ga = *(const f32x4*)(gate + col), gb = *(const f32x4*)(gate + col + 4);
            v[j][0] = xa + ga * y0; v[j][1] = xb + gb * y1;
#pragma unroll
            for (int q = 0; q < 2; ++q) s += v[j][q][0] * v[j][q][0] + v[j][q][1] * v[j][q][1] + v[j][q][2] * v[j][q][2] + v[j][q][3] * v[j][q][3]; }
        s = wave_sum(s);
        const float rstd = rsqrtf(s * (1.f / D) + NORM_EPS) * probe_scale;
#pragma unroll
        for (int j = 0; j < 4; ++j) { const int col = (lane + 64 * j) * 8;
            *(f32x4*)(out + (size_t)m * D + col) = v[j][0] * rstd * *(const f32x4*)(gout + col);
            *(f32x4*)(out + (size_t)m * D + col + 4) = v[j][1] * rstd * *(const f32x4*)(gout + col + 4); }
    }
}
__device__ __forceinline__ int moe_tables(const Frame& F, const unsigned* cnt) {
    const int lane = lane_id(), tid = F.wave * 64 + lane; (void)tid;
    LAS int* tile_e = (LAS int*)(F.lds + TILE_E_OFF); LAS int* tile_s = (LAS int*)(F.lds + TILE_S_OFF); LAS int* ecnt = (LAS int*)(F.lds + ECNT_OFF);
    if (tid < 65) ecnt[tid] = tid < 64 ? (int)__hip_atomic_load(cnt + tid * 64, RLX_AGENT) : M;
    __syncthreads();
    if (tid == 0) { int s = 0; for (int e = 0; e < 65; ++e) { tile_s[e] = s; s += (ecnt[e] + 255) >> 8; } tile_s[65] = s; }
    __syncthreads();
    const int total = tile_s[65];
    if (tid < 65) { for (int p = tile_s[tid]; p < tile_s[tid + 1]; ++p) tile_e[p] = tid; }
    __syncthreads();
    return total;
}
__device__ __forceinline__ void route_row(float lg, const float* bias, int row, LAS int* lcnt, LAS int* s_e, LAS int* s_lp, LAS float* s_w, LAS float* bscr, int lane) {
    const float score = 1.f / (1.f + __expf(-lg));
    const float biased = score + bias[lane];
    float m1 = biased;
    m1 = fmaxf(m1, __shfl_xor(m1, 1)); m1 = fmaxf(m1, __shfl_xor(m1, 2)); m1 = fmaxf(m1, __shfl_xor(m1, 4));
    const unsigned long long eq = __ballot(biased == m1);
    const unsigned gb = (unsigned)(eq >> (lane & ~7)) & 0xffu;
    const int first = __ffs(gb) - 1;
    float v2 = ((lane & 7) == first) ? -3e38f : biased;
    v2 = fmaxf(v2, __shfl_xor(v2, 1)); v2 = fmaxf(v2, __shfl_xor(v2, 2)); v2 = fmaxf(v2, __shfl_xor(v2, 4));
    const float gs = m1 + v2; const int g = lane >> 3;
    int grank = 0;
#pragma unroll
    for (int j = 0; j < 8; ++j) { const float o = __shfl(gs, j * 8); grank += (o > gs || (o == gs && j < g)) ? 1 : 0; }
    const float masked = grank < 4 ? biased : NEGF;
    int rank = 0, neq = 0;
    bscr[lane] = masked;
    __builtin_amdgcn_wave_barrier();
#pragma unroll
    for (int q = 0; q < 16; ++q) { const f32x4 o = *(const LAS f32x4*)(bscr + 4 * q);
#pragma unroll
        for (int c = 0; c < 4; ++c) { rank += (o[c] > masked) ? 1 : 0; neq += (o[c] == masked) ? 1 : 0; } }
    __builtin_amdgcn_wave_barrier();
    if (__ballot(neq > 1 && grank < 4) != 0ull) {
        int lo_ = lane; asm volatile("" : "+v"(lo_));
#pragma unroll 1
        for (int j = 0; j < 64; ++j) { const float o = __shfl(masked, j); rank += (o == masked && j < lo_) ? 1 : 0; } }
    const bool selx = rank < 8;
    const float ssum = wave_sum(selx ? score : 0.f);
    if (selx) { const int lp = __hip_atomic_fetch_add(lcnt + lane, 1, __ATOMIC_RELAXED, __HIP_MEMORY_SCOPE_WORKGROUP);
        s_e[row * 8 + rank] = lane; s_lp[row * 8 + rank] = lp; s_w[row * 8 + rank] = score / ssum * 2.5f; }
}
__device__ __forceinline__ void p7_route(const Frame& F, const Args& a) {
    typedef float f32x16 __attribute__((ext_vector_type(16)));
    const int lane = lane_id(), w = F.wave, tid = w * 64 + lane;
    const float* xin = (const float*)a.in[0]; const bf16* mixo = (const bf16*)(F.ws + WS_MIXO); float* x1o = (float*)(F.ws + WS_X1);
    const float* g = (const float*)a.in[6]; const float* mod = (const float*)(F.ws + WS_MOD);
    const float* w_router = (const float*)a.in[10]; const float* rbias = (const float*)a.in[11];
    unsigned char* xn = (unsigned char*)(F.ws + WS_XN);
    constexpr int AST = 1028;
    LAS float* At = (LAS float*)F.lds; LAS float* part = At;
    LAS float* cvec = At + 32 * AST; LAS int* lcnt = (LAS int*)(cvec + 64); LAS int* lbase = lcnt + 64; LAS int* s_e = lbase + 64; LAS int* s_lp = s_e + 256; LAS float* s_w = (LAS float*)(s_lp + 256);
    for (int tile = F.bid; tile < M / 32; tile += F.G) {
        const int m0 = tile * 32, b = m0 / T;
        const float* ga = mod + b * 6 * D + 2 * D; const float* shf = mod + b * 6 * D + 3 * D; const float* scf = mod + b * 6 * D + 4 * D;
        { const int t0_ = w * 64 + lane_id(); if (t0_ < 64) { cvec[t0_] = ((const float*)(F.ws + WS_CVEC))[b * 64 + t0_]; lcnt[t0_] = 0; } }
        f32x4 xv[4][8]; float ss[4] = {0.f, 0.f, 0.f, 0.f};
#pragma unroll
        for (int j = 0; j < 8; ++j) { const int col = (lane + 64 * j) * 4; const f32x4 gaa = *(const f32x4*)(ga + col);
#pragma unroll
            for (int r = 0; r < 4; ++r) { const size_t off = (size_t)(m0 + w * 4 + r) * D + col;
                const f32x4 xx = *(const GAS f32x4*)(xin + off); const v2u mm = *(const GAS v2u*)(mixo + off);
                const f32x4 v = xx + gaa * (f32x4){__uint_as_float(mm.x << 16), __uint_as_float(mm.x & 0xffff0000u), __uint_as_float(mm.y << 16), __uint_as_float(mm.y & 0xffff0000u)};
                xv[r][j] = v; ss[r] += v[0] * v[0] + v[1] * v[1] + v[2] * v[2] + v[3] * v[3];
                } }
        float rstd[4];
#pragma unroll
        for (int r = 0; r < 4; ++r) rstd[r] = rsqrtf(wave_sum(ss[r]) * (1.f / D) + NORM_EPS);
#pragma unroll
        for (int j = 0; j < 8; ++j) { const int col = (lane + 64 * j) * 4;
            const f32x4 gsv = *(const f32x4*)(g + col) * (*(const f32x4*)(scf + col) + 1.f), shv = *(const f32x4*)(shf + col);
#pragma unroll
            for (int r = 0; r < 4; ++r) { const f32x4 ap = xv[r][j] * rstd[r] * gsv; xv[r][j] = ap; const f32x4 o = (ap + shv) * 16.f;
                int pk = __builtin_amdgcn_cvt_pk_fp8_f32(__builtin_fminf(__builtin_fmaxf(o[0], -448.f), 448.f), __builtin_fminf(__builtin_fmaxf(o[1], -448.f), 448.f), 0, false);
                pk = __builtin_amdgcn_cvt_pk_fp8_f32(__builtin_fminf(__builtin_fmaxf(o[2], -448.f), 448.f), __builtin_fminf(__builtin_fmaxf(o[3], -448.f), 448.f), pk, true);
                *(int*)(xn + (size_t)(m0 + w * 4 + r) * D + col) = pk; } }
#define LDS_BAR() do { asm volatile("s_waitcnt lgkmcnt(0)" ::: "memory"); __builtin_amdgcn_s_barrier(); asm volatile("" ::: "memory"); } while (0)
        const int i = lane & 31, kh = lane >> 5;
        f32x16 acc0 = f32x16{}, acc1 = f32x16{};
#pragma unroll
        for (int hf = 0; hf < 2; ++hf) {
            LDS_BAR();
#pragma unroll
            for (int r = 0; r < 4; ++r)
#pragma unroll
                for (int j = 0; j < 4; ++j) *(LAS f32x4*)(At + (w * 4 + r) * AST + (lane + 64 * j) * 4) = xv[r][hf * 4 + j];
            LDS_BAR();
            const LAS float* arow = At + i * AST + w * 128 + 4 * kh;
            const float* wb = w_router + (size_t)(hf * 1024 + w * 128 + 4 * kh) * 64 + i;
            float bn[4][2];
#pragma unroll
            for (int c = 0; c < 4; ++c) { bn[c][0] = wb[(size_t)c * 64]; bn[c][1] = wb[(size_t)c * 64 + 32]; }
#pragma unroll 4
            for (int q = 0; q < 16; ++q) {
                float bc[4][2];
#pragma unroll
                for (int c = 0; c < 4; ++c) { bc[c][0] = bn[c][0]; bc[c][1] = bn[c][1]; }
                if (q + 1 < 16) {
#pragma unroll
                    for (int c = 0; c < 4; ++c) { bn[c][0] = wb[(size_t)(8 * (q + 1) + c) * 64]; bn[c][1] = wb[(size_t)(8 * (q + 1) + c) * 64 + 32]; } }
                const f32x4 av = *(const LAS f32x4*)(arow + 8 * q);
#pragma unroll
                for (int c = 0; c < 4; ++c) { acc0 = __builtin_amdgcn_mfma_f32_32x32x2f32(av[c], bc[c][0], acc0, 0, 0, 0); acc1 = __builtin_amdgcn_mfma_f32_32x32x2f32(av[c], bc[c][1], acc1, 0, 0, 0); }
            }
        }
        LDS_BAR();
#pragma unroll
        for (int r = 0; r < 16; ++r) { const int row = (r & 3) + 8 * (r >> 2) + 4 * kh; part[(w * 32 + row) * 64 + i] = acc0[r]; part[(w * 32 + row) * 64 + 32 + i] = acc1[r]; }
        LDS_BAR();
        const int ln = lane_id();
#undef LDS_BAR
        for (int rr = 0; rr < 4; ++rr) { const int row = w * 4 + rr;
            float acc = 0.f;
#pragma unroll
            for (int ww = 0; ww < 8; ++ww) acc += part[(ww * 32 + row) * 64 + ln];
            route_row(acc + cvec[ln], rbias, row, lcnt, s_e, s_lp, s_w, s_w + 256 + w * 64, ln);
        }
        __syncthreads();
        const int t2 = w * 64 + lane_id();
        if (t2 < 64) lbase[t2] = (int)atomicAdd((unsigned*)(F.ws + WS_CTL) + CW_CNT + t2 * 64, (unsigned)lcnt[t2]);
        __syncthreads();
        if (t2 < 256) { const int e = s_e[t2], pos = lbase[e] + s_lp[t2], m = m0 + (t2 >> 3), kk = t2 & 7;
            ((int*)(F.ws + WS_LTOK))[e * M + pos] = m * 16 + kk; ((int*)(F.ws + WS_INV))[m * 8 + kk] = e * 8192 + pos; ((float*)(F.ws + WS_WTS))[m * 8 + kk] = s_w[t2]; }
        else if (t2 < 288) { const int m = m0 + t2 - 256; ((int*)(F.ws + WS_LTOK))[64 * M + m] = m * 16 + 8; }
        __syncthreads();
    }
}

constexpr int CW_ATTQ = 2560;
__device__ __forceinline__ int pop_item(const Frame& F, unsigned* ctr, int tid) {
    LAS int* slot = (LAS int*)(F.lds + MISC_OFF + 132);
    __syncthreads();
    if (tid == 0) *slot = (int)atomicAdd(ctr, 1u);
    __syncthreads();
    return *slot;
}
__device__ __forceinline__ void p3_attention(const Frame& F, const Args& a) {
    char* lds = (char*)F.lds;
    att::Seam S; bool first = true;
    for (int it = F.bid; it < 256; it += F.G) {
        const att::BlockRef cur{F.ws, it}, nxt{F.ws, (it + F.G < 256) ? it + F.G : it};
        if (first) { att::moba_prime(cur, lds, S, F.wave); first = false; }
        att::moba_block(cur, nxt, lds, S, F.wave);
    }
    const int nl = F.G / 2;
    if (F.bid >= F.G - nl) for (int ri = F.bid - (F.G - nl); ri < 256; ri += nl) ret::ret_state(F.ws, F.lds, ri, F.wave);
    unsigned* done = (unsigned*)(F.ws + WS_CTL) + CW_DONE + 64;
    signal_done(F, done);
    conv_drain(F, a, CV_NCHUNK, done, (unsigned)F.G);
}

__global__ void __launch_bounds__(NWAVES * 64, 2) mk_fwd(Args args) {
    extern __shared__ __attribute__((aligned(16))) unsigned char lds_raw[];
    Frame F;
    F.lds = (LAS unsigned char*)lds_raw; F.wave = __builtin_amdgcn_readfirstlane(threadIdx.x >> 6);
    F.G = gridDim.x; F.bid = blockIdx.x; F.ws = args.ws;
    volatile LAS unsigned* MISC = (volatile LAS unsigned*)(F.lds + MISC_OFF);
    { const int l0 = lane_id(); if (F.wave == 0) MISC[l0] = 0u; }
    __syncthreads();
    unsigned* ctl = (unsigned*)(F.ws + WS_CTL);
    const int lo = args.ph_lo, hi = args.ph_hi;
    XcdBarrier bar; bar.bar = ctl + CW_BAR + args.li * XCD_BAR_WORDS; bar.x = 0; bar.st = nullptr;
    if (hi - lo > 1) bar = xcd_barrier_post(ctl + CW_BAR + args.li * XCD_BAR_WORDS, MISC + 8, F.wave * 64 + lane_id());
#ifndef PROBE_REP
#define PROBE_REP -1
#endif
#define IN(k) (lo <= (k) && (k) < hi)
#define REP(k) for (int rep_ = 0; rep_ < ((k) == PROBE_REP ? 2 : 1); ++rep_)
#ifndef PROBE_TS
#define PROBE_TS -1
#endif
#ifndef PROBE_TS_A
#define PROBE_TS_A PROBE_TS
#endif
#ifndef PROBE_HEAD
#define PROBE_HEAD 0
#endif
#ifndef PROBE_DIV
#define PROBE_DIV 32.f
#endif
    unsigned long long ts_a = 0ull;
#define TS_BEGIN(k) do { if ((k) == PROBE_TS_A) ts_a = __builtin_amdgcn_s_memrealtime(); } while (0)
#define TS_END(k) do { if ((k) == PROBE_TS && F.bid == 0 && F.wave == 0) { unsigned dt = (unsigned)(__builtin_amdgcn_s_memrealtime() - ts_a); if (PROBE_HEAD) dt = __hip_atomic_load(ctl + CW_CONVQ, RLX_AGENT) * (unsigned)(PROBE_DIV * 100.f) / 120u; __hip_atomic_store(ctl + 3000, (dt + (unsigned)(PROBE_DIV * 50.f)) / (unsigned)(PROBE_DIV * 100.f), RLX_AGENT); } } while (0)
#define SEAM(k) do { if (IN(k) && IN((k) + 1)) xcd_barrier(bar, F.wave * 64 + lane_id()); } while (0)
    LAS unsigned char* ring = F.lds; LAS unsigned char* tab = F.lds + TAB_OFF;
    TS_BEGIN(0); if (IN(0)) REP(0) { p0_prologue(F, args); __syncthreads(); } SEAM(0); TS_END(0);
    TS_BEGIN(1); if (IN(1)) REP(1) { p1_norm(F, args); } SEAM(1); TS_END(1);
    TS_BEGIN(2); if (IN(2)) REP(2) {
        const int GG = (F.G == 256) ? 240 : F.G, G3 = (F.G == 256) ? 16 : 0; unsigned* done = ctl + CW_DONE;
        if (F.bid < GG) {
            { pg8::Gemm g{(const bf16*)(F.ws + WS_XN), (const bf16*)(F.ws + WS_WIN), D}; pg8::StaticOrder S; S.init(M, 8 * 256, GG, F.bid); S.ident = (const int*)(F.ws + WS_IDENT);
              pg8::EpiProj E{(bf16*)(F.ws + WS_PROJ), (const int*)args.in[2], (float*)(F.ws + WS_KMEAN), 1.f};
              pg8::gemm_phase<pg8::EpiProj, pg8::StaticOrder, false, true>(ring, tab, g, S, E, F.wave); }
            if (F.bid >= G3) {
              pg8::Gemm g{(const bf16*)(F.ws + WS_XN8), (const bf16*)(F.ws + WS_WIN8), D}; pg8::StaticOrder S; S.init(M, 20 * 256, GG - G3, F.bid - G3); S.pbase = 8; S.ident = (const int*)(F.ws + WS_IDENT);
              pg8::EpiProj E{(bf16*)(F.ws + WS_PROJ), (const int*)args.in[2], (float*)(F.ws + WS_KMEAN), 1.f / 2048.f};
              pg8::gemm_phase<pg8::EpiProj, pg8::StaticOrder, true, true, true>(ring, tab, g, S, E, F.wave); }
            signal_done(F, done);
            conv_drain(F, args, CV_NCHUNK, done, (unsigned)GG);
        } else { if (F.bid - GG < 2) compute_cvec(F, args, F.bid - GG); conv_drain(F, args, CV_NCHUNK, done, (unsigned)GG); }
    } SEAM(2); TS_END(2);
    TS_BEGIN(3); if (IN(3)) REP(3) { p3_attention(F, args); } SEAM(3); TS_END(3);
    TS_BEGIN(4); if (IN(4)) REP(4) { ret::ret_scan(F.ws, F.bid * (NWAVES * 64) + F.wave * 64 + lane_id(), F.G * NWAVES * 64); } SEAM(4); TS_END(4);
    TS_BEGIN(5); if (IN(5)) REP(5) { for (int item = F.bid; item < 256; item += F.G) ret::ret_out(F.ws, F.lds, item, F.wave); conv_drain(F, args, CV_NOUT, nullptr, 0u);   } SEAM(5); TS_END(5);
    TS_BEGIN(6); if (IN(6)) REP(6) {
        pg8::Gemm g{(const bf16*)(F.ws + WS_MIX), (const bf16*)(F.ws + WS_WOUT), D}; pg8::StaticOrder S; S.init(M, D, F.G, F.bid); S.ident = (const int*)(F.ws + WS_IDENT);
        pg8::EpiOut E{(bf16*)(F.ws + WS_MIXO)};
        pg8::gemm_phase<pg8::EpiOut, pg8::StaticOrder, true, false, true>(ring, tab, g, S, E, F.wave);
    } SEAM(6); TS_END(6);
    TS_BEGIN(7); if (IN(7)) { p7_route(F, args); conv_drain(F, args, CV_NGU, nullptr, 0u); } SEAM(7); TS_END(7);
    TS_BEGIN(8); if (IN(8)) REP(8) {
        const int total = moe_tables(F, ctl + CW_CNT);
        const int nwg = total * 4, rounds = (nwg + F.G - 1) / F.G + 1; int GG = (((nwg + rounds - 1) / rounds) + 7) & ~7; if (GG > F.G) GG = F.G;
        unsigned* done = ctl + CW_DONE + 128;
        if (F.bid < GG) {
            pg8::MoeOrder S; S.nM = total; S.nN = 4; S.nwg = nwg; S.G = GG; S.c = F.bid;
            S.tile_e = (const LAS int*)(F.lds + TILE_E_OFF); S.tile_start = (const LAS int*)(F.lds + TILE_S_OFF); S.ecount = (const LAS int*)(F.lds + ECNT_OFF); S.ltok = (const int*)(F.ws + WS_LTOK); S.ident = nullptr;
            pg8::Gemm g{(const bf16*)(F.ws + WS_XN), (const bf16*)(F.ws + WS_WGU), D};
            pg8::EpiAct E{(unsigned char*)(F.ws + WS_ACT)};
            pg8::gemm_phase<pg8::EpiAct, pg8::MoeOrder, true, true, true>(ring, tab, g, S, E, F.wave);
        }
        conv_drain(F, args, CV_NCHUNK, nullptr, 0u);
    } SEAM(8); TS_END(8);
    TS_BEGIN(9); if (IN(9)) REP(9) {
        const int total = IN(8) ? ((const LAS int*)(F.lds + TILE_S_OFF))[65] : moe_tables(F, ctl + CW_CNT);
        pg8::MoeOrder S; S.nM = total; S.nN = 8; S.nwg = total * 8; S.G = F.G; S.c = F.bid;
        S.tile_e = (const LAS int*)(F.lds + TILE_E_OFF); S.tile_start = (const LAS int*)(F.lds + TILE_S_OFF); S.ecount = (const LAS int*)(F.lds + ECNT_OFF); S.ltok = (const int*)(F.ws + WS_LTOK); S.ident = (const int*)(F.ws + WS_IDENT);
        int kdn = EH; asm volatile("" : "+s"(kdn));
        pg8::Gemm g{(const bf16*)(F.ws + WS_ACT), (const bf16*)(F.ws + WS_WD), kdn};
        pg8::EpiDown E{(unsigned char*)(F.ws + WS_YSLOT)};
        pg8::gemm_phase<pg8::EpiDown, pg8::MoeOrder, true, true, true>(ring, tab, g, S, E, F.wave);
    } SEAM(9); TS_END(9);
    if (IN(10)) REP(10) { if (!IN(8)) (void)moe_tables(F, ctl + CW_CNT); p10_final(F, args, PROBE_TS >= 0 ? 1.f + (float)__hip_atomic_load(ctl + 3000, RLX_AGENT) * 0.01f : 1.f); }
#undef IN
#undef SEAM
}

extern "C" void kernel_launch(void* const* d_in, const int* in_sizes, int n_in, void* d_out, int out_size, void* d_ws, size_t ws_size, hipStream_t stream) {
    static int grid = 0;
    if (grid == 0) {
        if (n_in != 18 || ws_size < WS_END) { fprintf(stderr, "kernel_launch: bad args n_in %d ws %zu\n", n_in, ws_size); grid = -1; return; }
        int dev = 0, cus = 0, per_cu = 0;
        if (hipGetDevice(&dev) != hipSuccess || hipDeviceGetAttribute(&cus, hipDeviceAttributeMultiprocessorCount, dev) != hipSuccess) { grid = -1; return; }
        if (hipFuncSetAttribute((const void*)mk_fwd, hipFuncAttributeMaxDynamicSharedMemorySize, LDS_BYTES) != hipSuccess) { fprintf(stderr, "kernel_launch: hipFuncSetAttribute failed\n"); grid = -1; return; }
        if (hipOccupancyMaxActiveBlocksPerMultiprocessor(&per_cu, (const void*)mk_fwd, NWAVES * 64, LDS_BYTES) != hipSuccess || per_cu < 1) { fprintf(stderr, "kernel_launch: occupancy query says %d\n", per_cu); per_cu = 1; }
        (void)hipGetLastError();
        grid = cus;
    }
    if (grid < 0) return;
    unsigned char* ws = (unsigned char*)d_ws;
    (void)hipMemsetAsync(ws + WS_CTL, 0, CTL_ZERO_BYTES, stream);
    Args a{};
    for (int i = 0; i < 18; ++i) a.in[i] = d_in[i];
    a.out = (float*)d_out; a.ws = ws;
    a.ph_lo = 0; a.ph_hi = 11; a.li = 0;
    hipLaunchKernelGGL(mk_fwd, dim3(grid), dim3(NWAVES * 64), LDS_BYTES, stream, a);
}
```
